# Optimizing an MI355X kernel written in HIP

```python
import math
import jax
import jax.numpy as jnp
from jax import lax
import numpy as np

D_MODEL = 1024
BATCH = 8
SEQ = 2048
DEPTH = 1

HEAD_DIM = D_MODEL // 16
N_FOX_HEADS = 8
N_MOBA_HEADS = 8
FOX_WIDTH = N_FOX_HEADS * HEAD_DIM
MOBA_WIDTH = N_MOBA_HEADS * HEAD_DIM
IN_COLS = 3 * FOX_WIDTH + N_FOX_HEADS + 3 * MOBA_WIDTH + 2 * D_MODEL
Q_BLOCK = 128
MOBA_BLOCK = 256
MOBA_TOPK = 3
MOBA_Q_CHUNK = 32
PEER_HEADS = 8
PEER_N_KEYS = 128
PEER_N_EXPERTS = PEER_N_KEYS * PEER_N_KEYS
PEER_TOPK = 16
PEER_QUERY_DIM = 256
PEER_HALF = PEER_QUERY_DIM // 2
PEER_TOKEN_CHUNK = 128
EPS = 1e-6
NEG = -1e30

kernel_name = "hybrid_fox_moba_peer_adaln_block"


def rms_norm(x, g):
    xf = x.astype(jnp.float32)
    y = xf * lax.rsqrt(jnp.mean(xf * xf, axis=-1, keepdims=True) + EPS)
    return (y * g.astype(jnp.float32)).astype(x.dtype)


def fox_attention(q, k, v, log_f):
    B, H, S, d = q.shape
    F = jnp.cumsum(log_f, axis=-1)
    nq = S // Q_BLOCK
    qb = q.reshape(B, H, nq, Q_BLOCK, d).transpose(2, 0, 1, 3, 4)
    Fq = F.reshape(B, H, nq, Q_BLOCK).transpose(2, 0, 1, 3)
    kpos = jnp.arange(S)
    scale = d ** -0.5

    def block(args):
        qi, Fi, i = args
        s = jnp.einsum('bhqd,bhkd->bhqk', qi, k).astype(jnp.float32) * scale
        s = s + Fi[..., None] - F[:, :, None, :]
        qpos = i * Q_BLOCK + jnp.arange(Q_BLOCK)
        s = jnp.where(kpos[None, :] <= qpos[:, None], s, NEG)
        p = jax.nn.softmax(s, axis=-1).astype(v.dtype)
        return jnp.einsum('bhqk,bhkd->bhqd', p, v)

    out = lax.map(block, (qb, Fq, jnp.arange(nq)))
    return out.transpose(1, 2, 0, 3, 4).reshape(B, H, S, d)


def moba_attention(q, k, v, slopes):
    B, H, S, d = q.shape
    nb = -(-S // MOBA_BLOCK)
    s_pad = nb * MOBA_BLOCK
    pad = ((0, 0), (0, 0), (0, s_pad - S), (0, 0))
    qp, kp, vp = jnp.pad(q, pad), jnp.pad(k, pad), jnp.pad(v, pad)
    kb = kp.reshape(B, H, nb, MOBA_BLOCK, d)
    vb = vp.reshape(B, H, nb, MOBA_BLOCK, d)
    k_mean = jnp.mean(kb.astype(jnp.float32), axis=3)
    n_sel = min(MOBA_TOPK, nb - 1)
    C = MOBA_Q_CHUNK
    nc = s_pad // C
    qc = qp.reshape(B, H, nc, C, d).transpose(2, 0, 1, 3, 4)
    scale = d ** -0.5
    offs = jnp.arange(MOBA_BLOCK)
    b_idx = jnp.arange(B)[:, None, None, None]
    h_idx = jnp.arange(H)[None, :, None, None]
    slope4 = slopes.astype(jnp.float32)[None, :, None, None]
    slope5 = slope4[..., None]

    def chunk(args):
        qi, ci = args
        t0 = ci * C
        bt = t0 // MOBA_BLOCK
        qpos = t0 + jnp.arange(C)
        k_own = lax.dynamic_index_in_dim(kb, bt, axis=2, keepdims=False)
        v_own = lax.dynamic_index_in_dim(vb, bt, axis=2, keepdims=False)
        own_pos = bt * MOBA_BLOCK + offs
        dist_own = (qpos[:, None] - own_pos[None, :]).astype(jnp.float32)
        s_own = jnp.einsum('bhqd,bhkd->bhqk', qi, k_own).astype(jnp.float32) * scale - slope4 * dist_own
        s_own = jnp.where(dist_own >= 0, s_own, NEG)
        if n_sel == 0:
            p = jax.nn.softmax(s_own, axis=-1).astype(v.dtype)
            return jnp.einsum('bhqk,bhkd->bhqd', p, v_own)
        gate = jnp.einsum('bhqd,bhnd->bhqn', qi.astype(jnp.float32), k_mean)
        gate = jnp.where(jnp.arange(nb) < bt, gate, NEG)
        _, sel = lax.top_k(gate, n_sel)
        k_g = kb[b_idx, h_idx, sel]
        v_g = vb[b_idx, h_idx, sel]
        sel_pos = sel[..., None] * MOBA_BLOCK + offs
        dist_sel = (qpos[None, None, :, None, None] - sel_pos).astype(jnp.float32)
        s_sel = jnp.einsum('bhqd,bhqnkd->bhqnk', qi, k_g).astype(jnp.float32) * scale - slope5 * dist_sel
        s_sel = jnp.where((sel < bt)[..., None], s_sel, NEG)
        logits = jnp.concatenate([s_sel.reshape(B, H, C, n_sel * MOBA_BLOCK), s_own], axis=-1)
        p = jax.nn.softmax(logits, axis=-1).astype(v.dtype)
        p_sel = p[..., :n_sel * MOBA_BLOCK].reshape(B, H, C, n_sel, MOBA_BLOCK)
        p_own = p[..., n_sel * MOBA_BLOCK:]
        return (jnp.einsum('bhqnk,bhqnkd->bhqd', p_sel, v_g)
                + jnp.einsum('bhqk,bhkd->bhqd', p_own, v_own))

    out = lax.map(chunk, (qc, jnp.arange(nc)))
    return out.transpose(1, 2, 0, 3, 4).reshape(B, H, s_pad, d)[:, :, :S]


def peer_ffn(h, w_q, sub_keys, u_tab, v_tab):
    B, S, D = h.shape
    T = B * S
    ht = h.reshape(T, D)
    q = (ht @ w_q).reshape(T, PEER_HEADS, 2, PEER_HALF)
    sc = jnp.einsum('thpc,hpnc->thpn', q, sub_keys).astype(jnp.float32)
    s1, i1 = lax.top_k(sc[:, :, 0], PEER_TOPK)
    s2, i2 = lax.top_k(sc[:, :, 1], PEER_TOPK)
    cand = (s1[..., :, None] + s2[..., None, :]).reshape(T, PEER_HEADS, PEER_TOPK * PEER_TOPK)
    cand_id = (i1[..., :, None] * PEER_N_KEYS + i2[..., None, :]).reshape(T, PEER_HEADS, PEER_TOPK * PEER_TOPK)
    top_s, pos = lax.top_k(cand, PEER_TOPK)
    eid = jnp.take_along_axis(cand_id, pos, axis=-1)
    g = jax.nn.softmax(top_s, axis=-1).astype(h.dtype)
    nc = T // PEER_TOKEN_CHUNK

    def chunk(args):
        hc, ec, gc = args
        a = jnp.einsum('cd,chkd->chk', hc, u_tab[ec])
        w = gc * jax.nn.gelu(a)
        return jnp.einsum('chk,chkd->cd', w, v_tab[ec])

    y = lax.map(chunk, (ht.reshape(nc, PEER_TOKEN_CHUNK, D),
                        eid.reshape(nc, PEER_TOKEN_CHUNK, PEER_HEADS, PEER_TOPK),
                        g.reshape(nc, PEER_TOKEN_CHUNK, PEER_HEADS, PEER_TOPK)))
    return y.reshape(B, S, D)


def setup_inputs(seed: int = 0) -> dict:
    key = jax.random.key(seed)
    ks = jax.random.split(key, 20)
    D = D_MODEL
    nrm = lambda k, shape, s: jax.random.normal(k, shape, jnp.float32) * s
    return {
        "x": nrm(ks[0], (BATCH, SEQ, D), 1.0),
        "c": nrm(ks[1], (BATCH, D), 1.0),
        "w_ada": nrm(ks[2], (DEPTH, D, 6 * D), D ** -0.5),
        "b_ada": nrm(ks[3], (DEPTH, 6 * D), 0.02),
        "norm1_g": 1.0 + nrm(ks[4], (DEPTH, D), 0.05),
        "w_in": nrm(ks[5], (DEPTH, D, IN_COLS), D ** -0.5),
        "b_fgate": jnp.linspace(1.0, 4.0, N_FOX_HEADS, dtype=jnp.float32)[None, :] + nrm(ks[6], (DEPTH, N_FOX_HEADS), 0.1),
        "fox_q_g": 1.0 + nrm(ks[7], (DEPTH, HEAD_DIM), 0.05),
        "fox_k_g": 1.0 + nrm(ks[8], (DEPTH, HEAD_DIM), 0.05),
        "moba_q_g": 1.0 + nrm(ks[9], (DEPTH, HEAD_DIM), 0.05),
        "moba_k_g": 1.0 + nrm(ks[10], (DEPTH, HEAD_DIM), 0.05),
        "w_up_fox": nrm(ks[11], (DEPTH, FOX_WIDTH, D), FOX_WIDTH ** -0.5),
        "w_up_moba": nrm(ks[12], (DEPTH, MOBA_WIDTH, D), MOBA_WIDTH ** -0.5),
        "w_out": nrm(ks[13], (DEPTH, D, D), D ** -0.5),
        "norm2_g": 1.0 + nrm(ks[14], (DEPTH, D), 0.05),
        "w_peer_q": nrm(ks[15], (DEPTH, D, PEER_HEADS * PEER_QUERY_DIM), D ** -0.5),
        "peer_sub_keys": nrm(ks[16], (DEPTH, PEER_HEADS, 2, PEER_N_KEYS, PEER_HALF), PEER_HALF ** -0.5),
        "peer_u": nrm(ks[17], (DEPTH, PEER_N_EXPERTS, D), D ** -0.5),
        "peer_v": nrm(ks[18], (DEPTH, PEER_N_EXPERTS, D), (PEER_HEADS * PEER_TOPK) ** -0.5),
    }


def reference(x, c, w_ada, b_ada, norm1_g, w_in, b_fgate, fox_q_g, fox_k_g, moba_q_g, moba_k_g,
              w_up_fox, w_up_moba, w_out, norm2_g, w_peer_q, peer_sub_keys, peer_u, peer_v):
    B, S, D = x.shape
    slopes = 2.0 ** (-8.0 * jnp.arange(1, N_MOBA_HEADS + 1, dtype=jnp.float32) / N_MOBA_HEADS)
    split_at = list(np.cumsum([FOX_WIDTH, FOX_WIDTH, FOX_WIDTH, N_FOX_HEADS,
                               MOBA_WIDTH, MOBA_WIDTH, MOBA_WIDTH, D_MODEL]))

    def heads(t, n_h):
        return t.reshape(B, S, n_h, HEAD_DIM).transpose(0, 2, 1, 3)

    def merge_heads(t):
        return t.transpose(0, 2, 1, 3).reshape(B, S, -1)

    silu_c = jax.nn.silu(c)
    for l in range(DEPTH):
        mod = (silu_c @ w_ada[l] + b_ada[l])[:, None, :]
        shift1, scale1, gate1, shift2, scale2, gate2 = jnp.split(mod, 6, axis=-1)

        h = rms_norm(x, norm1_g[l]) * (1.0 + scale1) + shift1
        z = h @ w_in[l]
        q_a, k_a, v_a, f_a, q_b, k_b, v_b, g_a, g_b = jnp.split(z, split_at, axis=-1)

        q_a = rms_norm(heads(q_a, N_FOX_HEADS), fox_q_g[l])
        k_a = rms_norm(heads(k_a, N_FOX_HEADS), fox_k_g[l])
        log_f = jax.nn.log_sigmoid((f_a + b_fgate[l]).astype(jnp.float32)).transpose(0, 2, 1)
        y_a = merge_heads(fox_attention(q_a, k_a, heads(v_a, N_FOX_HEADS), log_f))

        q_b = rms_norm(heads(q_b, N_MOBA_HEADS), moba_q_g[l])
        k_b = rms_norm(heads(k_b, N_MOBA_HEADS), moba_k_g[l])
        y_b = merge_heads(moba_attention(q_b, k_b, heads(v_b, N_MOBA_HEADS), slopes))

        mixed = jax.nn.sigmoid(g_a) * (y_a @ w_up_fox[l]) + jax.nn.sigmoid(g_b) * (y_b @ w_up_moba[l])
        x = x + gate1 * (mixed @ w_out[l])

        h2 = rms_norm(x, norm2_g[l]) * (1.0 + scale2) + shift2
        x = x + gate2 * peer_ffn(h2, w_peer_q[l], peer_sub_keys[l], peer_u[l], peer_v[l])
    return x
```

```cpp
#include <hip/hip_runtime.h>
#include <hip/hip_bf16.h>
#include <cstdio>
#include <cstdint>
#include <cmath>

#ifndef MK_PER_PHASE
#define MK_PER_PHASE 0
#endif

constexpr int NB = 8, SEQ = 2048, DM = 1024, NTOK = NB * SEQ, NHEAD = 8, HDIM = 64;
constexpr int IN_COLS = 5128, NIN = 5120, NSC = 2048, NEXP = 16384;
constexpr float RMS_EPS = 1e-6f;
constexpr float LOG2E = 1.4426950408889634f;
constexpr float QSCALE = 0.125f * LOG2E;

namespace pg8 {
#define PG8_LAS __attribute__((address_space(3)))
typedef unsigned short bf16_t;
typedef short bf16x8 __attribute__((ext_vector_type(8)));
typedef float f32x4 __attribute__((ext_vector_type(4)));
typedef unsigned u32x4 __attribute__((ext_vector_type(4)));
constexpr int BM = 256, BK = 64, HALF = 128, HTB = HALF * BK * 2  , STAGE_BYTES = 8 * HTB, NXCD = 8, WGM = 8;

__host__ __device__ __forceinline__ int lds_byte(int r, int c) { const int st = (r >> 4) * 2 + (c >> 5), rr = r & 15, cc = c & 31, ob = rr * 64 + cc * 2; return st * 1024 + (ob ^ (((ob >> 9) & 1) << 5)); }
__host__ __device__ __forceinline__ void stage_rc(int b, int& R, int& C) { const int st = b / 1024, sb = b % 1024, swz = sb ^ (((sb >> 9) & 1) << 5); R = (st >> 1) * 16 + swz / 64; C = (st & 1) * 32 + (swz % 64) / 2; }
__host__ __device__ __forceinline__ int perm32(int rho) { const int n = rho >> 4, i = rho & 15; return 8 * (i >> 2) + 4 * n + (i & 3); }

struct Unit { int pm, pn; };
struct Gemm { const bf16_t* A; const bf16_t* Bt; int M, N, K, lda, ldb; };

struct StaticOrder {
    int nM, nN, nwg, G, c;
    __host__ __device__ void init(int M, int N, int G_, int c_) { nM = M / BM; nN = N / BM; nwg = nM * nN; G = G_; c = c_; }
    __host__ __device__ bool next(int i, Unit& u) const {
        const long L = (long)i * G + c; if (L >= nwg) return false;
        int wgid = (int)L; { const int q = nwg / NXCD, r = nwg % NXCD, xcd = wgid % NXCD, off = wgid / NXCD; wgid = (xcd < r ? xcd * (q + 1) : r * (q + 1) + (xcd - r) * q) + off; }
        const int nig = WGM * nN, gid = wgid / nig, fm = gid * WGM, gsz = (nM - fm) < WGM ? (nM - fm) : WGM;
        u.pm = fm + ((wgid % nig) % gsz); u.pn = (wgid % nig) / gsz; return true;
    }
    __device__ __forceinline__ void a_ready(const Unit&) const {}
    __device__ __forceinline__ void done(const Unit&) const {}
};

__device__ __forceinline__ unsigned cvt_pk_bf16(float lo, float hi) { unsigned r; asm volatile("v_cvt_pk_bf16_f32 %0, %1, %2" : "=v"(r) : "v"(lo), "v"(hi)); return r; }
__device__ __forceinline__ float bf_lo(unsigned w) { return __uint_as_float(w << 16); }
__device__ __forceinline__ float bf_hi(unsigned w) { return __uint_as_float(w & 0xffff0000u); }
__device__ __forceinline__ float sigmoidf_(float x) { return 1.0f / (1.0f + __expf(-x)); }

struct EpiIn {
    static constexpr bool PERM = true, AFTER_DRAIN = false;
    bf16_t* qkv;
    bf16_t* G;
    const float* gains;
    float* kmean;
    __device__ __forceinline__ void operator()(const f32x4 (&acc)[2][2][4][2], const Unit& u, int wr, int wc, int fr, int fq) const {
        const int pn = u.pn;
        if (pn < 12) {
            const int sec = pn >> 1, head = (pn & 1) * 4 + wc;
            const bool isq = (sec == 0 || sec == 3), isk = (sec == 1 || sec == 4);
            const float* gp = gains + ((sec >= 3 ? sec - 1 : sec) & 3) * 64;
            f32x4 gv[2][2];
#pragma unroll
            for (int bj = 0; bj < 2; ++bj)
#pragma unroll
                for (int n = 0; n < 2; ++n) { gv[bj][n] = (f32x4){1.f, 1.f, 1.f, 1.f}; if (isq || isk) gv[bj][n] = *(const f32x4*)(gp + 32 * bj + 8 * fq + 4 * n) * (isq ? QSCALE : 1.0f); }
            bf16_t* base = qkv + (size_t)sec * ((size_t)NTOK * 512);
            f32x4 cs[2][2];
#pragma unroll
            for (int bj = 0; bj < 2; ++bj)
#pragma unroll
                for (int n = 0; n < 2; ++n) cs[bj][n] = (f32x4){0.f, 0.f, 0.f, 0.f};
#pragma unroll
            for (int ai = 0; ai < 2; ++ai)
#pragma unroll
                for (int m = 0; m < 4; ++m) {
                    const int row = u.pm * BM + ai * HALF + wr * 64 + m * 16 + fr; const int b = row >> 11, s = row & 2047;
                    f32x4 v[2][2];
#pragma unroll
                    for (int bj = 0; bj < 2; ++bj)
#pragma unroll
                        for (int n = 0; n < 2; ++n) v[bj][n] = acc[ai][bj][m][n];
                    if (isq || isk) {
                        float ss = 0.f;
#pragma unroll
                        for (int bj = 0; bj < 2; ++bj)
#pragma unroll
                            for (int n = 0; n < 2; ++n) { const f32x4 x = v[bj][n]; ss += (x[0] * x[0] + x[1] * x[1]) + (x[2] * x[2] + x[3] * x[3]); }
                        ss += __shfl_xor(ss, 16); ss += __shfl_xor(ss, 32);
                        const float rstd = rsqrtf(ss * (1.0f / 64.0f) + RMS_EPS);
#pragma unroll
                        for (int bj = 0; bj < 2; ++bj)
#pragma unroll
                            for (int n = 0; n < 2; ++n) v[bj][n] = v[bj][n] * rstd * gv[bj][n];
                    }
                    if (sec == 4) {
#pragma unroll
                        for (int bj = 0; bj < 2; ++bj)
#pragma unroll
                            for (int n = 0; n < 2; ++n) cs[bj][n] += v[bj][n];
                    }
                    bf16_t* dst = base + ((size_t)(b * NHEAD + head) * SEQ + s) * HDIM + 8 * fq;
#pragma unroll
                    for (int bj = 0; bj < 2; ++bj) { u32x4 w; w.x = cvt_pk_bf16(v[bj][0][0], v[bj][0][1]); w.y = cvt_pk_bf16(v[bj][0][2], v[bj][0][3]); w.z = cvt_pk_bf16(v[bj][1][0], v[bj][1][1]); w.w = cvt_pk_bf16(v[bj][1][2], v[bj][1][3]);
                        *(u32x4*)(dst + 32 * bj) = w; }
                }
            if (sec == 4) {
                const int b = (u.pm * BM) >> 11, blk = u.pm & 7;
                float* km = kmean + ((size_t)(b * NHEAD + head) * 8 + blk) * HDIM + 8 * fq;
#pragma unroll
                for (int bj = 0; bj < 2; ++bj)
#pragma unroll
                    for (int n = 0; n < 2; ++n)
#pragma unroll
                        for (int e = 0; e < 4; ++e) { float x = cs[bj][n][e]; x += __shfl_xor(x, 1); x += __shfl_xor(x, 2); x += __shfl_xor(x, 4); x += __shfl_xor(x, 8);
                            if (fr == 0) atomicAdd(km + 32 * bj + 4 * n + e, x * (1.0f / 256.0f)); }
            }
        } else {
            const int gc0 = (pn - 12) * 256 + 64 * wc + 8 * fq;
#pragma unroll
            for (int ai = 0; ai < 2; ++ai)
#pragma unroll
                for (int m = 0; m < 4; ++m) {
                    const int row = u.pm * BM + ai * HALF + wr * 64 + m * 16 + fr;
                    bf16_t* dst = G + (size_t)row * 2048 + gc0;
#pragma unroll
                    for (int bj = 0; bj < 2; ++bj) { const f32x4 a = acc[ai][bj][m][0], c = acc[ai][bj][m][1]; u32x4 w;
                        w.x = cvt_pk_bf16(sigmoidf_(a[0]), sigmoidf_(a[1])); w.y = cvt_pk_bf16(sigmoidf_(a[2]), sigmoidf_(a[3])); w.z = cvt_pk_bf16(sigmoidf_(c[0]), sigmoidf_(c[1])); w.w = cvt_pk_bf16(sigmoidf_(c[2]), sigmoidf_(c[3]));
                        *(u32x4*)(dst + 32 * bj) = w; }
                }
        }
    }
};

template <int SECOND> struct EpiUp {
    static constexpr bool PERM = true, AFTER_DRAIN = false;
    const bf16_t* G; bf16_t* MIX;
    __device__ __forceinline__ void operator()(const f32x4 (&acc)[2][2][4][2], const Unit& u, int wr, int wc, int fr, int fq) const {
        const int col0 = u.pn * BM + wc * 32 + 8 * fq;
#pragma unroll
        for (int ai = 0; ai < 2; ++ai)
#pragma unroll
            for (int m = 0; m < 4; ++m) {
                const int row = u.pm * BM + ai * HALF + wr * 64 + m * 16 + fr;
#pragma unroll
                for (int bj = 0; bj < 2; ++bj) {
                    const int col = col0 + bj * HALF;
                    const u32x4 g = *(const u32x4*)(G + (size_t)row * 2048 + SECOND * 1024 + col);
                    const f32x4 a = acc[ai][bj][m][0], c = acc[ai][bj][m][1];
                    float v[8] = {a[0] * bf_lo(g.x), a[1] * bf_hi(g.x), a[2] * bf_lo(g.y), a[3] * bf_hi(g.y), c[0] * bf_lo(g.z), c[1] * bf_hi(g.z), c[2] * bf_lo(g.w), c[3] * bf_hi(g.w)};
                    bf16_t* p = MIX + (size_t)row * 1024 + col;
                    if (SECOND) { const u32x4 o = __builtin_nontemporal_load((const u32x4*)p);
                        v[0] += bf_lo(o.x); v[1] += bf_hi(o.x); v[2] += bf_lo(o.y); v[3] += bf_hi(o.y); v[4] += bf_lo(o.z); v[5] += bf_hi(o.z); v[6] += bf_lo(o.w); v[7] += bf_hi(o.w); }
                    u32x4 w; w.x = cvt_pk_bf16(v[0], v[1]); w.y = cvt_pk_bf16(v[2], v[3]); w.z = cvt_pk_bf16(v[4], v[5]); w.w = cvt_pk_bf16(v[6], v[7]);
                    *(u32x4*)p = w;
                }
            }
    }
};

struct EpiOut {
    static constexpr bool PERM = true, AFTER_DRAIN = false;
    const float* x; const float* mod; float* out; float* parts;
    __device__ __forceinline__ void operator()(const f32x4 (&acc)[2][2][4][2], const Unit& u, int wr, int wc, int fr, int fq) const {
        const int col0 = u.pn * BM + wc * 32 + 8 * fq;
        const int b = (u.pm * BM) >> 11;
        const float* g1 = mod + (size_t)b * 6144 + 2048;
        f32x4 gt[2][2];
#pragma unroll
        for (int bj = 0; bj < 2; ++bj)
#pragma unroll
            for (int n = 0; n < 2; ++n) gt[bj][n] = *(const f32x4*)(g1 + col0 + bj * HALF + 4 * n);
#pragma unroll
        for (int ai = 0; ai < 2; ++ai)
#pragma unroll
            for (int m = 0; m < 4; ++m) {
                const int row = u.pm * BM + ai * HALF + wr * 64 + m * 16 + fr; const size_t off = (size_t)row * 1024 + col0;
                float ss = 0.f;
#pragma unroll
                for (int bj = 0; bj < 2; ++bj)
#pragma unroll
                    for (int n = 0; n < 2; ++n) { const f32x4 xv = *(const f32x4*)(x + off + bj * HALF + 4 * n); const f32x4 o = xv + gt[bj][n] * acc[ai][bj][m][n];
                        ss += (o[0] * o[0] + o[1] * o[1]) + (o[2] * o[2] + o[3] * o[3]); *(f32x4*)(out + off + bj * HALF + 4 * n) = o; }
                ss += __shfl_xor(ss, 16); ss += __shfl_xor(ss, 32);
                if (fq == 0) parts[(size_t)row * 16 + u.pn * 4 + wc] = ss;
            }
    }
};

struct EpiSc {
    static constexpr bool PERM = true, AFTER_DRAIN = false;
    float* SC;
    __device__ __forceinline__ void operator()(const f32x4 (&acc)[2][2][4][2], const Unit& u, int wr, int wc, int fr, int fq) const {
        const int col0 = u.pn * BM + wc * 32 + 8 * fq;
#pragma unroll
        for (int ai = 0; ai < 2; ++ai)
#pragma unroll
            for (int m = 0; m < 4; ++m) {
                const int row = u.pm * BM + ai * HALF + wr * 64 + m * 16 + fr; const size_t off = (size_t)row * 2048 + col0;
#pragma unroll
                for (int bj = 0; bj < 2; ++bj)
#pragma unroll
                    for (int n = 0; n < 2; ++n) *(f32x4*)(SC + off + bj * HALF + 4 * n) = acc[ai][bj][m][n];
            }
    }
};

template <class Epi, class Sched, bool ALIGN_EPI = false, bool SP2 = false>
__device__ __forceinline__ void gemm_phase(PG8_LAS unsigned char* lds, const Gemm g, const Sched& S, const Epi& E) {
    const int tid = threadIdx.x, wid = __builtin_amdgcn_readfirstlane(tid >> 6), lane = tid & 63, wr = wid >> 2, wc = wid & 3, fr = lane & 15, fq = lane >> 4;
    const int K = g.K, nt = K / BK;
    unsigned voffA[2], voffB[2];
#pragma unroll
    for (int i = 0; i < 2; ++i) { int R, C; stage_rc(tid * 16 + i * 8192, R, C); const int Rb = Epi::PERM ? ((R & ~31) + perm32(R & 31)) : R;
        voffA[i] = (unsigned)(R * g.lda + C) * 2u; voffB[i] = (unsigned)(Rb * g.ldb + C) * 2u; }
    const size_t kstep = (size_t)(BK * 2);
    const size_t hstepA = (size_t)HALF * g.lda * 2, hstepB = (size_t)HALF * g.ldb * 2;
    const size_t tstepA = 2 * hstepA, tstepB = 2 * hstepB;
    const unsigned ldsw = (unsigned)wid * 1024u;
    const int aoff = lds_byte(wr * 64 + fr, fq * 8), boff = lds_byte(wc * 32 + fr, fq * 8);
#define PG8_SA(b, h) (((b) * 2 + (h)) * HTB)
#define PG8_SB(b, h) ((4 + (b) * 2 + (h)) * HTB)
#define PG8_STAGE(bufoff, gbase, voff) do { _Pragma("unroll") for (int _i = 0; _i < 2; ++_i) \
        __builtin_amdgcn_global_load_lds((const unsigned*)((const char*)(gbase) + (voff)[_i]), (PG8_LAS unsigned*)(lds + (bufoff) + ldsw + _i * 8192), 16, 0, 0); } while (0)
#define PG8_LDA(dst, b, h) do { _Pragma("unroll") for (int m = 0; m < 4; ++m) _Pragma("unroll") for (int k = 0; k < 2; ++k) dst[m][k] = *(const PG8_LAS bf16x8*)(lds + PG8_SA(b, h) + aoff + m * 2048 + k * 1024); } while (0)
#define PG8_LDB(dst, b, h) do { _Pragma("unroll") for (int n = 0; n < 2; ++n) _Pragma("unroll") for (int k = 0; k < 2; ++k) dst[n][k] = *(const PG8_LAS bf16x8*)(lds + PG8_SB(b, h) + boff + n * 2048 + k * 1024); } while (0)
#define PG8_MMA(ai, bj, At, Bt) do { __builtin_amdgcn_s_setprio(1); _Pragma("unroll") for (int m = 0; m < 4; ++m) _Pragma("unroll") for (int n = 0; n < 2; ++n) _Pragma("unroll") for (int k = 0; k < 2; ++k) \
        acc[ai][bj][m][n] = __builtin_amdgcn_mfma_f32_16x16x32_bf16(Bt[n][k], At[m][k], acc[ai][bj][m][n], 0, 0, 0); __builtin_amdgcn_s_setprio(0); } while (0)
#define PG8_WAIT_V(n) asm volatile("s_waitcnt vmcnt(" #n ")" ::: "memory")
#define PG8_WAIT_L(n) asm volatile("s_waitcnt lgkmcnt(" #n ")" ::: "memory")
#define PG8_BAR __builtin_amdgcn_s_barrier()
#define PG8_SCHED __builtin_amdgcn_sched_barrier(0)
    Unit cur, nxt; int ui = 0;
    if (!S.next(0, cur)) return;
    f32x4 acc[2][2][4][2];
#pragma unroll
    for (int a = 0; a < 2; ++a)
#pragma unroll
        for (int b = 0; b < 2; ++b)
#pragma unroll
            for (int m = 0; m < 4; ++m)
#pragma unroll
                for (int n = 0; n < 2; ++n) acc[a][b][m][n] = (f32x4){0.f, 0.f, 0.f, 0.f};
    bf16x8 At[4][2], B0[2][2], B1[2][2];
    const char* cA = (const char*)g.A + (size_t)cur.pm * tstepA; const char* cB = (const char*)g.Bt + (size_t)cur.pn * tstepB;
    S.a_ready(cur);
    if constexpr (SP2) {
        PG8_STAGE(PG8_SB(0, 0), cB, voffB); PG8_STAGE(PG8_SB(0, 1), cB + hstepB, voffB); PG8_STAGE(PG8_SA(0, 0), cA, voffA); PG8_STAGE(PG8_SA(0, 1), cA + hstepA, voffA);
        if (wr == 1) PG8_BAR;
        PG8_WAIT_V(2); PG8_BAR;
        PG8_STAGE(PG8_SB(1, 0), cB + kstep, voffB); PG8_STAGE(PG8_SA(1, 0), cA + kstep, voffA); PG8_STAGE(PG8_SB(1, 1), cB + hstepB + kstep, voffB);
        PG8_WAIT_V(6); PG8_BAR;
    } else {
        PG8_STAGE(PG8_SB(0, 0), cB, voffB); PG8_STAGE(PG8_SA(0, 0), cA, voffA); PG8_STAGE(PG8_SB(0, 1), cB + hstepB, voffB); PG8_STAGE(PG8_SA(0, 1), cA + hstepA, voffA);
        if (wr == 1) PG8_BAR;
        PG8_WAIT_V(4); PG8_BAR;
        PG8_STAGE(PG8_SB(1, 0), cB + kstep, voffB); PG8_STAGE(PG8_SA(1, 0), cA + kstep, voffA); PG8_STAGE(PG8_SB(1, 1), cB + hstepB + kstep, voffB);
        PG8_WAIT_V(6); PG8_BAR;
    }
    for (;;) {
        const bool has_next = S.next(ui + 1, nxt);
        const char* nA = has_next ? (const char*)g.A + (size_t)nxt.pm * tstepA : cA; const char* nB = has_next ? (const char*)g.Bt + (size_t)nxt.pn * tstepB : cB;
        for (int t = 0; t < nt; t += 2) {
            const bool last = (t == nt - 2);
            const char* a1 = cA + (size_t)(t + 1) * kstep;
            const char* a2 = last ? nA : cA + (size_t)(t + 2) * kstep; const char* b2 = last ? nB : cB + (size_t)(t + 2) * kstep;
            const char* a3 = a2 + kstep; const char* b3 = b2 + kstep;
            if (last && has_next) S.a_ready(nxt);
            if constexpr (SP2) {
            PG8_LDB(B0, 0, 0); PG8_LDB(B1, 0, 1); PG8_SCHED; PG8_LDA(At, 0, 0); PG8_STAGE(PG8_SA(1, 1), a1 + hstepA, voffA);
            PG8_WAIT_V(8); PG8_WAIT_L(0); PG8_BAR; PG8_MMA(0, 0, At, B0); PG8_MMA(0, 1, At, B1); PG8_BAR; PG8_SCHED;
            PG8_LDA(At, 0, 1); PG8_STAGE(PG8_SB(0, 0), b2, voffB); PG8_STAGE(PG8_SB(0, 1), b2 + hstepB, voffB); PG8_STAGE(PG8_SA(0, 0), a2, voffA);
            PG8_WAIT_V(8); PG8_WAIT_L(0); PG8_BAR; PG8_MMA(1, 0, At, B0); PG8_MMA(1, 1, At, B1); PG8_BAR; PG8_SCHED;
            PG8_LDB(B0, 1, 0); PG8_LDB(B1, 1, 1); PG8_SCHED; PG8_LDA(At, 1, 0); PG8_STAGE(PG8_SA(0, 1), a2 + hstepA, voffA);
            PG8_WAIT_V(8); PG8_WAIT_L(0); PG8_BAR; PG8_MMA(0, 0, At, B0); PG8_MMA(0, 1, At, B1); PG8_BAR; PG8_SCHED;
            PG8_LDA(At, 1, 1); PG8_STAGE(PG8_SB(1, 0), b3, voffB); PG8_STAGE(PG8_SB(1, 1), b3 + hstepB, voffB); PG8_STAGE(PG8_SA(1, 0), a3, voffA);
            PG8_WAIT_V(8); PG8_WAIT_L(0); PG8_BAR; PG8_MMA(1, 0, At, B0); PG8_MMA(1, 1, At, B1); PG8_BAR; PG8_SCHED;
            } else {
            PG8_LDB(B0, 0, 0); PG8_SCHED; PG8_LDA(At, 0, 0); PG8_STAGE(PG8_SA(1, 1), a1 + hstepA, voffA);
            PG8_WAIT_L(8); PG8_BAR; PG8_WAIT_L(0); PG8_MMA(0, 0, At, B0); PG8_BAR; PG8_SCHED;
            PG8_LDB(B1, 0, 1); PG8_STAGE(PG8_SB(0, 0), b2, voffB);
            PG8_BAR; PG8_WAIT_L(0); PG8_MMA(0, 1, At, B1); PG8_BAR;
            PG8_LDA(At, 0, 1); PG8_STAGE(PG8_SA(0, 0), a2, voffA);
            PG8_BAR; PG8_WAIT_L(0); PG8_MMA(1, 0, At, B0); PG8_BAR; PG8_SCHED;
            PG8_STAGE(PG8_SB(0, 1), b2 + hstepB, voffB);
            PG8_WAIT_V(6); PG8_BAR; PG8_MMA(1, 1, At, B1); PG8_BAR;
            PG8_LDB(B0, 1, 0); PG8_SCHED; PG8_LDA(At, 1, 0); PG8_STAGE(PG8_SA(0, 1), a2 + hstepA, voffA);
            PG8_WAIT_L(8); PG8_BAR; PG8_WAIT_L(0); PG8_MMA(0, 0, At, B0); PG8_BAR; PG8_SCHED;
            PG8_LDB(B1, 1, 1); PG8_STAGE(PG8_SB(1, 0), b3, voffB);
            PG8_BAR; PG8_WAIT_L(0); PG8_MMA(0, 1, At, B1); PG8_BAR;
            PG8_LDA(At, 1, 1); PG8_STAGE(PG8_SA(1, 0), a3, voffA);
            PG8_BAR; PG8_WAIT_L(0); PG8_MMA(1, 0, At, B0); PG8_BAR; PG8_SCHED;
            PG8_STAGE(PG8_SB(1, 1), b3 + hstepB, voffB);
            PG8_WAIT_V(6); PG8_BAR; PG8_MMA(1, 1, At, B1); PG8_BAR;
            }
        }
        if constexpr (ALIGN_EPI) { if (wr == 0) PG8_BAR; }
        if constexpr (!Epi::AFTER_DRAIN) { E(acc, cur, wr, wc, fr, fq); S.done(cur); }
        if (!has_next) break;
#pragma unroll
        for (int a = 0; a < 2; ++a)
#pragma unroll
            for (int b = 0; b < 2; ++b)
#pragma unroll
                for (int m = 0; m < 4; ++m)
#pragma unroll
                    for (int n = 0; n < 2; ++n) acc[a][b][m][n] = (f32x4){0.f, 0.f, 0.f, 0.f};
        cur = nxt; cA = nA; cB = nB; ++ui;
        if constexpr (ALIGN_EPI) { if (wr == 1) PG8_BAR; }
    }
    PG8_WAIT_V(0);
    if constexpr (!ALIGN_EPI) { if (wr == 0) PG8_BAR; }
    PG8_BAR;
    if constexpr (Epi::AFTER_DRAIN) { E.fused(acc, cur, wr, wc, fr, fq, lds, wid, lane); S.done(cur); }
#undef PG8_SA
#undef PG8_SB
#undef PG8_STAGE
#undef PG8_LDA
#undef PG8_LDB
#undef PG8_MMA
#undef PG8_WAIT_V
#undef PG8_WAIT_L
#undef PG8_BAR
#undef PG8_SCHED
}
}

namespace att {
#define ALAS __attribute__((address_space(3)))
typedef unsigned short bf16_t;
typedef short bf16x8 __attribute__((ext_vector_type(8)));
typedef short s16x4 __attribute__((ext_vector_type(4)));
typedef short v4i16_t __attribute__((ext_vector_type(4)));
typedef float f32x16 __attribute__((ext_vector_type(16)));
typedef float f32x4 __attribute__((ext_vector_type(4)));
typedef unsigned u32x4 __attribute__((ext_vector_type(4)));
constexpr int L_K = 0, L_V = 16384, L_KB = 32768, L_WSF = 40960, L_KM = 43008, L_STG = 45056, L_END = L_STG + 8 * 4096;
__device__ __forceinline__ s16x4 vtr(const ALAS char* p) { return __builtin_bit_cast(s16x4, __builtin_amdgcn_ds_read_tr16_b64_v4i16((ALAS v4i16_t*)p)); }
__device__ __forceinline__ unsigned cvtpk(float lo, float hi) { typedef float f2 __attribute__((ext_vector_type(2))); typedef __bf16 b2 __attribute__((ext_vector_type(2))); f2 v = {lo, hi}; b2 b = __builtin_convertvector(v, b2); return __builtin_bit_cast(unsigned, b); }
__device__ __forceinline__ float swap32f(float v) { return __shfl_xor(v, 32); }

template <int TYPE>
__device__ __forceinline__ void attn_unit(int b, int h, int qb, const bf16_t* Q, const bf16_t* K, const bf16_t* V, const float* Fcum, const float* kmean, bf16_t* Y, ALAS char* lds) {
    const int tid = threadIdx.x, lane = tid & 63, r32 = lane & 31, hi = lane >> 5; const int wid = __builtin_amdgcn_readfirstlane(tid >> 6);
    const size_t headbase = (size_t)(b * NHEAD + h) * SEQ * HDIM;
    const char* Kh = (const char*)(K + headbase); const char* Vh = (const char*)(V + headbase); const bf16_t* Qh = Q + headbase;
    const int q0 = qb * 256, NT = 4 * (qb + 1);
    ALAS float* kbias = (ALAS float*)(lds + L_KB);
    ALAS float* wsf = (ALAS float*)(lds + L_WSF) + wid * 64;
    ALAS float* km = (ALAS float*)(lds + L_KM);
    {
        const float slope = exp2f(-(float)(h + 1));
        for (int s = tid; s < q0 + 256; s += 512) kbias[s] = (TYPE == 0) ? (-Fcum[(size_t)(b * NHEAD + h) * SEQ + s] * LOG2E) : (slope * (float)s * LOG2E);
        if (TYPE == 1) km[tid] = kmean[(size_t)(b * NHEAD + h) * 512 + tid];
    }
    bf16x8 qr[4];
    { const bf16_t* qrow = Qh + (size_t)(q0 + wid * 32 + r32) * HDIM;
#pragma unroll
      for (int d0 = 0; d0 < 4; ++d0) qr[d0] = *(const bf16x8*)(qrow + d0 * 16 + hi * 8); }
    const int koff = lane * 128 + wid * 16;
    const int voff = (16 * (wid & 3) + (lane >> 2)) * 128 + (wid >> 2) * 64 + (lane & 3) * 16;
    const int ldst = wid * 1024 + lane * 16;
    u32x4 kreg = *(const u32x4*)(Kh + koff), vreg = *(const u32x4*)(Vh + voff);
    *(ALAS u32x4*)(lds + L_K + ldst) = kreg; *(ALAS u32x4*)(lds + L_V + ldst) = vreg;
    if (NT > 1) { kreg = *(const u32x4*)(Kh + 8192 + koff); vreg = *(const u32x4*)(Vh + 8192 + voff); }
    __syncthreads();
    unsigned sel = 0xffu;
    if (TYPE == 1) {
        float gate[7];
#pragma unroll
        for (int jb = 0; jb < 7; ++jb) {
            float g = 0.f;
#pragma unroll
            for (int d0 = 0; d0 < 4; ++d0) {
                const f32x4 k0 = *(const ALAS f32x4*)(km + jb * 64 + d0 * 16 + hi * 8), k1 = *(const ALAS f32x4*)(km + jb * 64 + d0 * 16 + hi * 8 + 4);
#pragma unroll
                for (int e = 0; e < 4; ++e) { g += __uint_as_float((unsigned)(unsigned short)qr[d0][e] << 16) * k0[e]; g += __uint_as_float((unsigned)(unsigned short)qr[d0][4 + e] << 16) * k1[e]; }
            }
            gate[jb] = g + swap32f(g);
        }
        if (qb <= 3) sel = (1u << qb) - 1u;
        else { sel = 0u;
#pragma unroll
            for (int it = 0; it < 3; ++it) { float best = -INFINITY; int bi = 0;
#pragma unroll
                for (int jb = 0; jb < 7; ++jb) { const bool ok = (jb < qb) && !((sel >> jb) & 1u) && (gate[jb] > best); best = ok ? gate[jb] : best; bi = ok ? jb : bi; }
                sel |= 1u << bi; } }
    }
    float m_run = -1e30f, l_run = 0.f; f32x16 o[2]; o[0] = f32x16{}; o[1] = f32x16{};
    const int qrel = wid * 32 + r32;
    for (int t = 0; t < NT; ++t) {
        const int buf = t & 1, jband = t - (NT - 4);
        bool active = true;
        if (jband >= 0) active = (64 * jband <= wid * 32 + 31);
        else if (TYPE == 1) active = __any((int)((sel >> (t >> 2)) & 1u)) != 0;
        if (active) {
            f32x16 p0 = f32x16{}, p1 = f32x16{};
            { const ALAS char* kb = lds + L_K + buf * 8192 + hi * 1024 + r32 * 16;
#pragma unroll
              for (int d0 = 0; d0 < 4; ++d0) { const bf16x8 b0 = *(const ALAS bf16x8*)(kb + d0 * 2048), b1 = *(const ALAS bf16x8*)(kb + d0 * 2048 + 512);
                  p0 = __builtin_amdgcn_mfma_f32_32x32x16_bf16(b0, qr[d0], p0, 0, 0, 0); p1 = __builtin_amdgcn_mfma_f32_32x32x16_bf16(b1, qr[d0], p1, 0, 0, 0); } }
            { const ALAS float* kbt = kbias + 64 * t + 4 * hi;
#pragma unroll
              for (int rq = 0; rq < 4; ++rq) { const f32x4 b0 = *(const ALAS f32x4*)(kbt + 8 * rq), b1 = *(const ALAS f32x4*)(kbt + 32 + 8 * rq);
#pragma unroll
                  for (int e = 0; e < 4; ++e) { p0[4 * rq + e] += b0[e]; p1[4 * rq + e] += b1[e]; } } }
            if (jband >= 0) { const int kb0 = 64 * jband + 4 * hi;
#pragma unroll
                for (int r = 0; r < 16; ++r) { const int kv = kb0 + (r & 3) + 8 * (r >> 2); if (kv > qrel) p0[r] = -INFINITY; if (kv + 32 > qrel) p1[r] = -INFINITY; } }
            else if (TYPE == 1) { if (!((sel >> (t >> 2)) & 1u)) {
#pragma unroll
                for (int r = 0; r < 16; ++r) { p0[r] = -INFINITY; p1[r] = -INFINITY; } } }
            float rm = fmaxf(p0[0], p1[0]);
#pragma unroll
            for (int r = 1; r < 16; ++r) rm = fmaxf(rm, fmaxf(p0[r], p1[r]));
            rm = fmaxf(rm, swap32f(rm));
            const float mn = fmaxf(m_run, rm), alpha = __builtin_amdgcn_exp2f(m_run - mn); m_run = mn;
            float rs = 0.f;
#pragma unroll
            for (int r = 0; r < 16; ++r) { p0[r] = __builtin_amdgcn_exp2f(p0[r] - mn); p1[r] = __builtin_amdgcn_exp2f(p1[r] - mn); rs += p0[r] + p1[r]; }
            l_run = l_run * alpha + rs;
            if (__any(alpha != 1.0f)) {
                if (hi == 0) wsf[r32] = alpha;
                asm volatile("s_waitcnt lgkmcnt(0)" ::: "memory");
#pragma unroll
                for (int rq = 0; rq < 4; ++rq) { const f32x4 a4 = *(const ALAS f32x4*)(wsf + 8 * rq + 4 * hi);
#pragma unroll
                    for (int e = 0; e < 4; ++e) { o[0][4 * rq + e] *= a4[e]; o[1][4 * rq + e] *= a4[e]; } }
                asm volatile("s_waitcnt lgkmcnt(0)" ::: "memory");
            }
            u32x4 pw[4];
            pw[0] = (u32x4){cvtpk(p0[0], p0[1]), cvtpk(p0[2], p0[3]), cvtpk(p0[4], p0[5]), cvtpk(p0[6], p0[7])};
            pw[1] = (u32x4){cvtpk(p0[8], p0[9]), cvtpk(p0[10], p0[11]), cvtpk(p0[12], p0[13]), cvtpk(p0[14], p0[15])};
            pw[2] = (u32x4){cvtpk(p1[0], p1[1]), cvtpk(p1[2], p1[3]), cvtpk(p1[4], p1[5]), cvtpk(p1[6], p1[7])};
            pw[3] = (u32x4){cvtpk(p1[8], p1[9]), cvtpk(p1[10], p1[11]), cvtpk(p1[12], p1[13]), cvtpk(p1[14], p1[15])};
            const ALAS char* vp = lds + L_V + buf * 8192 + ((lane >> 4) & 1) * 32 + (lane & 3) * 8 + (4 * hi + ((lane & 15) >> 2)) * 64;
#pragma unroll
            for (int d0 = 0; d0 < 2; ++d0)
#pragma unroll
                for (int ks = 0; ks < 4; ++ks) { const s16x4 lo = vtr(vp + d0 * 4096 + ks * 1024), hh = vtr(vp + d0 * 4096 + ks * 1024 + 512);
                    const bf16x8 vf = (bf16x8){lo[0], lo[1], lo[2], lo[3], hh[0], hh[1], hh[2], hh[3]};
                    o[d0] = __builtin_amdgcn_mfma_f32_32x32x16_bf16(__builtin_bit_cast(bf16x8, pw[ks]), vf, o[d0], 0, 0, 0); }
        }
        if (t + 1 < NT) {
            *(ALAS u32x4*)(lds + L_K + (buf ^ 1) * 8192 + ldst) = kreg; *(ALAS u32x4*)(lds + L_V + (buf ^ 1) * 8192 + ldst) = vreg;
            if (t + 2 < NT) { kreg = *(const u32x4*)(Kh + (size_t)(t + 2) * 8192 + koff); vreg = *(const u32x4*)(Vh + (size_t)(t + 2) * 8192 + voff); }
        }
        __syncthreads();
    }
    l_run += swap32f(l_run);
    if (hi == 0) wsf[32 + r32] = l_run;
    asm volatile("s_waitcnt lgkmcnt(0)" ::: "memory");
    ALAS bf16_t* stg = (ALAS bf16_t*)(lds + L_STG) + wid * 2048;
#pragma unroll
    for (int rq = 0; rq < 4; ++rq) { const f32x4 l4 = *(const ALAS f32x4*)(wsf + 32 + 8 * rq + 4 * hi);
#pragma unroll
        for (int e = 0; e < 4; ++e) { const float rl = 1.0f / l4[e]; const int orow = 8 * rq + 4 * hi + e;
#pragma unroll
            for (int d0 = 0; d0 < 2; ++d0) stg[orow * 64 + d0 * 32 + r32] = (bf16_t)(cvtpk(o[d0][4 * rq + e] * rl, 0.f) & 0xffffu); } }
    asm volatile("s_waitcnt lgkmcnt(0)" ::: "memory");
    bf16_t* Yw = Y + (size_t)(b * SEQ + q0 + wid * 32) * 1024 + TYPE * 512 + h * 64;
#pragma unroll
    for (int i = 0; i < 4; ++i) { const int row = i * 8 + (lane >> 3), ch = lane & 7; const u32x4 v = *(const ALAS u32x4*)(stg + row * 64 + ch * 8); *(u32x4*)(Yw + (size_t)row * 1024 + ch * 8) = v; }
    __syncthreads();
}
#undef ALAS
}

constexpr int NWAVES = 8;
constexpr size_t MiB = 1u << 20;
constexpr size_t WS_CTL = 0, CTL_ZERO_BYTES = 256 * 1024;
constexpr size_t WS_KMEAN = 64 * 1024;
constexpr size_t WS_MOD = 256 * 1024;
constexpr size_t WS_WFG = 448 * 1024;
constexpr size_t WS_GAINS = 480 * 1024;
constexpr size_t WS_LF = 512 * 1024;
constexpr size_t WS_FC = 1 * MiB;
constexpr size_t WS_PARTS = 2 * MiB;
constexpr size_t WS_WIN = 4 * MiB;
constexpr size_t WS_WFT = 14 * MiB, WS_WMT = 15 * MiB;
constexpr size_t WS_WOT = 16 * MiB;
constexpr size_t WS_WEFF = 18 * MiB;
constexpr size_t WS_HY = 24 * MiB;
constexpr size_t WS_QKV = 56 * MiB;
constexpr size_t WS_MIX = 152 * MiB;
constexpr size_t WS_U = 184 * MiB, WS_V = 216 * MiB;
constexpr size_t WS_EG = 248 * MiB;
constexpr size_t WS_SC = 56 * MiB;
constexpr size_t WS_END = 256 * MiB;
constexpr int CW_BAR = 4096;
constexpr int RING_BYTES = 131072, LDSCTL_OFF = RING_BYTES, MISC_OFF = LDSCTL_OFF + 320, LDS_BYTES = 147456;

#define GAS __attribute__((address_space(1)))
#define LAS __attribute__((address_space(3)))
typedef unsigned short bf16;
typedef unsigned v4u __attribute__((ext_vector_type(4)));
typedef unsigned v2u __attribute__((ext_vector_type(2)));
typedef float f32x4 __attribute__((ext_vector_type(4)));
typedef GAS unsigned gu32;
#define RLX_AGENT __ATOMIC_RELAXED, __HIP_MEMORY_SCOPE_AGENT
#define LDS_WAIT() asm volatile("s_waitcnt lgkmcnt(0)" ::: "memory")
#define VM_WAIT() asm volatile("s_waitcnt vmcnt(0)" ::: "memory")
__device__ __forceinline__ unsigned f2bf(float f) { unsigned u = __builtin_bit_cast(unsigned, f); return (u + 0x7fffu + ((u >> 16) & 1u)) >> 16; }
__device__ __forceinline__ unsigned pk2(float lo, float hi) { return f2bf(lo) | (f2bf(hi) << 16); }
__device__ __forceinline__ float wave_sum(float v) {
#pragma unroll
    for (int o = 1; o < 64; o <<= 1) v += __shfl_xor(v, o);
    return v;
}
#define XB_TMO      128
#define XB_XCNT(j)  (256  + 64 * (j))
#define XB_XSUB(j)  (1280 + 64 * (j))
#define XB_XGEN(j)  (2304 + 64 * (j))
#define XB_TOP      3328
#define XB_TOPGEN   3392
#define XCD_BAR_WORDS 3456
#define XB_SPIN_CAP (1u << 18)

__device__ __forceinline__ unsigned xb_ld(unsigned* p)              { return __hip_atomic_load(p, __ATOMIC_RELAXED, __HIP_MEMORY_SCOPE_AGENT); }
__device__ __forceinline__ unsigned xb_add(unsigned* p, unsigned v) { return __hip_atomic_fetch_add(p, v, __ATOMIC_RELAXED, __HIP_MEMORY_SCOPE_AGENT); }
__device__ __forceinline__ unsigned xb_xcc_id() { return (unsigned)__builtin_amdgcn_s_getreg((3 << 11) | 20) & 0xFu; }
#define XB_SPIN(cond, bar) do { unsigned _sp = 0; while (cond) { __builtin_amdgcn_s_sleep(1); \
    if ((++_sp & 255u) == 0u) { if (xb_ld(&(bar)[XB_TMO])) break; if (_sp > XB_SPIN_CAP) { atomicAdd(&(bar)[XB_TMO], 1u); break; } } } } while (0)

struct XcdBarrier {
    unsigned* bar; unsigned x;
    volatile LAS unsigned* st;
};

__device__ __forceinline__ XcdBarrier xcd_barrier_post(unsigned* bar, volatile LAS unsigned* st) {
    XcdBarrier b; b.bar = bar; b.x = xb_xcc_id(); b.st = st;
    if (threadIdx.x == 0) (void)xb_add(&bar[XB_XCNT(b.x)], 1u);
    return b;
}
__device__ __forceinline__ void xcd_barrier_complete(unsigned* bar, unsigned x, unsigned& nloc, unsigned& nx) {
    const unsigned G = gridDim.x * gridDim.y * gridDim.z;
    unsigned sum, cnt, mine, sp = 0u;
    for (;;) {
        sum = 0u; cnt = 0u; mine = 0u;
#pragma unroll
        for (unsigned j = 0; j < 16; ++j) { const unsigned c = xb_ld(&bar[XB_XCNT(j)]); sum += c; cnt += (c > 0u) ? 1u : 0u; mine = (j == x) ? c : mine; }
        if (sum == G) break;
        __builtin_amdgcn_s_sleep(1);
        if ((++sp & 255u) == 0u) { if (xb_ld(&bar[XB_TMO])) break; if (sp > XB_SPIN_CAP) { atomicAdd(&bar[XB_TMO], 1u); break; } }
    }
    nloc = mine > 0u ? mine : 1u; nx = cnt > 0u ? cnt : 1u;
}

__device__ __forceinline__ void xcd_barrier(const XcdBarrier& b) {
    asm volatile("s_waitcnt vmcnt(0)" ::: "memory");
    __syncthreads();
    if (threadIdx.x == 0) {
        unsigned* bar = b.bar;
        __builtin_amdgcn_s_waitcnt(0);
        unsigned nloc = b.st[0], nx = b.st[1];
        if (nloc == 0u) { xcd_barrier_complete(bar, b.x, nloc, nx); b.st[0] = nloc; b.st[1] = nx; }
        const unsigned old = xb_add(&bar[XB_XSUB(b.x)], 1u);
        const unsigned gen = old / nloc;
        if (old + 1u == (gen + 1u) * nloc) {
            __builtin_amdgcn_fence(__ATOMIC_RELEASE, "agent");
            asm volatile("s_waitcnt vmcnt(0)" ::: "memory");
            const unsigned og = xb_add(&bar[XB_TOP], 1u);
            const unsigned tg = og / nx;
            if (og + 1u == (tg + 1u) * nx) xb_add(&bar[XB_TOPGEN], 1u);
            else XB_SPIN(xb_ld(&bar[XB_TOPGEN]) == tg, bar);
            __builtin_amdgcn_fence(__ATOMIC_ACQUIRE, "agent");
            xb_add(&bar[XB_XGEN(b.x)], 1u);
            asm volatile("s_waitcnt vmcnt(0)" ::: "memory");
        } else {
            XB_SPIN(xb_ld(&bar[XB_XGEN(b.x)]) == gen, bar);
            __builtin_amdgcn_fence(__ATOMIC_ACQUIRE, "agent");
            asm volatile("s_waitcnt vmcnt(0)" ::: "memory");
        }
    }
    __syncthreads();
}

struct Frame {
    LAS unsigned char* lds; int tid, lane, wave, G, bid;
    const float *x, *c, *w_ada, *b_ada, *norm1_g, *w_in, *b_fgate, *fox_q_g, *fox_k_g, *moba_q_g, *moba_k_g, *w_up_fox, *w_up_moba, *w_out, *norm2_g, *w_peer_q, *sub_keys, *peer_u, *peer_v;
    float* out; unsigned char* ws;
};

__device__ __forceinline__ void tr_item(const float* W, int ldw, int col0, int k0, bf16* WT, int ldt, int row0, LAS float* scr, int lane) {
#pragma unroll 8
    for (int i = 0; i < 32; ++i) { const int kk = 2 * i + (lane >> 5); scr[kk * 33 + (lane & 31)] = W[(size_t)(k0 + kk) * ldw + col0 + (lane & 31)]; }
    LDS_WAIT(); asm volatile("" ::: "memory");
    const int c = lane & 7;
#pragma unroll
    for (int j = 0; j < 4; ++j) { const int n = (lane >> 3) + 8 * j; const LAS float* s = scr + (8 * c) * 33 + n;
        v4u o; o.x = pk2(s[0 * 33], s[1 * 33]); o.y = pk2(s[2 * 33], s[3 * 33]); o.z = pk2(s[4 * 33], s[5 * 33]); o.w = pk2(s[6 * 33], s[7 * 33]);
        *(GAS v4u*)(WT + (size_t)(row0 + n) * ldt + k0 + 8 * c) = o; }
    LDS_WAIT(); asm volatile("" ::: "memory");
}

__device__ __forceinline__ void p0_prep(Frame& F) {
    const int tid = F.tid, lane = F.lane, wave = F.wave, G = F.G;
    float* mod = (float*)(F.ws + WS_MOD);
    {
        LAS float* Kt = (LAS float*)F.lds; LAS float* Wt = Kt + 128 * 128;
        bf16* WeffT = (bf16*)(F.ws + WS_WEFF);
        for (int it = F.bid; it < 256; it += G) {
            const int hp = it >> 4, d0 = (it & 15) * 64;
            const float* keys = F.sub_keys + (size_t)hp * 128 * 128;
#pragma unroll
            for (int i = 0; i < 8; ++i) { const int idx = (i * 512 + tid) * 4, n = idx >> 7, cc = idx & 127; const f32x4 v = *(const f32x4*)(keys + idx);
                Kt[(cc + 0) * 128 + n] = v[0]; Kt[(cc + 1) * 128 + n] = v[1]; Kt[(cc + 2) * 128 + n] = v[2]; Kt[(cc + 3) * 128 + n] = v[3]; }
#pragma unroll
            for (int i = 0; i < 4; ++i) { const int idx = (i * 512 + tid) * 4, dd = idx >> 7, cc = idx & 127; const f32x4 v = *(const f32x4*)(F.w_peer_q + (size_t)(d0 + dd) * 2048 + hp * 128 + cc);
                Wt[(cc + 0) * 64 + dd] = v[0]; Wt[(cc + 1) * 64 + dd] = v[1]; Wt[(cc + 2) * 64 + dd] = v[2]; Wt[(cc + 3) * 64 + dd] = v[3]; }
            __syncthreads();
            const int tn = tid & 31, td = tid >> 5;
            float acc[4][4];
#pragma unroll
            for (int i = 0; i < 4; ++i)
#pragma unroll
                for (int j = 0; j < 4; ++j) acc[i][j] = 0.f;
            for (int cc = 0; cc < 128; ++cc) { const f32x4 kv = *(const LAS f32x4*)(Kt + cc * 128 + 4 * tn), wv = *(const LAS f32x4*)(Wt + cc * 64 + 4 * td);
#pragma unroll
                for (int i = 0; i < 4; ++i)
#pragma unroll
                    for (int j = 0; j < 4; ++j) acc[i][j] += kv[i] * wv[j]; }
#pragma unroll
            for (int i = 0; i < 4; ++i) { v2u o; o.x = pk2(acc[i][0], acc[i][1]); o.y = pk2(acc[i][2], acc[i][3]); *(GAS v2u*)(WeffT + (size_t)(hp * 128 + 4 * tn + i) * 1024 + d0 + 4 * td) = o; }
            __syncthreads();
        }
    }
    {
        LAS float* sc = (LAS float*)F.lds; LAS float* red = sc + 8192;
        for (int it = F.bid; it < 96; it += G) {
            for (int i = tid; i < 8192; i += 512) { const int bb = i >> 10, k = i & 1023; const float v = F.c[i]; sc[k * 8 + bb] = v / (1.0f + expf(-v)); }
            __syncthreads();
            const int n = it * 64 + lane; float a[8];
#pragma unroll
            for (int bb = 0; bb < 8; ++bb) a[bb] = 0.f;
#pragma unroll 4
            for (int k = wave * 128; k < wave * 128 + 128; ++k) { const float w = F.w_ada[(size_t)k * 6144 + n]; const f32x4 s0 = *(const LAS f32x4*)(sc + k * 8), s1 = *(const LAS f32x4*)(sc + k * 8 + 4);
                a[0] += w * s0[0]; a[1] += w * s0[1]; a[2] += w * s0[2]; a[3] += w * s0[3]; a[4] += w * s1[0]; a[5] += w * s1[1]; a[6] += w * s1[2]; a[7] += w * s1[3]; }
#pragma unroll
            for (int bb = 0; bb < 8; ++bb) red[(wave * 8 + bb) * 64 + lane] = a[bb];
            __syncthreads();
            { const int bb = tid >> 6; float s = 0.f;
#pragma unroll
              for (int w = 0; w < 8; ++w) s += red[(w * 8 + bb) * 64 + lane];
              mod[bb * 6144 + it * 64 + lane] = s + F.b_ada[it * 64 + lane]; }
            __syncthreads();
        }
    }
    {
        LAS float* scr = (LAS float*)(F.lds + wave * 16384);
        const int gw = F.bid * NWAVES + wave, NGW = G * NWAVES;
        constexpr int I_IN = 16 * 160, I_UP = 8 * 32, I_OUT = 16 * 32;
        for (int it = gw; it < I_IN + 2 * I_UP + I_OUT; it += NGW) {
            int r = it;
            if (r < I_IN) { const int kb = r / 160, rb = r % 160, tile = rb >> 3, bj = (rb >> 2) & 1, wc = rb & 3; const int Lg = tile * 256 + 64 * wc + 32 * bj; const int src = Lg < 1536 ? Lg : Lg + 8;
                tr_item(F.w_in, IN_COLS, src, kb * 64, (bf16*)(F.ws + WS_WIN), 1024, rb * 32, scr, lane); continue; }
            r -= I_IN;
            if (r < I_UP) { tr_item(F.w_up_fox, 1024, (r & 31) * 32, (r >> 5) * 64, (bf16*)(F.ws + WS_WFT), 512, (r & 31) * 32, scr, lane); continue; }
            r -= I_UP;
            if (r < I_UP) { tr_item(F.w_up_moba, 1024, (r & 31) * 32, (r >> 5) * 64, (bf16*)(F.ws + WS_WMT), 512, (r & 31) * 32, scr, lane); continue; }
            r -= I_UP;
            tr_item(F.w_out, 1024, (r & 31) * 32, (r >> 5) * 64, (bf16*)(F.ws + WS_WOT), 1024, (r & 31) * 32, scr, lane);
        }
    }
    {
        const size_t gt = (size_t)F.bid * 512 + tid, NT_ = (size_t)G * 512;
        float* wfg = (float*)(F.ws + WS_WFG);
        for (size_t i = gt; i < 8192; i += NT_) { const int j = (int)(i >> 10), k = (int)(i & 1023); wfg[i] = F.w_in[(size_t)k * IN_COLS + 1536 + j]; }
        if (gt < 64) { float* gn = (float*)(F.ws + WS_GAINS); gn[gt] = F.fox_q_g[gt]; gn[64 + gt] = F.fox_k_g[gt]; gn[128 + gt] = F.moba_q_g[gt]; gn[192 + gt] = F.moba_k_g[gt]; }
        constexpr size_t NV = (size_t)NEXP * 1024 / 8;
        for (size_t i = gt; i < 2 * NV; i += NT_) {
            const float* src = (i < NV) ? F.peer_u + i * 8 : F.peer_v + (i - NV) * 8;
            bf16* dst = (i < NV) ? (bf16*)(F.ws + WS_U) + i * 8 : (bf16*)(F.ws + WS_V) + (i - NV) * 8;
            const f32x4 a = *(const f32x4*)src, b = *(const f32x4*)(src + 4);
            v4u o; o.x = pk2(a[0], a[1]); o.y = pk2(a[2], a[3]); o.z = pk2(b[0], b[1]); o.w = pk2(b[2], b[3]);
            *(GAS v4u*)dst = o;
        }
    }
}

template <int SECOND>
__device__ __forceinline__ void rows_phase(Frame& F) {
    const int tid = F.tid, lane = F.lane, wave = F.wave;
    LAS float* Ac = (LAS float*)F.lds; LAS float* Bc = Ac + 1024; LAS float* wfs = Bc + 1024;
    const float* mod = (const float*)(F.ws + WS_MOD);
    const float* src = SECOND ? F.out : F.x;
    const float* gain = SECOND ? F.norm2_g : F.norm1_g;
    bf16* dst = (bf16*)(F.ws + WS_HY);
    if (!SECOND) { const float* wfg = (const float*)(F.ws + WS_WFG); for (int i = tid; i < 8192; i += 512) wfs[i] = wfg[i]; }
    for (int it = F.bid; it < 256; it += F.G) {
        const int b = it >> 5;
        const float* shift = mod + (size_t)b * 6144 + (SECOND ? 3072 : 0); const float* scale = shift + 1024;
        __syncthreads();
        for (int i = tid; i < 1024; i += 512) { Ac[i] = gain[i] * (1.0f + scale[i]); Bc[i] = shift[i]; }
        __syncthreads();
        for (int i = 0; i < 8; ++i) {
            const int row = it * 64 + wave * 8 + i;
            const GAS f32x4* xr = (const GAS f32x4*)(src + (size_t)row * 1024) + lane;
            f32x4 v[4]; float ss = 0.f;
#pragma unroll
            for (int j = 0; j < 4; ++j) { v[j] = xr[64 * j]; ss += (v[j][0] * v[j][0] + v[j][1] * v[j][1]) + (v[j][2] * v[j][2] + v[j][3] * v[j][3]); }
            float rstd;
            if (SECOND) { const float* pp = (const float*)(F.ws + WS_PARTS) + (size_t)row * 16; float s = 0.f;
#pragma unroll
                for (int q = 0; q < 16; ++q) s += pp[q];
                rstd = rsqrtf(s * (1.0f / 1024.0f) + RMS_EPS); }
            else rstd = rsqrtf(wave_sum(ss) * (1.0f / 1024.0f) + RMS_EPS);
            float p[8];
#pragma unroll
            for (int q = 0; q < 8; ++q) p[q] = 0.f;
            GAS v2u* o8 = (GAS v2u*)(dst + (size_t)row * 1024) + lane;
#pragma unroll
            for (int j = 0; j < 4; ++j) {
                const int col = 4 * (64 * j + lane);
                const f32x4 a = *(const LAS f32x4*)(Ac + col), bb = *(const LAS f32x4*)(Bc + col);
                const f32x4 hv = v[j] * rstd * a + bb;
                v2u o; o.x = pk2(hv[0], hv[1]); o.y = pk2(hv[2], hv[3]); o8[64 * j] = o;
                if (!SECOND) {
#pragma unroll
                    for (int q = 0; q < 8; ++q) { const f32x4 w = *(const LAS f32x4*)(wfs + q * 1024 + col); p[q] += (hv[0] * w[0] + hv[1] * w[1]) + (hv[2] * w[2] + hv[3] * w[3]); }
                }
            }
            if (!SECOND) {
                float mine = 0.f;
#pragma unroll
                for (int q = 0; q < 8; ++q) { const float s = wave_sum(p[q]); mine = (lane == q) ? s : mine; }
                if (lane < 8) { const float z = mine + F.b_fgate[lane]; const float ls = fminf(z, 0.f) - log1pf(expf(-fabsf(z))); ((float*)(F.ws + WS_LF))[(size_t)row * 8 + lane] = ls; }
            }
        }
    }
    __syncthreads();
}

__device__ __forceinline__ void fcum_items(Frame& F) {
    LAS float* wtot = (LAS float*)F.lds;
    const float* LFp = (const float*)(F.ws + WS_LF); float* Fc = (float*)(F.ws + WS_FC);
    for (int it = F.bid; it < 64; it += F.G) {
        const int b = it >> 3, h = it & 7, s0 = 4 * F.tid;
        float v[4];
#pragma unroll
        for (int i = 0; i < 4; ++i) v[i] = LFp[((size_t)b * SEQ + s0 + i) * 8 + h];
        v[1] += v[0]; v[2] += v[1]; v[3] += v[2];
        float inc = v[3];
#pragma unroll
        for (int o = 1; o < 64; o <<= 1) { const float t = __shfl_up(inc, o); if (F.lane >= o) inc += t; }
        __syncthreads();
        if (F.lane == 63) wtot[F.wave] = inc;
        __syncthreads();
        float base = inc - v[3];
        for (int w = 0; w < F.wave; ++w) base += wtot[w];
        float* o = Fc + (size_t)(b * NHEAD + h) * SEQ + s0;
#pragma unroll
        for (int i = 0; i < 4; ++i) o[i] = base + v[i];
    }
    __syncthreads();
}

__device__ __forceinline__ unsigned okey(float f) { const unsigned u = __float_as_uint(f); return (u & 0x80000000u) ? ~u : (u | 0x80000000u); }
__device__ __forceinline__ float okey_inv(unsigned k) { return __uint_as_float((k & 0x80000000u) ? (k ^ 0x80000000u) : ~k); }
__device__ __forceinline__ void chain16(unsigned (&L)[16], unsigned x) {
#pragma unroll
    for (int k = 0; k < 16; ++k) { const unsigned hi = L[k] > x ? L[k] : x; x = L[k] > x ? x : L[k]; L[k] = hi; }
}
__device__ __forceinline__ void top16_of_128(const float* p, unsigned (&L)[16]) {
#pragma unroll
    for (int k = 0; k < 16; ++k) L[k] = 0u;
    for (int c = 0; c < 4; ++c) {
        f32x4 v[8];
#pragma unroll
        for (int j = 0; j < 8; ++j) v[j] = *(const f32x4*)(p + c * 32 + j * 4);
#pragma unroll
        for (int j = 0; j < 8; ++j)
#pragma unroll
            for (int e = 0; e < 4; ++e) chain16(L, (okey(v[j][e]) & ~127u) | (unsigned)(127 - (c * 32 + j * 4 + e)));
    }
}
__device__ __forceinline__ void topk_phase(Frame& F) {
    const float* SC = (const float*)(F.ws + WS_SC); unsigned* EG = (unsigned*)(F.ws + WS_EG);
    LAS unsigned char* tab = F.lds + F.tid * 32;
    for (int th = F.bid * 512 + F.tid; th < NTOK * 8; th += F.G * 512) {
        const float* p = SC + (size_t)th * 256;
        unsigned L1[16], L2[16];
        top16_of_128(p, L1); top16_of_128(p + 128, L2);
        float v1[16], v2[16];
#pragma unroll
        for (int k = 0; k < 16; ++k) { v1[k] = okey_inv(L1[k] & ~127u); tab[k] = (unsigned char)(127u - (L1[k] & 127u)); v2[k] = okey_inv(L2[k] & ~127u); tab[16 + k] = (unsigned char)(127u - (L2[k] & 127u)); }
        unsigned C[16];
#pragma unroll
        for (int j = 0; j < 16; ++j) C[j] = (okey(v1[0] + v2[j]) & ~255u) | (unsigned)(255 - j);
#pragma unroll
        for (int i = 1; i < 16; ++i)
#pragma unroll
            for (int j = 0; j < 16 / (i + 1); ++j) chain16(C, (okey(v1[i] + v2[j]) & ~255u) | (unsigned)(255 - (i * 16 + j)));
        float sv[16]; float sum = 0.f; const float mx = okey_inv(C[0] & ~255u);
#pragma unroll
        for (int k = 0; k < 16; ++k) { sv[k] = expf(okey_inv(C[k] & ~255u) - mx); sum += sv[k]; }
        const float rs = 1.0f / sum;
        unsigned o[16];
#pragma unroll
        for (int k = 0; k < 16; ++k) { const int pos = 255 - (int)(C[k] & 255u); const unsigned eid = (unsigned)tab[pos >> 4] * 128u + (unsigned)tab[16 + (pos & 15)];
            const _Float16 hg = (_Float16)(sv[k] * rs); o[k] = ((unsigned)__builtin_bit_cast(unsigned short, hg) << 16) | eid; }
        GAS v4u* dst = (GAS v4u*)(EG + (size_t)th * 16);
#pragma unroll
        for (int q = 0; q < 4; ++q) dst[q] = (v4u){o[4 * q], o[4 * q + 1], o[4 * q + 2], o[4 * q + 3]};
    }
}

__device__ __forceinline__ float dot8(v4u r, v4u h, float acc) {
#pragma unroll
    for (int q = 0; q < 4; ++q) { acc += pg8::bf_lo(r[q]) * pg8::bf_lo(h[q]); acc += pg8::bf_hi(r[q]) * pg8::bf_hi(h[q]); }
    return acc;
}
__device__ __forceinline__ float gelu_tanh(float a) { const float y = 0.7978845608028654f * (a + 0.044715f * a * a * a); const float th = 1.0f - 2.0f / (expf(2.0f * y) + 1.0f); return 0.5f * a * (1.0f + th); }
__device__ __forceinline__ void gather_phase(Frame& F) {
    const int lane = F.lane, wave = F.wave;
    const unsigned* EG = (const unsigned*)(F.ws + WS_EG); const bf16* H2 = (const bf16*)(F.ws + WS_HY);
    const bf16* U = (const bf16*)(F.ws + WS_U); const bf16* V = (const bf16*)(F.ws + WS_V); const float* mod = (const float*)(F.ws + WS_MOD);
    LAS float* abuf = (LAS float*)F.lds + wave * 128;
    const bool b5 = (lane & 32) != 0, b4 = (lane & 16) != 0, b3 = (lane & 8) != 0;
    for (int t = F.bid * NWAVES + wave; t < NTOK; t += F.G * NWAVES) {
        const unsigned eg0 = EG[(size_t)t * 128 + lane], eg1 = EG[(size_t)t * 128 + 64 + lane];
        const v4u ha = *(const GAS v4u*)(H2 + (size_t)t * 1024 + 8 * lane), hb = *(const GAS v4u*)(H2 + (size_t)t * 1024 + 512 + 8 * lane);
        for (int kb = 0; kb < 16; ++kb) {
            const unsigned egs = (kb < 8) ? eg0 : eg1;
            v4u ra[8], rb[8];
#pragma unroll
            for (int i = 0; i < 8; ++i) { const unsigned e = (unsigned)__builtin_amdgcn_readlane((int)egs, (kb & 7) * 8 + i) & 0xffffu; const bf16* row = U + (size_t)e * 1024;
                ra[i] = *(const GAS v4u*)(row + 8 * lane); rb[i] = *(const GAS v4u*)(row + 512 + 8 * lane); }
            float p[8];
#pragma unroll
            for (int i = 0; i < 8; ++i) p[i] = dot8(rb[i], hb, dot8(ra[i], ha, 0.f));
            float q4[4], r2[2];
#pragma unroll
            for (int i = 0; i < 4; ++i) { const float keep = b5 ? p[4 + i] : p[i], send = b5 ? p[i] : p[4 + i]; q4[i] = keep + __shfl_xor(send, 32); }
#pragma unroll
            for (int i = 0; i < 2; ++i) { const float keep = b4 ? q4[2 + i] : q4[i], send = b4 ? q4[i] : q4[2 + i]; r2[i] = keep + __shfl_xor(send, 16); }
            float s = (b3 ? r2[1] : r2[0]) + __shfl_xor(b3 ? r2[0] : r2[1], 8);
            s += __shfl_xor(s, 4); s += __shfl_xor(s, 2); s += __shfl_xor(s, 1);
            if ((lane & 7) == 0) abuf[kb * 8 + (lane >> 3)] = s;
        }
        LDS_WAIT(); asm volatile("" ::: "memory");
        const float a0 = abuf[lane], a1 = abuf[64 + lane];
        LDS_WAIT(); asm volatile("" ::: "memory");
        const float w0 = (float)__builtin_bit_cast(_Float16, (unsigned short)(eg0 >> 16)) * gelu_tanh(a0);
        const float w1 = (float)__builtin_bit_cast(_Float16, (unsigned short)(eg1 >> 16)) * gelu_tanh(a1);
        float y[16];
#pragma unroll
        for (int j = 0; j < 16; ++j) y[j] = 0.f;
        for (int kb = 0; kb < 16; ++kb) {
            const unsigned egs = (kb < 8) ? eg0 : eg1; const float ws_ = (kb < 8) ? w0 : w1;
            v4u ra[8], rb[8]; float wk[8];
#pragma unroll
            for (int i = 0; i < 8; ++i) { const int sl = (kb & 7) * 8 + i; const unsigned e = (unsigned)__builtin_amdgcn_readlane((int)egs, sl) & 0xffffu; wk[i] = __int_as_float(__builtin_amdgcn_readlane(__float_as_int(ws_), sl));
                const bf16* row = V + (size_t)e * 1024; ra[i] = *(const GAS v4u*)(row + 8 * lane); rb[i] = *(const GAS v4u*)(row + 512 + 8 * lane); }
#pragma unroll
            for (int i = 0; i < 8; ++i)
#pragma unroll
                for (int q = 0; q < 4; ++q) { y[2 * q] += wk[i] * pg8::bf_lo(ra[i][q]); y[2 * q + 1] += wk[i] * pg8::bf_hi(ra[i][q]); y[8 + 2 * q] += wk[i] * pg8::bf_lo(rb[i][q]); y[8 + 2 * q + 1] += wk[i] * pg8::bf_hi(rb[i][q]); }
        }
        const int b = t >> 11; const float* g2 = mod + (size_t)b * 6144 + 5120;
        float* orow = F.out + (size_t)t * 1024;
#pragma unroll
        for (int hseg = 0; hseg < 2; ++hseg)
#pragma unroll
            for (int q = 0; q < 2; ++q) { const int col = hseg * 512 + 8 * lane + 4 * q; const f32x4 xv = *(const GAS f32x4*)(orow + col), gv = *(const GAS f32x4*)(g2 + col);
                f32x4 o; o[0] = xv[0] + gv[0] * y[hseg * 8 + 4 * q]; o[1] = xv[1] + gv[1] * y[hseg * 8 + 4 * q + 1]; o[2] = xv[2] + gv[2] * y[hseg * 8 + 4 * q + 2]; o[3] = xv[3] + gv[3] * y[hseg * 8 + 4 * q + 3];
                *(GAS f32x4*)(orow + col) = o; }
    }
}

constexpr int N_PHASES = 10;
struct Args { const float* in[19]; float* out; unsigned char* ws; int ph_lo, ph_hi; };
__global__ void __launch_bounds__(NWAVES * 64, 2) fwd_kernel(Args args) {
    extern __shared__ __attribute__((aligned(16))) unsigned char lds_raw[];
    Frame F;
    F.lds = (LAS unsigned char*)lds_raw;
    F.tid = threadIdx.x; F.lane = F.tid & 63; F.wave = __builtin_amdgcn_readfirstlane(F.tid >> 6); F.G = gridDim.x; F.bid = blockIdx.x;
    F.x = args.in[0]; F.c = args.in[1]; F.w_ada = args.in[2]; F.b_ada = args.in[3]; F.norm1_g = args.in[4]; F.w_in = args.in[5]; F.b_fgate = args.in[6];
    F.fox_q_g = args.in[7]; F.fox_k_g = args.in[8]; F.moba_q_g = args.in[9]; F.moba_k_g = args.in[10]; F.w_up_fox = args.in[11]; F.w_up_moba = args.in[12];
    F.w_out = args.in[13]; F.norm2_g = args.in[14]; F.w_peer_q = args.in[15]; F.sub_keys = args.in[16]; F.peer_u = args.in[17]; F.peer_v = args.in[18];
    F.out = args.out; F.ws = args.ws;
    unsigned char* ws = args.ws;
    volatile LAS unsigned* MISC = (volatile LAS unsigned*)(F.lds + MISC_OFF);
    for (int u = F.tid; u < (LDS_BYTES - LDSCTL_OFF) / 4; u += NWAVES * 64) ((LAS unsigned*)(F.lds + LDSCTL_OFF))[u] = 0u;
    __syncthreads();
#if !MK_PER_PHASE
    XcdBarrier bar = xcd_barrier_post((unsigned*)(ws + WS_CTL) + CW_BAR, MISC + 8);
#define GRID_BAR() xcd_barrier(bar)
#else
    (void)MISC;
#define GRID_BAR() do {} while (0)
#endif
    const int lo = args.ph_lo, hi = args.ph_hi;
#define IN(k) (lo <= (k) && (k) < hi)
#define SEAM(k) do { if (IN(k) && IN((k) + 1)) GRID_BAR(); } while (0)
    typedef pg8::bf16_t pb;

    if (IN(0)) { p0_prep(F); } SEAM(0);
    if (IN(1)) { rows_phase<0>(F); } SEAM(1);
    if (IN(2)) {
        fcum_items(F);
        pg8::Gemm g{(const pb*)(ws + WS_HY), (const pb*)(ws + WS_WIN), NTOK, NIN, DM, DM, DM}; pg8::StaticOrder S; S.init(NTOK, NIN, F.G, F.bid);
        pg8::EpiIn E{(pb*)(ws + WS_QKV), (pb*)F.out, (const float*)(ws + WS_GAINS), (float*)(ws + WS_KMEAN)};
        pg8::gemm_phase<pg8::EpiIn, pg8::StaticOrder, true, true>(F.lds, g, S, E);
    } SEAM(2);
    if (IN(3)) {
        const pb* qkv = (const pb*)(ws + WS_QKV); constexpr size_t TS = (size_t)NTOK * 512;
        for (int it = F.bid; it < 256; it += F.G) {
            const int bh = it >> 2, s = it & 3, b = bh >> 3, h = bh & 7;
            att::attn_unit<0>(b, h, 7 - s, qkv, qkv + TS, qkv + 2 * TS, (const float*)(ws + WS_FC), nullptr, (pb*)(ws + WS_HY), (__attribute__((address_space(3))) char*)F.lds);
            att::attn_unit<1>(b, h, 7 - s, qkv + 3 * TS, qkv + 4 * TS, qkv + 5 * TS, nullptr, (const float*)(ws + WS_KMEAN), (pb*)(ws + WS_HY), (__attribute__((address_space(3))) char*)F.lds);
            att::attn_unit<0>(b, h, s, qkv, qkv + TS, qkv + 2 * TS, (const float*)(ws + WS_FC), nullptr, (pb*)(ws + WS_HY), (__attribute__((address_space(3))) char*)F.lds);
            att::attn_unit<1>(b, h, s, qkv + 3 * TS, qkv + 4 * TS, qkv + 5 * TS, nullptr, (const float*)(ws + WS_KMEAN), (pb*)(ws + WS_HY), (__attribute__((address_space(3))) char*)F.lds);
        }
    } SEAM(3);
    if (IN(4)) {
        pg8::StaticOrder S; S.init(NTOK, DM, F.G, F.bid);
        { pg8::Gemm g{(const pb*)(ws + WS_HY), (const pb*)(ws + WS_WFT), NTOK, DM, 512, DM, 512};
          pg8::EpiUp<0> E{(const pb*)F.out, (pb*)(ws + WS_MIX)}; pg8::gemm_phase<pg8::EpiUp<0>, pg8::StaticOrder, true, true>(F.lds, g, S, E); }
        VM_WAIT(); __syncthreads();
        { pg8::Gemm g{(const pb*)(ws + WS_HY) + 512, (const pb*)(ws + WS_WMT), NTOK, DM, 512, DM, 512};
          pg8::EpiUp<1> E{(const pb*)F.out, (pb*)(ws + WS_MIX)}; pg8::gemm_phase<pg8::EpiUp<1>, pg8::StaticOrder, true, true>(F.lds, g, S, E); }
    } SEAM(4);
    if (IN(5)) {
        pg8::Gemm g{(const pb*)(ws + WS_MIX), (const pb*)(ws + WS_WOT), NTOK, DM, DM, DM, DM}; pg8::StaticOrder S; S.init(NTOK, DM, F.G, F.bid);
        pg8::EpiOut E{F.x, (const float*)(ws + WS_MOD), F.out, (float*)(ws + WS_PARTS)};
        pg8::gemm_phase<pg8::EpiOut, pg8::StaticOrder, true, true>(F.lds, g, S, E);
    } SEAM(5);
    if (IN(6)) { rows_phase<1>(F); } SEAM(6);
    if (IN(7)) {
        pg8::Gemm g{(const pb*)(ws + WS_HY), (const pb*)(ws + WS_WEFF), NTOK, NSC, DM, DM, DM}; pg8::StaticOrder S; S.init(NTOK, NSC, F.G, F.bid);
        pg8::EpiSc E{(float*)(ws + WS_SC)};
        pg8::gemm_phase<pg8::EpiSc, pg8::StaticOrder, true, true>(F.lds, g, S, E);
    } SEAM(7);
    if (IN(8)) { topk_phase(F); } SEAM(8);
    if (IN(9)) { gather_phase(F); }
#undef IN
#undef SEAM
}

extern "C" void kernel_launch(void* const* d_in, const int* in_sizes, int n_in, void* d_out, int out_size, void* d_ws, size_t ws_size, hipStream_t stream) {
    static int grid = 0;
    if (grid == 0) {
        if (n_in != 19 || out_size != NTOK * DM || ws_size < WS_END) { fprintf(stderr, "kernel_launch: unexpected shapes (n_in %d, out %d, ws %zu); nothing launched\n", n_in, out_size, ws_size); grid = -1; return; }
        int dev = 0, cus = 0, per_cu = 0;
        if (hipGetDevice(&dev) != hipSuccess || hipDeviceGetAttribute(&cus, hipDeviceAttributeMultiprocessorCount, dev) != hipSuccess) { grid = -1; return; }
        if (hipFuncSetAttribute((const void*)fwd_kernel, hipFuncAttributeMaxDynamicSharedMemorySize, LDS_BYTES) != hipSuccess) { fprintf(stderr, "kernel_launch: hipFuncSetAttribute failed\n"); grid = -1; return; }
        if (hipOccupancyMaxActiveBlocksPerMultiprocessor(&per_cu, (const void*)fwd_kernel, NWAVES * 64, LDS_BYTES) != hipSuccess || per_cu < 1) { fprintf(stderr, "kernel_launch: occupancy query says %d blocks per CU\n", per_cu); per_cu = 1; }
        (void)hipGetLastError();
        grid = cus;
    }
    if (grid < 0) return;
    (void)hipMemsetAsync((char*)d_ws + WS_CTL, 0, CTL_ZERO_BYTES, stream);
    Args a{};
    for (int i = 0; i < 19; ++i) a.in[i] = (const float*)d_in[i];
    a.out = (float*)d_out; a.ws = (unsigned char*)d_ws;
#if MK_PER_PHASE
    for (int ph = 0; ph < N_PHASES; ++ph) { a.ph_lo = ph; a.ph_hi = ph + 1; hipLaunchKernelGGL(fwd_kernel, dim3(grid), dim3(NWAVES * 64), LDS_BYTES, stream, a); }
#else
    a.ph_lo = 0; a.ph_hi = N_PHASES;
    hipLaunchKernelGGL(fwd_kernel, dim3(grid), dim3(NWAVES * 64), LDS_BYTES, stream, a);
#endif
}
```

```cpp
#include <hip/hip_runtime.h>
#include <hip/hip_bf16.h>
#include <cstdio>
#include <cstdint>
#include <cmath>

#ifndef DUP_PHASE
#define DUP_PHASE -1
#endif
#define DUP_N 2
#ifndef MK_PER_PHASE
#define MK_PER_PHASE 0
#endif

constexpr int NB = 8, SEQ = 2048, DM = 1024, NTOK = NB * SEQ, NHEAD = 8, HDIM = 64;
constexpr int IN_COLS = 5128, NIN = 5120, NSC = 2048, NEXP = 16384;
constexpr float RMS_EPS = 1e-6f;
constexpr float LOG2E = 1.4426950408889634f;
constexpr float QSCALE = 0.125f * LOG2E;

namespace pg8 {
#define PG8_LAS __attribute__((address_space(3)))
typedef unsigned short bf16_t;
typedef short bf16x8 __attribute__((ext_vector_type(8)));
typedef float f32x4 __attribute__((ext_vector_type(4)));
typedef unsigned u32x4 __attribute__((ext_vector_type(4)));
constexpr int BM = 256, BK = 64, HALF = 128, HTB = HALF * BK * 2  , STAGE_BYTES = 8 * HTB, NXCD = 8, WGM = 8;

__host__ __device__ __forceinline__ int lds_byte(int r, int c) { const int st = (r >> 4) * 2 + (c >> 5), rr = r & 15, cc = c & 31, ob = rr * 64 + cc * 2; return st * 1024 + (ob ^ (((ob >> 9) & 1) << 5)); }
__host__ __device__ __forceinline__ void stage_rc(int b, int& R, int& C) { const int st = b / 1024, sb = b % 1024, swz = sb ^ (((sb >> 9) & 1) << 5); R = (st >> 1) * 16 + swz / 64; C = (st & 1) * 32 + (swz % 64) / 2; }
__host__ __device__ __forceinline__ int perm32(int rho) { const int n = rho >> 4, i = rho & 15; return 8 * (i >> 2) + 4 * n + (i & 3); }

struct Unit { int pm, pn; };
struct Gemm { const bf16_t* A; const bf16_t* Bt; int M, N, K, lda, ldb; };

struct StaticOrder {
    int nM, nN, nwg, G, c;
    __host__ __device__ void init(int M, int N, int G_, int c_) { nM = M / BM; nN = N / BM; nwg = nM * nN; G = G_; c = c_; }
    __host__ __device__ bool next(int i, Unit& u) const {
        const long L = (long)i * G + c; if (L >= nwg) return false;
        int wgid = (int)L; { const int q = nwg / NXCD, r = nwg % NXCD, xcd = wgid % NXCD, off = wgid / NXCD; wgid = (xcd < r ? xcd * (q + 1) : r * (q + 1) + (xcd - r) * q) + off; }
        const int nig = WGM * nN, gid = wgid / nig, fm = gid * WGM, gsz = (nM - fm) < WGM ? (nM - fm) : WGM;
        u.pm = fm + ((wgid % nig) % gsz); u.pn = (wgid % nig) / gsz; return true;
    }
    __device__ __forceinline__ void a_ready(const Unit&) const {}
    __device__ __forceinline__ void done(const Unit&) const {}
};

__device__ __forceinline__ unsigned cvt_pk_bf16(float lo, float hi) { unsigned r; asm volatile("v_cvt_pk_bf16_f32 %0, %1, %2" : "=v"(r) : "v"(lo), "v"(hi)); return r; }
__device__ __forceinline__ float bf_lo(unsigned w) { return __uint_as_float(w << 16); }
__device__ __forceinline__ float bf_hi(unsigned w) { return __uint_as_float(w & 0xffff0000u); }
__device__ __forceinline__ float sigmoidf_(float x) { return 1.0f / (1.0f + __expf(-x)); }

struct EpiIn {
    static constexpr bool PERM = true, AFTER_DRAIN = false;
    bf16_t* qkv;
    bf16_t* G;
    const float* gains;
    float* kmean;
    __device__ __forceinline__ void operator()(const f32x4 (&acc)[2][2][4][2], const Unit& u, int wr, int wc, int fr, int fq) const {
        const int pn = u.pn;
        if (pn < 12) {
            const int sec = pn >> 1, head = (pn & 1) * 4 + wc;
            const bool isq = (sec == 0 || sec == 3), isk = (sec == 1 || sec == 4);
            const float* gp = gains + ((sec >= 3 ? sec - 1 : sec) & 3) * 64;
            f32x4 gv[2][2];
#pragma unroll
            for (int bj = 0; bj < 2; ++bj)
#pragma unroll
                for (int n = 0; n < 2; ++n) { gv[bj][n] = (f32x4){1.f, 1.f, 1.f, 1.f}; if (isq || isk) gv[bj][n] = *(const f32x4*)(gp + 32 * bj + 8 * fq + 4 * n) * (isq ? QSCALE : 1.0f); }
            bf16_t* base = qkv + (size_t)sec * ((size_t)NTOK * 512);
            f32x4 cs[2][2];
#pragma unroll
            for (int bj = 0; bj < 2; ++bj)
#pragma unroll
                for (int n = 0; n < 2; ++n) cs[bj][n] = (f32x4){0.f, 0.f, 0.f, 0.f};
#pragma unroll
            for (int ai = 0; ai < 2; ++ai)
#pragma unroll
                for (int m = 0; m < 4; ++m) {
                    const int row = u.pm * BM + ai * HALF + wr * 64 + m * 16 + fr; const int b = row >> 11, s = row & 2047;
                    f32x4 v[2][2];
#pragma unroll
                    for (int bj = 0; bj < 2; ++bj)
#pragma unroll
                        for (int n = 0; n < 2; ++n) v[bj][n] = acc[ai][bj][m][n];
                    if (isq || isk) {
                        float ss = 0.f;
#pragma unroll
                        for (int bj = 0; bj < 2; ++bj)
#pragma unroll
                            for (int n = 0; n < 2; ++n) { const f32x4 x = v[bj][n]; ss += (x[0] * x[0] + x[1] * x[1]) + (x[2] * x[2] + x[3] * x[3]); }
                        ss += __shfl_xor(ss, 16); ss += __shfl_xor(ss, 32);
                        const float rstd = rsqrtf(ss * (1.0f / 64.0f) + RMS_EPS);
#pragma unroll
                        for (int bj = 0; bj < 2; ++bj)
#pragma unroll
                            for (int n = 0; n < 2; ++n) v[bj][n] = v[bj][n] * rstd * gv[bj][n];
                    }
                    if (sec == 4) {
#pragma unroll
                        for (int bj = 0; bj < 2; ++bj)
#pragma unroll
                            for (int n = 0; n < 2; ++n) cs[bj][n] += v[bj][n];
                    }
                    bf16_t* dst = base + ((size_t)(b * NHEAD + head) * SEQ + s) * HDIM + 8 * fq;
#pragma unroll
                    for (int bj = 0; bj < 2; ++bj) { u32x4 w; w.x = cvt_pk_bf16(v[bj][0][0], v[bj][0][1]); w.y = cvt_pk_bf16(v[bj][0][2], v[bj][0][3]); w.z = cvt_pk_bf16(v[bj][1][0], v[bj][1][1]); w.w = cvt_pk_bf16(v[bj][1][2], v[bj][1][3]);
                        *(u32x4*)(dst + 32 * bj) = w; }
                }
            if (sec == 4) {
                const int b = (u.pm * BM) >> 11, blk = u.pm & 7;
                float* km = kmean + ((size_t)(b * NHEAD + head) * 8 + blk) * HDIM + 8 * fq;
#pragma unroll
                for (int bj = 0; bj < 2; ++bj)
#pragma unroll
                    for (int n = 0; n < 2; ++n)
#pragma unroll
                        for (int e = 0; e < 4; ++e) { float x = cs[bj][n][e]; x += __shfl_xor(x, 1); x += __shfl_xor(x, 2); x += __shfl_xor(x, 4); x += __shfl_xor(x, 8);
                            if (fr == 0) atomicAdd(km + 32 * bj + 4 * n + e, x * (1.0f / 256.0f)); }
            }
        } else {
            const int gc0 = (pn - 12) * 256 + 64 * wc + 8 * fq;
#pragma unroll
            for (int ai = 0; ai < 2; ++ai)
#pragma unroll
                for (int m = 0; m < 4; ++m) {
                    const int row = u.pm * BM + ai * HALF + wr * 64 + m * 16 + fr;
                    bf16_t* dst = G + (size_t)row * 2048 + gc0;
#pragma unroll
                    for (int bj = 0; bj < 2; ++bj) { const f32x4 a = acc[ai][bj][m][0], c = acc[ai][bj][m][1]; u32x4 w;
                        w.x = cvt_pk_bf16(sigmoidf_(a[0]), sigmoidf_(a[1])); w.y = cvt_pk_bf16(sigmoidf_(a[2]), sigmoidf_(a[3])); w.z = cvt_pk_bf16(sigmoidf_(c[0]), sigmoidf_(c[1])); w.w = cvt_pk_bf16(sigmoidf_(c[2]), sigmoidf_(c[3]));
                        *(u32x4*)(dst + 32 * bj) = w; }
                }
        }
    }
};

template <int SECOND> struct EpiUp {
    static constexpr bool PERM = true, AFTER_DRAIN = false;
    const bf16_t* G; bf16_t* MIX;
    __device__ __forceinline__ void operator()(const f32x4 (&acc)[2][2][4][2], const Unit& u, int wr, int wc, int fr, int fq) const {
        const int col0 = u.pn * BM + wc * 32 + 8 * fq;
#pragma unroll
        for (int ai = 0; ai < 2; ++ai)
#pragma unroll
            for (int m = 0; m < 4; ++m) {
                const int row = u.pm * BM + ai * HALF + wr * 64 + m * 16 + fr;
#pragma unroll
                for (int bj = 0; bj < 2; ++bj) {
                    const int col = col0 + bj * HALF;
                    const u32x4 g = *(const u32x4*)(G + (size_t)row * 2048 + SECOND * 1024 + col);
                    const f32x4 a = acc[ai][bj][m][0], c = acc[ai][bj][m][1];
                    float v[8] = {a[0] * bf_lo(g.x), a[1] * bf_hi(g.x), a[2] * bf_lo(g.y), a[3] * bf_hi(g.y), c[0] * bf_lo(g.z), c[1] * bf_hi(g.z), c[2] * bf_lo(g.w), c[3] * bf_hi(g.w)};
                    bf16_t* p = MIX + (size_t)row * 1024 + col;
                    if (SECOND) { const u32x4 o = __builtin_nontemporal_load((const u32x4*)p);
                        v[0] += bf_lo(o.x); v[1] += bf_hi(o.x); v[2] += bf_lo(o.y); v[3] += bf_hi(o.y); v[4] += bf_lo(o.z); v[5] += bf_hi(o.z); v[6] += bf_lo(o.w); v[7] += bf_hi(o.w); }
                    u32x4 w; w.x = cvt_pk_bf16(v[0], v[1]); w.y = cvt_pk_bf16(v[2], v[3]); w.z = cvt_pk_bf16(v[4], v[5]); w.w = cvt_pk_bf16(v[6], v[7]);
                    *(u32x4*)p = w;
                }
            }
    }
};

struct EpiOut {
    static constexpr bool PERM = true, AFTER_DRAIN = false;
    const float* x; const float* mod; float* out; float* parts;
    __device__ __forceinline__ void operator()(const f32x4 (&acc)[2][2][4][2], const Unit& u, int wr, int wc, int fr, int fq) const {
        const int col0 = u.pn * BM + wc * 32 + 8 * fq;
        const int b = (u.pm * BM) >> 11;
        const float* g1 = mod + (size_t)b * 6144 + 2048;
        f32x4 gt[2][2];
#pragma unroll
        for (int bj = 0; bj < 2; ++bj)
#pragma unroll
            for (int n = 0; n < 2; ++n) gt[bj][n] = *(const f32x4*)(g1 + col0 + bj * HALF + 4 * n);
#pragma unroll
        for (int ai = 0; ai < 2; ++ai)
#pragma unroll
            for (int m = 0; m < 4; ++m) {
                const int row = u.pm * BM + ai * HALF + wr * 64 + m * 16 + fr; const size_t off = (size_t)row * 1024 + col0;
                float ss = 0.f;
#pragma unroll
                for (int bj = 0; bj < 2; ++bj)
#pragma unroll
                    for (int n = 0; n < 2; ++n) { const f32x4 xv = *(const f32x4*)(x + off + bj * HALF + 4 * n); const f32x4 o = xv + gt[bj][n] * acc[ai][bj][m][n];
                        ss += (o[0] * o[0] + o[1] * o[1]) + (o[2] * o[2] + o[3] * o[3]); *(f32x4*)(out + off + bj * HALF + 4 * n) = o; }
                ss += __shfl_xor(ss, 16); ss += __shfl_xor(ss, 32);
                if (fq == 0) parts[(size_t)row * 16 + u.pn * 4 + wc] = ss;
            }
    }
};

struct EpiSc {
    static constexpr bool PERM = true, AFTER_DRAIN = false;
    float* SC;
    __device__ __forceinline__ void operator()(const f32x4 (&acc)[2][2][4][2], const Unit& u, int wr, int wc, int fr, int fq) const {
        const int col0 = u.pn * BM + wc * 32 + 8 * fq;
#pragma unroll
        for (int ai = 0; ai < 2; ++ai)
#pragma unroll
            for (int m = 0; m < 4; ++m) {
                const int row = u.pm * BM + ai * HALF + wr * 64 + m * 16 + fr; const size_t off = (size_t)row * 2048 + col0;
#pragma unroll
                for (int bj = 0; bj < 2; ++bj)
#pragma unroll
                    for (int n = 0; n < 2; ++n) *(f32x4*)(SC + off + bj * HALF + 4 * n) = acc[ai][bj][m][n];
            }
    }
};

template <class Epi, class Sched, bool ALIGN_EPI = false, bool SP2 = false>
__device__ __forceinline__ void gemm_phase(PG8_LAS unsigned char* lds, const Gemm g, const Sched& S, const Epi& E) {
    const int tid = threadIdx.x, wid = __builtin_amdgcn_readfirstlane(tid >> 6), lane = tid & 63, wr = wid >> 2, wc = wid & 3, fr = lane & 15, fq = lane >> 4;
    const int K = g.K, nt = K / BK;
    unsigned voffA[2], voffB[2];
#pragma unroll
    for (int i = 0; i < 2; ++i) { int R, C; stage_rc(tid * 16 + i * 8192, R, C); const int Rb = Epi::PERM ? ((R & ~31) + perm32(R & 31)) : R;
        voffA[i] = (unsigned)(R * g.lda + C) * 2u; voffB[i] = (unsigned)(Rb * g.ldb + C) * 2u; }
    const size_t kstep = (size_t)(BK * 2);
    const size_t hstepA = (size_t)HALF * g.lda * 2, hstepB = (size_t)HALF * g.ldb * 2;
    const size_t tstepA = 2 * hstepA, tstepB = 2 * hstepB;
    const unsigned ldsw = (unsigned)wid * 1024u;
    const int aoff = lds_byte(wr * 64 + fr, fq * 8), boff = lds_byte(wc * 32 + fr, fq * 8);
#define PG8_SA(b, h) (((b) * 2 + (h)) * HTB)
#define PG8_SB(b, h) ((4 + (b) * 2 + (h)) * HTB)
#define PG8_STAGE(bufoff, gbase, voff) do { _Pragma("unroll") for (int _i = 0; _i < 2; ++_i) \
        __builtin_amdgcn_global_load_lds((const unsigned*)((const char*)(gbase) + (voff)[_i]), (PG8_LAS unsigned*)(lds + (bufoff) + ldsw + _i * 8192), 16, 0, 0); } while (0)
#define PG8_LDA(dst, b, h) do { _Pragma("unroll") for (int m = 0; m < 4; ++m) _Pragma("unroll") for (int k = 0; k < 2; ++k) dst[m][k] = *(const PG8_LAS bf16x8*)(lds + PG8_SA(b, h) + aoff + m * 2048 + k * 1024); } while (0)
#define PG8_LDB(dst, b, h) do { _Pragma("unroll") for (int n = 0; n < 2; ++n) _Pragma("unroll") for (int k = 0; k < 2; ++k) dst[n][k] = *(const PG8_LAS bf16x8*)(lds + PG8_SB(b, h) + boff + n * 2048 + k * 1024); } while (0)
#define PG8_MMA(ai, bj, At, Bt) do { __builtin_amdgcn_s_setprio(1); _Pragma("unroll") for (int m = 0; m < 4; ++m) _Pragma("unroll") for (int n = 0; n < 2; ++n) _Pragma("unroll") for (int k = 0; k < 2; ++k) \
        acc[ai][bj][m][n] = __builtin_amdgcn_mfma_f32_16x16x32_bf16(Bt[n][k], At[m][k], acc[ai][bj][m][n], 0, 0, 0); __builtin_amdgcn_s_setprio(0); } while (0)
#define PG8_WAIT_V(n) asm volatile("s_waitcnt vmcnt(" #n ")" ::: "memory")
#define PG8_WAIT_L(n) asm volatile("s_waitcnt lgkmcnt(" #n ")" ::: "memory")
#define PG8_BAR __builtin_amdgcn_s_barrier()
#define PG8_SCHED __builtin_amdgcn_sched_barrier(0)
    Unit cur, nxt; int ui = 0;
    if (!S.next(0, cur)) return;
    f32x4 acc[2][2][4][2];
#pragma unroll
    for (int a = 0; a < 2; ++a)
#pragma unroll
        for (int b = 0; b < 2; ++b)
#pragma unroll
            for (int m = 0; m < 4; ++m)
#pragma unroll
                for (int n = 0; n < 2; ++n) acc[a][b][m][n] = (f32x4){0.f, 0.f, 0.f, 0.f};
    bf16x8 At[4][2], B0[2][2], B1[2][2];
    const char* cA = (const char*)g.A + (size_t)cur.pm * tstepA; const char* cB = (const char*)g.Bt + (size_t)cur.pn * tstepB;
    S.a_ready(cur);
    if constexpr (SP2) {
        PG8_STAGE(PG8_SB(0, 0), cB, voffB); PG8_STAGE(PG8_SB(0, 1), cB + hstepB, voffB); PG8_STAGE(PG8_SA(0, 0), cA, voffA); PG8_STAGE(PG8_SA(0, 1), cA + hstepA, voffA);
        if (wr == 1) PG8_BAR;
        PG8_WAIT_V(2); PG8_BAR;
        PG8_STAGE(PG8_SB(1, 0), cB + kstep, voffB); PG8_STAGE(PG8_SA(1, 0), cA + kstep, voffA); PG8_STAGE(PG8_SB(1, 1), cB + hstepB + kstep, voffB);
        PG8_WAIT_V(6); PG8_BAR;
    } else {
        PG8_STAGE(PG8_SB(0, 0), cB, voffB); PG8_STAGE(PG8_SA(0, 0), cA, voffA); PG8_STAGE(PG8_SB(0, 1), cB + hstepB, voffB); PG8_STAGE(PG8_SA(0, 1), cA + hstepA, voffA);
        if (wr == 1) PG8_BAR;
        PG8_WAIT_V(4); PG8_BAR;
        PG8_STAGE(PG8_SB(1, 0), cB + kstep, voffB); PG8_STAGE(PG8_SA(1, 0), cA + kstep, voffA); PG8_STAGE(PG8_SB(1, 1), cB + hstepB + kstep, voffB);
        PG8_WAIT_V(6); PG8_BAR;
    }
    for (;;) {
        const bool has_next = S.next(ui + 1, nxt);
        const char* nA = has_next ? (const char*)g.A + (size_t)nxt.pm * tstepA : cA; const char* nB = has_next ? (const char*)g.Bt + (size_t)nxt.pn * tstepB : cB;
        for (int t = 0; t < nt; t += 2) {
            const bool last = (t == nt - 2);
            const char* a1 = cA + (size_t)(t + 1) * kstep;
            const char* a2 = last ? nA : cA + (size_t)(t + 2) * kstep; const char* b2 = last ? nB : cB + (size_t)(t + 2) * kstep;
            const char* a3 = a2 + kstep; const char* b3 = b2 + kstep;
            if (last && has_next) S.a_ready(nxt);
            if constexpr (SP2) {
            PG8_LDB(B0, 0, 0); PG8_LDB(B1, 0, 1); PG8_SCHED; PG8_LDA(At, 0, 0); PG8_STAGE(PG8_SA(1, 1), a1 + hstepA, voffA);
            PG8_WAIT_V(8); PG8_WAIT_L(0); PG8_BAR; PG8_MMA(0, 0, At, B0); PG8_MMA(0, 1, At, B1); PG8_BAR; PG8_SCHED;
            PG8_LDA(At, 0, 1); PG8_STAGE(PG8_SB(0, 0), b2, voffB); PG8_STAGE(PG8_SB(0, 1), b2 + hstepB, voffB); PG8_STAGE(PG8_SA(0, 0), a2, voffA);
            PG8_WAIT_V(8); PG8_WAIT_L(0); PG8_BAR; PG8_MMA(1, 0, At, B0); PG8_MMA(1, 1, At, B1); PG8_BAR; PG8_SCHED;
            PG8_LDB(B0, 1, 0); PG8_LDB(B1, 1, 1); PG8_SCHED; PG8_LDA(At, 1, 0); PG8_STAGE(PG8_SA(0, 1), a2 + hstepA, voffA);
            PG8_WAIT_V(8); PG8_WAIT_L(0); PG8_BAR; PG8_MMA(0, 0, At, B0); PG8_MMA(0, 1, At, B1); PG8_BAR; PG8_SCHED;
            PG8_LDA(At, 1, 1); PG8_STAGE(PG8_SB(1, 0), b3, voffB); PG8_STAGE(PG8_SB(1, 1), b3 + hstepB, voffB); PG8_STAGE(PG8_SA(1, 0), a3, voffA);
            PG8_WAIT_V(8); PG8_WAIT_L(0); PG8_BAR; PG8_MMA(1, 0, At, B0); PG8_MMA(1, 1, At, B1); PG8_BAR; PG8_SCHED;
            } else {
            PG8_LDB(B0, 0, 0); PG8_SCHED; PG8_LDA(At, 0, 0); PG8_STAGE(PG8_SA(1, 1), a1 + hstepA, voffA);
            PG8_WAIT_L(8); PG8_BAR; PG8_WAIT_L(0); PG8_MMA(0, 0, At, B0); PG8_BAR; PG8_SCHED;
            PG8_LDB(B1, 0, 1); PG8_STAGE(PG8_SB(0, 0), b2, voffB);
            PG8_BAR; PG8_WAIT_L(0); PG8_MMA(0, 1, At, B1); PG8_BAR;
            PG8_LDA(At, 0, 1); PG8_STAGE(PG8_SA(0, 0), a2, voffA);
            PG8_BAR; PG8_WAIT_L(0); PG8_MMA(1, 0, At, B0); PG8_BAR; PG8_SCHED;
            PG8_STAGE(PG8_SB(0, 1), b2 + hstepB, voffB);
            PG8_WAIT_V(6); PG8_BAR; PG8_MMA(1, 1, At, B1); PG8_BAR;
            PG8_LDB(B0, 1, 0); PG8_SCHED; PG8_LDA(At, 1, 0); PG8_STAGE(PG8_SA(0, 1), a2 + hstepA, voffA);
            PG8_WAIT_L(8); PG8_BAR; PG8_WAIT_L(0); PG8_MMA(0, 0, At, B0); PG8_BAR; PG8_SCHED;
            PG8_LDB(B1, 1, 1); PG8_STAGE(PG8_SB(1, 0), b3, voffB);
            PG8_BAR; PG8_WAIT_L(0); PG8_MMA(0, 1, At, B1); PG8_BAR;
            PG8_LDA(At, 1, 1); PG8_STAGE(PG8_SA(1, 0), a3, voffA);
            PG8_BAR; PG8_WAIT_L(0); PG8_MMA(1, 0, At, B0); PG8_BAR; PG8_SCHED;
            PG8_STAGE(PG8_SB(1, 1), b3 + hstepB, voffB);
            PG8_WAIT_V(6); PG8_BAR; PG8_MMA(1, 1, At, B1); PG8_BAR;
            }
        }
        if constexpr (ALIGN_EPI) { if (wr == 0) PG8_BAR; }
        if constexpr (!Epi::AFTER_DRAIN) { E(acc, cur, wr, wc, fr, fq); S.done(cur); }
        if (!has_next) break;
#pragma unroll
        for (int a = 0; a < 2; ++a)
#pragma unroll
            for (int b = 0; b < 2; ++b)
#pragma unroll
                for (int m = 0; m < 4; ++m)
#pragma unroll
                    for (int n = 0; n < 2; ++n) acc[a][b][m][n] = (f32x4){0.f, 0.f, 0.f, 0.f};
        cur = nxt; cA = nA; cB = nB; ++ui;
        if constexpr (ALIGN_EPI) { if (wr == 1) PG8_BAR; }
    }
    PG8_WAIT_V(0);
    if constexpr (!ALIGN_EPI) { if (wr == 0) PG8_BAR; }
    PG8_BAR;
    if constexpr (Epi::AFTER_DRAIN) { E.fused(acc, cur, wr, wc, fr, fq, lds, wid, lane); S.done(cur); }
#undef PG8_SA
#undef PG8_SB
#undef PG8_STAGE
#undef PG8_LDA
#undef PG8_LDB
#undef PG8_MMA
#undef PG8_WAIT_V
#undef PG8_WAIT_L
#undef PG8_BAR
#undef PG8_SCHED
}
}

namespace att {
#define ALAS __attribute__((address_space(3)))
typedef unsigned short bf16_t;
typedef short bf16x8 __attribute__((ext_vector_type(8)));
typedef short s16x4 __attribute__((ext_vector_type(4)));
typedef short v4i16_t __attribute__((ext_vector_type(4)));
typedef float f32x16 __attribute__((ext_vector_type(16)));
typedef float f32x4 __attribute__((ext_vector_type(4)));
typedef unsigned u32x4 __attribute__((ext_vector_type(4)));
constexpr int L_K = 0, L_V = 16384, L_KB = 32768, L_WSF = 40960, L_KM = 43008, L_STG = 45056, L_END = L_STG + 8 * 4096;
__device__ __forceinline__ s16x4 vtr(const ALAS char* p) { return __builtin_bit_cast(s16x4, __builtin_amdgcn_ds_read_tr16_b64_v4i16((ALAS v4i16_t*)p)); }
__device__ __forceinline__ unsigned cvtpk(float lo, float hi) { typedef float f2 __attribute__((ext_vector_type(2))); typedef __bf16 b2 __attribute__((ext_vector_type(2))); f2 v = {lo, hi}; b2 b = __builtin_convertvector(v, b2); return __builtin_bit_cast(unsigned, b); }
__device__ __forceinline__ float swap32f(float v) { return __shfl_xor(v, 32); }

template <int TYPE>
__device__ __forceinline__ void attn_unit(int b, int h, int qb, const bf16_t* Q, const bf16_t* K, const bf16_t* V, const float* Fcum, const float* kmean, bf16_t* Y, ALAS char* lds) {
    const int tid = threadIdx.x, lane = tid & 63, r32 = lane & 31, hi = lane >> 5; const int wid = __builtin_amdgcn_readfirstlane(tid >> 6);
    const size_t headbase = (size_t)(b * NHEAD + h) * SEQ * HDIM;
    const char* Kh = (const char*)(K + headbase); const char* Vh = (const char*)(V + headbase); const bf16_t* Qh = Q + headbase;
    const int q0 = qb * 256, NT = 4 * (qb + 1);
    ALAS float* kbias = (ALAS float*)(lds + L_KB);
    ALAS float* wsf = (ALAS float*)(lds + L_WSF) + wid * 64;
    ALAS float* km = (ALAS float*)(lds + L_KM);
    {
        const float slope = exp2f(-(float)(h + 1));
        for (int s = tid; s < q0 + 256; s += 512) kbias[s] = (TYPE == 0) ? (-Fcum[(size_t)(b * NHEAD + h) * SEQ + s] * LOG2E) : (slope * (float)s * LOG2E);
        if (TYPE == 1) km[tid] = kmean[(size_t)(b * NHEAD + h) * 512 + tid];
    }
    bf16x8 qr[4];
    { const bf16_t* qrow = Qh + (size_t)(q0 + wid * 32 + r32) * HDIM;
#pragma unroll
      for (int d0 = 0; d0 < 4; ++d0) qr[d0] = *(const bf16x8*)(qrow + d0 * 16 + hi * 8); }
    const int koff = lane * 128 + wid * 16;
    const int voff = (16 * (wid & 3) + (lane >> 2)) * 128 + (wid >> 2) * 64 + (lane & 3) * 16;
    const int ldst = wid * 1024 + lane * 16;
    u32x4 kreg = *(const u32x4*)(Kh + koff), vreg = *(const u32x4*)(Vh + voff);
    *(ALAS u32x4*)(lds + L_K + ldst) = kreg; *(ALAS u32x4*)(lds + L_V + ldst) = vreg;
    if (NT > 1) { kreg = *(const u32x4*)(Kh + 8192 + koff); vreg = *(const u32x4*)(Vh + 8192 + voff); }
    __syncthreads();
    unsigned sel = 0xffu;
    if (TYPE == 1) {
        float gate[7];
#pragma unroll
        for (int jb = 0; jb < 7; ++jb) {
            float g = 0.f;
#pragma unroll
            for (int d0 = 0; d0 < 4; ++d0) {
                const f32x4 k0 = *(const ALAS f32x4*)(km + jb * 64 + d0 * 16 + hi * 8), k1 = *(const ALAS f32x4*)(km + jb * 64 + d0 * 16 + hi * 8 + 4);
#pragma unroll
                for (int e = 0; e < 4; ++e) { g += __uint_as_float((unsigned)(unsigned short)qr[d0][e] << 16) * k0[e]; g += __uint_as_float((unsigned)(unsigned short)qr[d0][4 + e] << 16) * k1[e]; }
            }
            gate[jb] = g + swap32f(g);
        }
        if (qb <= 3) sel = (1u << qb) - 1u;
        else { sel = 0u;
#pragma unroll
            for (int it = 0; it < 3; ++it) { float best = -INFINITY; int bi = 0;
#pragma unroll
                for (int jb = 0; jb < 7; ++jb) { const bool ok = (jb < qb) && !((sel >> jb) & 1u) && (gate[jb] > best); best = ok ? gate[jb] : best; bi = ok ? jb : bi; }
                sel |= 1u << bi; } }
    }
    float m_run = -1e30f, l_run = 0.f; f32x16 o[2]; o[0] = f32x16{}; o[1] = f32x16{};
    const int qrel = wid * 32 + r32;
    for (int t = 0; t < NT; ++t) {
        const int buf = t & 1, jband = t - (NT - 4);
        bool active = true;
        if (jband >= 0) active = (64 * jband <= wid * 32 + 31);
        else if (TYPE == 1) active = __any((int)((sel >> (t >> 2)) & 1u)) != 0;
        if (active) {
            f32x16 p0 = f32x16{}, p1 = f32x16{};
            { const ALAS char* kb = lds + L_K + buf * 8192 + hi * 1024 + r32 * 16;
#pragma unroll
              for (int d0 = 0; d0 < 4; ++d0) { const bf16x8 b0 = *(const ALAS bf16x8*)(kb + d0 * 2048), b1 = *(const ALAS bf16x8*)(kb + d0 * 2048 + 512);
                  p0 = __builtin_amdgcn_mfma_f32_32x32x16_bf16(b0, qr[d0], p0, 0, 0, 0); p1 = __builtin_amdgcn_mfma_f32_32x32x16_bf16(b1, qr[d0], p1, 0, 0, 0); } }
            { const ALAS float* kbt = kbias + 64 * t + 4 * hi;
#pragma unroll
              for (int rq = 0; rq < 4; ++rq) { const f32x4 b0 = *(const ALAS f32x4*)(kbt + 8 * rq), b1 = *(const ALAS f32x4*)(kbt + 32 + 8 * rq);
#pragma unroll
                  for (int e = 0; e < 4; ++e) { p0[4 * rq + e] += b0[e]; p1[4 * rq + e] += b1[e]; } } }
            if (jband >= 0) { const int kb0 = 64 * jband + 4 * hi;
#pragma unroll
                for (int r = 0; r < 16; ++r) { const int kv = kb0 + (r & 3) + 8 * (r >> 2); if (kv > qrel) p0[r] = -INFINITY; if (kv + 32 > qrel) p1[r] = -INFINITY; } }
            else if (TYPE == 1) { if (!((sel >> (t >> 2)) & 1u)) {
#pragma unroll
                for (int r = 0; r < 16; ++r) { p0[r] = -INFINITY; p1[r] = -INFINITY; } } }
            float rm = fmaxf(p0[0], p1[0]);
#pragma unroll
            for (int r = 1; r < 16; ++r) rm = fmaxf(rm, fmaxf(p0[r], p1[r]));
            rm = fmaxf(rm, swap32f(rm));
            const float mn = fmaxf(m_run, rm), alpha = __builtin_amdgcn_exp2f(m_run - mn); m_run = mn;
            float rs = 0.f;
#pragma unroll
            for (int r = 0; r < 16; ++r) { p0[r] = __builtin_amdgcn_exp2f(p0[r] - mn); p1[r] = __builtin_amdgcn_exp2f(p1[r] - mn); rs += p0[r] + p1[r]; }
            l_run = l_run * alpha + rs;
            if (__any(alpha != 1.0f)) {
                if (hi == 0) wsf[r32] = alpha;
                asm volatile("s_waitcnt lgkmcnt(0)" ::: "memory");
#pragma unroll
                for (int rq = 0; rq < 4; ++rq) { const f32x4 a4 = *(const ALAS f32x4*)(wsf + 8 * rq + 4 * hi);
#pragma unroll
                    for (int e = 0; e < 4; ++e) { o[0][4 * rq + e] *= a4[e]; o[1][4 * rq + e] *= a4[e]; } }
                asm volatile("s_waitcnt lgkmcnt(0)" ::: "memory");
            }
            u32x4 pw[4];
            pw[0] = (u32x4){cvtpk(p0[0], p0[1]), cvtpk(p0[2], p0[3]), cvtpk(p0[4], p0[5]), cvtpk(p0[6], p0[7])};
            pw[1] = (u32x4){cvtpk(p0[8], p0[9]), cvtpk(p0[10], p0[11]), cvtpk(p0[12], p0[13]), cvtpk(p0[14], p0[15])};
            pw[2] = (u32x4){cvtpk(p1[0], p1[1]), cvtpk(p1[2], p1[3]), cvtpk(p1[4], p1[5]), cvtpk(p1[6], p1[7])};
            pw[3] = (u32x4){cvtpk(p1[8], p1[9]), cvtpk(p1[10], p1[11]), cvtpk(p1[12], p1[13]), cvtpk(p1[14], p1[15])};
            const ALAS char* vp = lds + L_V + buf * 8192 + ((lane >> 4) & 1) * 32 + (lane & 3) * 8 + (4 * hi + ((lane & 15) >> 2)) * 64;
#pragma unroll
            for (int d0 = 0; d0 < 2; ++d0)
#pragma unroll
                for (int ks = 0; ks < 4; ++ks) { const s16x4 lo = vtr(vp + d0 * 4096 + ks * 1024), hh = vtr(vp + d0 * 4096 + ks * 1024 + 512);
                    const bf16x8 vf = (bf16x8){lo[0], lo[1], lo[2], lo[3], hh[0], hh[1], hh[2], hh[3]};
                    o[d0] = __builtin_amdgcn_mfma_f32_32x32x16_bf16(__builtin_bit_cast(bf16x8, pw[ks]), vf, o[d0], 0, 0, 0); }
        }
        if (t + 1 < NT) {
            *(ALAS u32x4*)(lds + L_K + (buf ^ 1) * 8192 + ldst) = kreg; *(ALAS u32x4*)(lds + L_V + (buf ^ 1) * 8192 + ldst) = vreg;
            if (t + 2 < NT) { kreg = *(const u32x4*)(Kh + (size_t)(t + 2) * 8192 + koff); vreg = *(const u32x4*)(Vh + (size_t)(t + 2) * 8192 + voff); }
        }
        __syncthreads();
    }
    l_run += swap32f(l_run);
    if (hi == 0) wsf[32 + r32] = l_run;
    asm volatile("s_waitcnt lgkmcnt(0)" ::: "memory");
    ALAS bf16_t* stg = (ALAS bf16_t*)(lds + L_STG) + wid * 2048;
#pragma unroll
    for (int rq = 0; rq < 4; ++rq) { const f32x4 l4 = *(const ALAS f32x4*)(wsf + 32 + 8 * rq + 4 * hi);
#pragma unroll
        for (int e = 0; e < 4; ++e) { const float rl = 1.0f / l4[e]; const int orow = 8 * rq + 4 * hi + e;
#pragma unroll
            for (int d0 = 0; d0 < 2; ++d0) stg[orow * 64 + d0 * 32 + r32] = (bf16_t)(cvtpk(o[d0][4 * rq + e] * rl, 0.f) & 0xffffu); } }
    asm volatile("s_waitcnt lgkmcnt(0)" ::: "memory");
    bf16_t* Yw = Y + (size_t)(b * SEQ + q0 + wid * 32) * 1024 + TYPE * 512 + h * 64;
#pragma unroll
    for (int i = 0; i < 4; ++i) { const int row = i * 8 + (lane >> 3), ch = lane & 7; const u32x4 v = *(const ALAS u32x4*)(stg + row * 64 + ch * 8); *(u32x4*)(Yw + (size_t)row * 1024 + ch * 8) = v; }
    __syncthreads();
}
#undef ALAS
}

constexpr int NWAVES = 8;
constexpr size_t MiB = 1u << 20;
constexpr size_t WS_CTL = 0, CTL_ZERO_BYTES = 256 * 1024;
constexpr size_t WS_KMEAN = 64 * 1024;
constexpr size_t WS_MOD = 256 * 1024;
constexpr size_t WS_WFG = 448 * 1024;
constexpr size_t WS_GAINS = 480 * 1024;
constexpr size_t WS_LF = 512 * 1024;
constexpr size_t WS_FC = 1 * MiB;
constexpr size_t WS_PARTS = 2 * MiB;
constexpr size_t WS_WIN = 4 * MiB;
constexpr size_t WS_WFT = 14 * MiB, WS_WMT = 15 * MiB;
constexpr size_t WS_WOT = 16 * MiB;
constexpr size_t WS_WEFF = 18 * MiB;
constexpr size_t WS_HY = 24 * MiB;
constexpr size_t WS_QKV = 56 * MiB;
constexpr size_t WS_MIX = 152 * MiB;
constexpr size_t WS_U8 = 184 * MiB, WS_V8 = 200 * MiB;
constexpr size_t WS_SU = 216 * MiB, WS_SV = 216 * MiB + 65536;
constexpr size_t WS_WT = 220 * MiB;
constexpr size_t WS_EG = 248 * MiB;
constexpr size_t WS_SC = 56 * MiB;
constexpr size_t WS_END = 256 * MiB;
constexpr int CW_BAR = 4096;
constexpr int RING_BYTES = 131072, LDSCTL_OFF = RING_BYTES, MISC_OFF = LDSCTL_OFF + 320, LDS_BYTES = 147456;

#define GAS __attribute__((address_space(1)))
#define LAS __attribute__((address_space(3)))
typedef unsigned short bf16;
typedef unsigned v4u __attribute__((ext_vector_type(4)));
typedef unsigned v2u __attribute__((ext_vector_type(2)));
typedef float f32x4 __attribute__((ext_vector_type(4)));
typedef GAS unsigned gu32;
#define RLX_AGENT __ATOMIC_RELAXED, __HIP_MEMORY_SCOPE_AGENT
#define LDS_WAIT() asm volatile("s_waitcnt lgkmcnt(0)" ::: "memory")
#define VM_WAIT() asm volatile("s_waitcnt vmcnt(0)" ::: "memory")
__device__ __forceinline__ unsigned f2bf(float f) { unsigned u = __builtin_bit_cast(unsigned, f); return (u + 0x7fffu + ((u >> 16) & 1u)) >> 16; }
__device__ __forceinline__ unsigned pk2(float lo, float hi) { return f2bf(lo) | (f2bf(hi) << 16); }
__device__ __forceinline__ float wave_sum(float v) {
#pragma unroll
    for (int o = 1; o < 64; o <<= 1) v += __shfl_xor(v, o);
    return v;
}
#define XB_TMO      128
#define XB_XCNT(j)  (256  + 64 * (j))
#define XB_XSUB(j)  (1280 + 64 * (j))
#define XB_XGEN(j)  (2304 + 64 * (j))
#define XB_TOP      3328
#define XB_TOPGEN   3392
#define XCD_BAR_WORDS 3456
#define XB_SPIN_CAP (1u << 18)

__device__ __forceinline__ unsigned xb_ld(unsigned* p)              { return __hip_atomic_load(p, __ATOMIC_RELAXED, __HIP_MEMORY_SCOPE_AGENT); }
__device__ __forceinline__ unsigned xb_add(unsigned* p, unsigned v) { return __hip_atomic_fetch_add(p, v, __ATOMIC_RELAXED, __HIP_MEMORY_SCOPE_AGENT); }
__device__ __forceinline__ unsigned xb_xcc_id() { return (unsigned)__builtin_amdgcn_s_getreg((3 << 11) | 20) & 0xFu; }
#define XB_SPIN(cond, bar) do { unsigned _sp = 0; while (cond) { __builtin_amdgcn_s_sleep(1); \
    if ((++_sp & 255u) == 0u) { if (xb_ld(&(bar)[XB_TMO])) break; if (_sp > XB_SPIN_CAP) { atomicAdd(&(bar)[XB_TMO], 1u); break; } } } } while (0)

struct XcdBarrier {
    unsigned* bar; unsigned x;
    volatile LAS unsigned* st;
};

__device__ __forceinline__ XcdBarrier xcd_barrier_post(unsigned* bar, volatile LAS unsigned* st) {
    XcdBarrier b; b.bar = bar; b.x = xb_xcc_id(); b.st = st;
    if (threadIdx.x == 0) (void)xb_add(&bar[XB_XCNT(b.x)], 1u);
    return b;
}
__device__ __forceinline__ void xcd_barrier_complete(unsigned* bar, unsigned x, unsigned& nloc, unsigned& nx) {
    const unsigned G = gridDim.x * gridDim.y * gridDim.z;
    unsigned sum, cnt, mine, sp = 0u;
    for (;;) {
        sum = 0u; cnt = 0u; mine = 0u;
#pragma unroll
        for (unsigned j = 0; j < 16; ++j) { const unsigned c = xb_ld(&bar[XB_XCNT(j)]); sum += c; cnt += (c > 0u) ? 1u : 0u; mine = (j == x) ? c : mine; }
        if (sum == G) break;
        __builtin_amdgcn_s_sleep(1);
        if ((++sp & 255u) == 0u) { if (xb_ld(&bar[XB_TMO])) break; if (sp > XB_SPIN_CAP) { atomicAdd(&bar[XB_TMO], 1u); break; } }
    }
    nloc = mine > 0u ? mine : 1u; nx = cnt > 0u ? cnt : 1u;
}

__device__ __forceinline__ void xcd_barrier(const XcdBarrier& b) {
    asm volatile("s_waitcnt vmcnt(0)" ::: "memory");
    __syncthreads();
    if (threadIdx.x == 0) {
        unsigned* bar = b.bar;
        __builtin_amdgcn_s_waitcnt(0);
        unsigned nloc = b.st[0], nx = b.st[1];
        if (nloc == 0u) { xcd_barrier_complete(bar, b.x, nloc, nx); b.st[0] = nloc; b.st[1] = nx; }
        const unsigned old = xb_add(&bar[XB_XSUB(b.x)], 1u);
        const unsigned gen = old / nloc;
        if (old + 1u == (gen + 1u) * nloc) {
            __builtin_amdgcn_fence(__ATOMIC_RELEASE, "agent");
            asm volatile("s_waitcnt vmcnt(0)" ::: "memory");
            const unsigned og = xb_add(&bar[XB_TOP], 1u);
            const unsigned tg = og / nx;
            if (og + 1u == (tg + 1u) * nx) xb_add(&bar[XB_TOPGEN], 1u);
            else XB_SPIN(xb_ld(&bar[XB_TOPGEN]) == tg, bar);
            __builtin_amdgcn_fence(__ATOMIC_ACQUIRE, "agent");
            xb_add(&bar[XB_XGEN(b.x)], 1u);
            asm volatile("s_waitcnt vmcnt(0)" ::: "memory");
        } else {
            XB_SPIN(xb_ld(&bar[XB_XGEN(b.x)]) == gen, bar);
            __builtin_amdgcn_fence(__ATOMIC_ACQUIRE, "agent");
            asm volatile("s_waitcnt vmcnt(0)" ::: "memory");
        }
    }
    __syncthreads();
}

struct Frame {
    LAS unsigned char* lds; int tid, lane, wave, G, bid;
    const float *x, *c, *w_ada, *b_ada, *norm1_g, *w_in, *b_fgate, *fox_q_g, *fox_k_g, *moba_q_g, *moba_k_g, *w_up_fox, *w_up_moba, *w_out, *norm2_g, *w_peer_q, *sub_keys, *peer_u, *peer_v;
    float* out; unsigned char* ws;
};

__device__ __forceinline__ void tr_item(const float* W, int ldw, int col0, int k0, bf16* WT, int ldt, int row0, LAS float* scr, int lane) {
#pragma unroll 8
    for (int i = 0; i < 32; ++i) { const int kk = 2 * i + (lane >> 5); scr[kk * 33 + (lane & 31)] = W[(size_t)(k0 + kk) * ldw + col0 + (lane & 31)]; }
    LDS_WAIT(); asm volatile("" ::: "memory");
    const int c = lane & 7;
#pragma unroll
    for (int j = 0; j < 4; ++j) { const int n = (lane >> 3) + 8 * j; const LAS float* s = scr + (8 * c) * 33 + n;
        v4u o; o.x = pk2(s[0 * 33], s[1 * 33]); o.y = pk2(s[2 * 33], s[3 * 33]); o.z = pk2(s[4 * 33], s[5 * 33]); o.w = pk2(s[6 * 33], s[7 * 33]);
        *(GAS v4u*)(WT + (size_t)(row0 + n) * ldt + k0 + 8 * c) = o; }
    LDS_WAIT(); asm volatile("" ::: "memory");
}

__device__ __forceinline__ void p0_prep(Frame& F) {
    const int tid = F.tid, lane = F.lane, wave = F.wave, G = F.G;
    float* mod = (float*)(F.ws + WS_MOD);
    {
        LAS float* Kt = (LAS float*)F.lds; LAS float* Wt = Kt + 128 * 128;
        bf16* WeffT = (bf16*)(F.ws + WS_WEFF);
        for (int it = F.bid; it < 256; it += G) {
            const int hp = it >> 4, d0 = (it & 15) * 64;
            const float* keys = F.sub_keys + (size_t)hp * 128 * 128;
#pragma unroll
            for (int i = 0; i < 8; ++i) { const int idx = (i * 512 + tid) * 4, n = idx >> 7, cc = idx & 127; const f32x4 v = *(const f32x4*)(keys + idx);
                Kt[(cc + 0) * 128 + n] = v[0]; Kt[(cc + 1) * 128 + n] = v[1]; Kt[(cc + 2) * 128 + n] = v[2]; Kt[(cc + 3) * 128 + n] = v[3]; }
#pragma unroll
            for (int i = 0; i < 4; ++i) { const int idx = (i * 512 + tid) * 4, dd = idx >> 7, cc = idx & 127; const f32x4 v = *(const f32x4*)(F.w_peer_q + (size_t)(d0 + dd) * 2048 + hp * 128 + cc);
                Wt[(cc + 0) * 64 + dd] = v[0]; Wt[(cc + 1) * 64 + dd] = v[1]; Wt[(cc + 2) * 64 + dd] = v[2]; Wt[(cc + 3) * 64 + dd] = v[3]; }
            __syncthreads();
            const int tn = tid & 31, td = tid >> 5;
            float acc[4][4];
#pragma unroll
            for (int i = 0; i < 4; ++i)
#pragma unroll
                for (int j = 0; j < 4; ++j) acc[i][j] = 0.f;
            for (int cc = 0; cc < 128; ++cc) { const f32x4 kv = *(const LAS f32x4*)(Kt + cc * 128 + 4 * tn), wv = *(const LAS f32x4*)(Wt + cc * 64 + 4 * td);
#pragma unroll
                for (int i = 0; i < 4; ++i)
#pragma unroll
                    for (int j = 0; j < 4; ++j) acc[i][j] += kv[i] * wv[j]; }
#pragma unroll
            for (int i = 0; i < 4; ++i) { v2u o; o.x = pk2(acc[i][0], acc[i][1]); o.y = pk2(acc[i][2], acc[i][3]); *(GAS v2u*)(WeffT + (size_t)(hp * 128 + 4 * tn + i) * 1024 + d0 + 4 * td) = o; }
            __syncthreads();
        }
    }
    {
        LAS float* sc = (LAS float*)F.lds; LAS float* red = sc + 8192;
        for (int it = F.bid; it < 96; it += G) {
            for (int i = tid; i < 8192; i += 512) { const int bb = i >> 10, k = i & 1023; const float v = F.c[i]; sc[k * 8 + bb] = v / (1.0f + expf(-v)); }
            __syncthreads();
            const int n = it * 64 + lane; float a[8];
#pragma unroll
            for (int bb = 0; bb < 8; ++bb) a[bb] = 0.f;
#pragma unroll 4
            for (int k = wave * 128; k < wave * 128 + 128; ++k) { const float w = F.w_ada[(size_t)k * 6144 + n]; const f32x4 s0 = *(const LAS f32x4*)(sc + k * 8), s1 = *(const LAS f32x4*)(sc + k * 8 + 4);
                a[0] += w * s0[0]; a[1] += w * s0[1]; a[2] += w * s0[2]; a[3] += w * s0[3]; a[4] += w * s1[0]; a[5] += w * s1[1]; a[6] += w * s1[2]; a[7] += w * s1[3]; }
#pragma unroll
            for (int bb = 0; bb < 8; ++bb) red[(wave * 8 + bb) * 64 + lane] = a[bb];
            __syncthreads();
            { const int bb = tid >> 6; float s = 0.f;
#pragma unroll
              for (int w = 0; w < 8; ++w) s += red[(w * 8 + bb) * 64 + lane];
              mod[bb * 6144 + it * 64 + lane] = s + F.b_ada[it * 64 + lane]; }
            __syncthreads();
        }
    }
    {
        LAS float* scr = (LAS float*)(F.lds + wave * 16384);
        const int gw = F.bid * NWAVES + wave, NGW = G * NWAVES;
        constexpr int I_IN = 16 * 160, I_UP = 8 * 32, I_OUT = 16 * 32;
        for (int it = gw; it < I_IN + 2 * I_UP + I_OUT; it += NGW) {
            int r = it;
            if (r < I_IN) { const int kb = r / 160, rb = r % 160, tile = rb >> 3, bj = (rb >> 2) & 1, wc = rb & 3; const int Lg = tile * 256 + 64 * wc + 32 * bj; const int src = Lg < 1536 ? Lg : Lg + 8;
                tr_item(F.w_in, IN_COLS, src, kb * 64, (bf16*)(F.ws + WS_WIN), 1024, rb * 32, scr, lane); continue; }
            r -= I_IN;
            if (r < I_UP) { tr_item(F.w_up_fox, 1024, (r & 31) * 32, (r >> 5) * 64, (bf16*)(F.ws + WS_WFT), 512, (r & 31) * 32, scr, lane); continue; }
            r -= I_UP;
            if (r < I_UP) { tr_item(F.w_up_moba, 1024, (r & 31) * 32, (r >> 5) * 64, (bf16*)(F.ws + WS_WMT), 512, (r & 31) * 32, scr, lane); continue; }
            r -= I_UP;
            tr_item(F.w_out, 1024, (r & 31) * 32, (r >> 5) * 64, (bf16*)(F.ws + WS_WOT), 1024, (r & 31) * 32, scr, lane);
        }
    }
    {
        const size_t gt = (size_t)F.bid * 512 + tid, NT_ = (size_t)G * 512;
        float* wfg = (float*)(F.ws + WS_WFG);
        for (size_t i = gt; i < 8192; i += NT_) { const int j = (int)(i >> 10), k = (int)(i & 1023); wfg[i] = F.w_in[(size_t)k * IN_COLS + 1536 + j]; }
        if (gt < 64) { float* gn = (float*)(F.ws + WS_GAINS); gn[gt] = F.fox_q_g[gt]; gn[64 + gt] = F.fox_k_g[gt]; gn[128 + gt] = F.moba_q_g[gt]; gn[192 + gt] = F.moba_k_g[gt]; }
    }
    {
        const int gw = F.bid * NWAVES + wave, NGW = G * NWAVES;
        for (int r = gw; r < 2 * NEXP; r += NGW) {
            const bool isu = r < NEXP; const int rr = isu ? r : r - NEXP;
            const GAS f32x4* src = (const GAS f32x4*)((isu ? F.peer_u : F.peer_v) + (size_t)rr * 1024) + lane;
            f32x4 v[4]; float mx = 0.f;
#pragma unroll
            for (int j = 0; j < 4; ++j) { v[j] = src[64 * j]; mx = fmaxf(mx, fmaxf(fmaxf(fabsf(v[j][0]), fabsf(v[j][1])), fmaxf(fabsf(v[j][2]), fabsf(v[j][3])))); }
#pragma unroll
            for (int o = 1; o < 64; o <<= 1) mx = fmaxf(mx, __shfl_xor(mx, o));
            const float sc = mx > 0.f ? mx * (1.0f / 384.0f) : 1.0f, inv = 1.0f / sc;
            GAS unsigned* dst = (GAS unsigned*)(F.ws + (isu ? WS_U8 : WS_V8) + (size_t)rr * 1024) + lane;
#pragma unroll
            for (int j = 0; j < 4; ++j) { int w = 0; w = __builtin_amdgcn_cvt_pk_fp8_f32(v[j][0] * inv, v[j][1] * inv, w, false); w = __builtin_amdgcn_cvt_pk_fp8_f32(v[j][2] * inv, v[j][3] * inv, w, true); dst[64 * j] = (unsigned)w; }
            if (lane == 0) ((float*)(F.ws + (isu ? WS_SU : WS_SV)))[rr] = sc;
        }
    }
}

template <int SECOND>
__device__ __forceinline__ void rows_phase(Frame& F) {
    const int tid = F.tid, lane = F.lane, wave = F.wave;
    LAS float* Ac = (LAS float*)F.lds; LAS float* Bc = Ac + 1024; LAS float* wfs = Bc + 1024;
    const float* mod = (const float*)(F.ws + WS_MOD);
    const float* src = SECOND ? F.out : F.x;
    const float* gain = SECOND ? F.norm2_g : F.norm1_g;
    bf16* dst = (bf16*)(F.ws + WS_HY);
    if (!SECOND) { const float* wfg = (const float*)(F.ws + WS_WFG); for (int i = tid; i < 8192; i += 512) wfs[i] = wfg[i]; }
    for (int it = F.bid; it < 256; it += F.G) {
        const int b = it >> 5;
        const float* shift = mod + (size_t)b * 6144 + (SECOND ? 3072 : 0); const float* scale = shift + 1024;
        __syncthreads();
        for (int i = tid; i < 1024; i += 512) { Ac[i] = gain[i] * (1.0f + scale[i]); Bc[i] = shift[i]; }
        __syncthreads();
        for (int i = 0; i < 8; ++i) {
            const int row = it * 64 + wave * 8 + i;
            const GAS f32x4* xr = (const GAS f32x4*)(src + (size_t)row * 1024) + lane;
            f32x4 v[4]; float ss = 0.f;
#pragma unroll
            for (int j = 0; j < 4; ++j) { v[j] = xr[64 * j]; ss += (v[j][0] * v[j][0] + v[j][1] * v[j][1]) + (v[j][2] * v[j][2] + v[j][3] * v[j][3]); }
            float rstd;
            if (SECOND) { const float* pp = (const float*)(F.ws + WS_PARTS) + (size_t)row * 16; float s = 0.f;
#pragma unroll
                for (int q = 0; q < 16; ++q) s += pp[q];
                rstd = rsqrtf(s * (1.0f / 1024.0f) + RMS_EPS); }
            else rstd = rsqrtf(wave_sum(ss) * (1.0f / 1024.0f) + RMS_EPS);
            float p[8];
#pragma unroll
            for (int q = 0; q < 8; ++q) p[q] = 0.f;
            GAS v2u* o8 = (GAS v2u*)(dst + (size_t)row * 1024) + lane;
#pragma unroll
            for (int j = 0; j < 4; ++j) {
                const int col = 4 * (64 * j + lane);
                const f32x4 a = *(const LAS f32x4*)(Ac + col), bb = *(const LAS f32x4*)(Bc + col);
                const f32x4 hv = v[j] * rstd * a + bb;
                v2u o; o.x = pk2(hv[0], hv[1]); o.y = pk2(hv[2], hv[3]); o8[64 * j] = o;
                if (!SECOND) {
#pragma unroll
                    for (int q = 0; q < 8; ++q) { const f32x4 w = *(const LAS f32x4*)(wfs + q * 1024 + col); p[q] += (hv[0] * w[0] + hv[1] * w[1]) + (hv[2] * w[2] + hv[3] * w[3]); }
                }
            }
            if (!SECOND) {
                float mine = 0.f;
#pragma unroll
                for (int q = 0; q < 8; ++q) { const float s = wave_sum(p[q]); mine = (lane == q) ? s : mine; }
                if (lane < 8) { const float z = mine + F.b_fgate[lane]; const float ls = fminf(z, 0.f) - log1pf(expf(-fabsf(z))); ((float*)(F.ws + WS_LF))[(size_t)row * 8 + lane] = ls; }
            }
        }
    }
    __syncthreads();
}

__device__ __forceinline__ void fcum_items(Frame& F) {
    LAS float* wtot = (LAS float*)F.lds;
    const float* LFp = (const float*)(F.ws + WS_LF); float* Fc = (float*)(F.ws + WS_FC);
    for (int it = F.bid; it < 64; it += F.G) {
        const int b = it >> 3, h = it & 7, s0 = 4 * F.tid;
        float v[4];
#pragma unroll
        for (int i = 0; i < 4; ++i) v[i] = LFp[((size_t)b * SEQ + s0 + i) * 8 + h];
        v[1] += v[0]; v[2] += v[1]; v[3] += v[2];
        float inc = v[3];
#pragma unroll
        for (int o = 1; o < 64; o <<= 1) { const float t = __shfl_up(inc, o); if (F.lane >= o) inc += t; }
        __syncthreads();
        if (F.lane == 63) wtot[F.wave] = inc;
        __syncthreads();
        float base = inc - v[3];
        for (int w = 0; w < F.wave; ++w) base += wtot[w];
        float* o = Fc + (size_t)(b * NHEAD + h) * SEQ + s0;
#pragma unroll
        for (int i = 0; i < 4; ++i) o[i] = base + v[i];
    }
    __syncthreads();
}

__device__ __forceinline__ unsigned okey(float f) { const unsigned u = __float_as_uint(f); return (u & 0x80000000u) ? ~u : (u | 0x80000000u); }
__device__ __forceinline__ float okey_inv(unsigned k) { return __uint_as_float((k & 0x80000000u) ? (k ^ 0x80000000u) : ~k); }
__device__ __forceinline__ void chain16(unsigned (&L)[16], unsigned x) {
#pragma unroll
    for (int k = 0; k < 16; ++k) { const unsigned hi = L[k] > x ? L[k] : x; x = L[k] > x ? x : L[k]; L[k] = hi; }
}
__device__ __forceinline__ void top16_of_128(const float* p, unsigned (&L)[16]) {
#pragma unroll
    for (int k = 0; k < 16; ++k) L[k] = 0u;
    for (int c = 0; c < 4; ++c) {
        f32x4 v[8];
#pragma unroll
        for (int j = 0; j < 8; ++j) v[j] = *(const f32x4*)(p + c * 32 + j * 4);
#pragma unroll
        for (int j = 0; j < 8; ++j)
#pragma unroll
            for (int e = 0; e < 4; ++e) chain16(L, (okey(v[j][e]) & ~127u) | (unsigned)(127 - (c * 32 + j * 4 + e)));
    }
}
__device__ __forceinline__ void topk_phase(Frame& F) {
    const float* SC = (const float*)(F.ws + WS_SC); unsigned* EG = (unsigned*)(F.ws + WS_EG);
    LAS unsigned char* tab = F.lds + F.tid * 32;
    for (int th = F.bid * 512 + F.tid; th < NTOK * 8; th += F.G * 512) {
        const float* p = SC + (size_t)th * 256;
        unsigned L1[16], L2[16];
        top16_of_128(p, L1); top16_of_128(p + 128, L2);
        float v1[16], v2[16];
#pragma unroll
        for (int k = 0; k < 16; ++k) { v1[k] = okey_inv(L1[k] & ~127u); tab[k] = (unsigned char)(127u - (L1[k] & 127u)); v2[k] = okey_inv(L2[k] & ~127u); tab[16 + k] = (unsigned char)(127u - (L2[k] & 127u)); }
        unsigned C[16];
#pragma unroll
        for (int j = 0; j < 16; ++j) C[j] = (okey(v1[0] + v2[j]) & ~255u) | (unsigned)(255 - j);
#pragma unroll
        for (int i = 1; i < 16; ++i)
#pragma unroll
            for (int j = 0; j < 16 / (i + 1); ++j) chain16(C, (okey(v1[i] + v2[j]) & ~255u) | (unsigned)(255 - (i * 16 + j)));
        float sv[16]; float sum = 0.f; const float mx = okey_inv(C[0] & ~255u);
#pragma unroll
        for (int k = 0; k < 16; ++k) { sv[k] = expf(okey_inv(C[k] & ~255u) - mx); sum += sv[k]; }
        const float rs = 1.0f / sum;
        unsigned o[16];
#pragma unroll
        for (int k = 0; k < 16; ++k) { const int pos = 255 - (int)(C[k] & 255u); const unsigned eid = (unsigned)tab[pos >> 4] * 128u + (unsigned)tab[16 + (pos & 15)];
            const _Float16 hg = (_Float16)(sv[k] * rs); o[k] = ((unsigned)__builtin_bit_cast(unsigned short, hg) << 16) | eid; }
        GAS v4u* dst = (GAS v4u*)(EG + (size_t)th * 16);
#pragma unroll
        for (int q = 0; q < 4; ++q) dst[q] = (v4u){o[4 * q], o[4 * q + 1], o[4 * q + 2], o[4 * q + 3]};
    }
}

typedef float f32x2v __attribute__((ext_vector_type(2)));
__device__ __forceinline__ float gelu_tanh(float a) { const float y = 0.7978845608028654f * (a + 0.044715f * a * a * a); const float th = 1.0f - 2.0f / (__expf(2.0f * y) + 1.0f); return 0.5f * a * (1.0f + th); }
__device__ __forceinline__ void fp8x16_to_f32(const v4u r, float (&f)[16]) {
#pragma unroll
    for (int q = 0; q < 4; ++q) { const f32x2v lo = __builtin_amdgcn_cvt_pk_f32_fp8((int)r[q], false), hi = __builtin_amdgcn_cvt_pk_f32_fp8((int)r[q], true); f[4 * q] = lo[0]; f[4 * q + 1] = lo[1]; f[4 * q + 2] = hi[0]; f[4 * q + 3] = hi[1]; }
}
__device__ __forceinline__ void peer_u_phase(Frame& F) {
    const int lane = F.lane, wave = F.wave;
    const bool sliced = (F.G % 8) == 0;
    const int x_lo = sliced ? (F.bid & 7) : 0, x_hi = sliced ? x_lo + 1 : 8;
    const int wv = sliced ? (F.bid >> 3) * NWAVES + wave : F.bid * NWAVES + wave, NW = sliced ? (F.G >> 3) * NWAVES : F.G * NWAVES;
    const unsigned* EG = (const unsigned*)(F.ws + WS_EG); const bf16* H2 = (const bf16*)(F.ws + WS_HY);
    const unsigned char* U8 = F.ws + WS_U8; const float* SU = (const float*)(F.ws + WS_SU); const float* SV = (const float*)(F.ws + WS_SV);
    float* Wt = (float*)(F.ws + WS_WT);
    const bool b5 = (lane & 32) != 0, b4 = (lane & 16) != 0, b3 = (lane & 8) != 0;
    for (int x = x_lo; x < x_hi; ++x)
    for (int t = wv; t < NTOK; t += NW) {
        const unsigned eg0 = EG[(size_t)t * 128 + lane], eg1 = EG[(size_t)t * 128 + 64 + lane];
        float hf[16];
        { const v4u ha = *(const GAS v4u*)(H2 + (size_t)t * 1024 + 16 * lane), hb = *(const GAS v4u*)(H2 + (size_t)t * 1024 + 16 * lane + 8);
#pragma unroll
          for (int q = 0; q < 4; ++q) { hf[2 * q] = pg8::bf_lo(ha[q]); hf[2 * q + 1] = pg8::bf_hi(ha[q]); hf[8 + 2 * q] = pg8::bf_lo(hb[q]); hf[8 + 2 * q + 1] = pg8::bf_hi(hb[q]); } }
        unsigned long long m0 = __ballot((int)(((eg0 & 0xffffu) >> 11) == (unsigned)x)), m1 = __ballot((int)(((eg1 & 0xffffu) >> 11) == (unsigned)x));
        while (m0 | m1) {
            int kv = -1; unsigned ev = 0u, gv = 0u; v4u r[8]; unsigned e_first = 0u;
#pragma unroll
            for (int i = 0; i < 8; ++i) {
                int k = -1;
                if (m0) { k = __builtin_ctzll(m0); m0 &= m0 - 1ull; } else if (m1) { k = 64 + __builtin_ctzll(m1); m1 &= m1 - 1ull; }
                unsigned egs = 0u;
                if (k >= 0) { const unsigned s0 = (unsigned)__builtin_amdgcn_readlane((int)eg0, k & 63), s1 = (unsigned)__builtin_amdgcn_readlane((int)eg1, k & 63); egs = (k < 64) ? s0 : s1; }
                unsigned e = egs & 0xffffu; if (i == 0) e_first = e; if (k < 0) e = e_first;
                r[i] = *(const GAS v4u*)(U8 + (size_t)e * 1024 + 16 * lane);
                if ((lane >> 3) == i) { kv = k; ev = e; gv = egs >> 16; }
            }
            float p[8];
#pragma unroll
            for (int i = 0; i < 8; ++i) { float f[16]; fp8x16_to_f32(r[i], f); float a = 0.f;
#pragma unroll
                for (int c = 0; c < 16; ++c) a += f[c] * hf[c];
                p[i] = a; }
            float q4[4], r2[2];
#pragma unroll
            for (int i = 0; i < 4; ++i) { const float keep = b5 ? p[4 + i] : p[i], send = b5 ? p[i] : p[4 + i]; q4[i] = keep + __shfl_xor(send, 32); }
#pragma unroll
            for (int i = 0; i < 2; ++i) { const float keep = b4 ? q4[2 + i] : q4[i], send = b4 ? q4[i] : q4[2 + i]; r2[i] = keep + __shfl_xor(send, 16); }
            float s = (b3 ? r2[1] : r2[0]) + __shfl_xor(b3 ? r2[0] : r2[1], 8);
            s += __shfl_xor(s, 4); s += __shfl_xor(s, 2); s += __shfl_xor(s, 1);
            if ((lane & 7) == 0 && kv >= 0) {
                const float a = s * SU[ev];
                Wt[(size_t)t * 128 + kv] = (float)__builtin_bit_cast(_Float16, (unsigned short)gv) * gelu_tanh(a) * SV[ev];
            }
        }
    }
}
__device__ __forceinline__ void peer_v_phase(Frame& F, bool dry) {
    const int lane = F.lane, wave = F.wave;
    const bool sliced = (F.G % 8) == 0;
    const int x_lo = sliced ? (F.bid & 7) : 0, x_hi = sliced ? x_lo + 1 : 8;
    const int wv = sliced ? (F.bid >> 3) * NWAVES + wave : F.bid * NWAVES + wave, NW = sliced ? (F.G >> 3) * NWAVES : F.G * NWAVES;
    const unsigned* EG = (const unsigned*)(F.ws + WS_EG); const float* Wt = (const float*)(F.ws + WS_WT);
    const unsigned char* V8 = F.ws + WS_V8; const float* mod = (const float*)(F.ws + WS_MOD);
    const bool b5 = (lane & 32) != 0, b4 = (lane & 16) != 0, b3 = (lane & 8) != 0;
    for (int x = x_lo; x < x_hi; ++x)
    for (int t = wv; t < NTOK; t += NW) {
        const unsigned eg0 = EG[(size_t)t * 128 + lane], eg1 = EG[(size_t)t * 128 + 64 + lane];
        const float w0 = Wt[(size_t)t * 128 + lane], w1 = Wt[(size_t)t * 128 + 64 + lane];
        v4u r[16]; float wk[16];
#pragma unroll
        for (int i = 0; i < 16; ++i) { const int srcl = (8 * i + (lane >> 3)) & 63; const unsigned e = (unsigned)__shfl((int)(i < 8 ? eg0 : eg1), srcl) & 0xffffu; wk[i] = __shfl(i < 8 ? w0 : w1, srcl);
            r[i] = *(const GAS v4u*)(V8 + (size_t)e * 1024 + 128 * x + 16 * (lane & 7)); }
        float acc[16];
#pragma unroll
        for (int c = 0; c < 16; ++c) acc[c] = 0.f;
#pragma unroll
        for (int i = 0; i < 16; ++i) { float f[16]; fp8x16_to_f32(r[i], f);
#pragma unroll
            for (int c = 0; c < 16; ++c) acc[c] += wk[i] * f[c]; }
        float r8[8], r4[4], r2[2];
#pragma unroll
        for (int c = 0; c < 8; ++c) { const float keep = b3 ? acc[8 + c] : acc[c], send = b3 ? acc[c] : acc[8 + c]; r8[c] = keep + __shfl_xor(send, 8); }
#pragma unroll
        for (int c = 0; c < 4; ++c) { const float keep = b4 ? r8[4 + c] : r8[c], send = b4 ? r8[c] : r8[4 + c]; r4[c] = keep + __shfl_xor(send, 16); }
#pragma unroll
        for (int c = 0; c < 2; ++c) { const float keep = b5 ? r4[2 + c] : r4[c], send = b5 ? r4[c] : r4[2 + c]; r2[c] = keep + __shfl_xor(send, 32); }
        const int col = 128 * x + 16 * (lane & 7) + (b3 ? 8 : 0) + (b4 ? 4 : 0) + (b5 ? 2 : 0);
        const int b = t >> 11; const float* g2 = mod + (size_t)b * 6144 + 5120;
        float* orow = F.out + (size_t)t * 1024;
        const f32x2v xv = *(const GAS f32x2v*)(orow + col), gvv = *(const GAS f32x2v*)(g2 + col);
        f32x2v o; o[0] = xv[0] + gvv[0] * r2[0]; o[1] = xv[1] + gvv[1] * r2[1];
        *(GAS f32x2v*)((dry ? (float*)(F.ws + WS_SC) + (size_t)t * 1024 : orow) + col) = o;
    }
}

constexpr int N_PHASES = 11;
struct Args { const float* in[19]; float* out; unsigned char* ws; int ph_lo, ph_hi; };
__global__ void __launch_bounds__(NWAVES * 64, 2) fwd_kernel(Args args) {
    extern __shared__ __attribute__((aligned(16))) unsigned char lds_raw[];
    Frame F;
    F.lds = (LAS unsigned char*)lds_raw;
    F.tid = threadIdx.x; F.lane = F.tid & 63; F.wave = __builtin_amdgcn_readfirstlane(F.tid >> 6); F.G = gridDim.x; F.bid = blockIdx.x;
    F.x = args.in[0]; F.c = args.in[1]; F.w_ada = args.in[2]; F.b_ada = args.in[3]; F.norm1_g = args.in[4]; F.w_in = args.in[5]; F.b_fgate = args.in[6];
    F.fox_q_g = args.in[7]; F.fox_k_g = args.in[8]; F.moba_q_g = args.in[9]; F.moba_k_g = args.in[10]; F.w_up_fox = args.in[11]; F.w_up_moba = args.in[12];
    F.w_out = args.in[13]; F.norm2_g = args.in[14]; F.w_peer_q = args.in[15]; F.sub_keys = args.in[16]; F.peer_u = args.in[17]; F.peer_v = args.in[18];
    F.out = args.out; F.ws = args.ws;
    unsigned char* ws = args.ws;
    volatile LAS unsigned* MISC = (volatile LAS unsigned*)(F.lds + MISC_OFF);
    for (int u = F.tid; u < (LDS_BYTES - LDSCTL_OFF) / 4; u += NWAVES * 64) ((LAS unsigned*)(F.lds + LDSCTL_OFF))[u] = 0u;
    __syncthreads();
#if !MK_PER_PHASE
    XcdBarrier bar = xcd_barrier_post((unsigned*)(ws + WS_CTL) + CW_BAR, MISC + 8);
#define GRID_BAR() xcd_barrier(bar)
#else
    (void)MISC;
#define GRID_BAR() do {} while (0)
#endif
    const int lo = args.ph_lo, hi = args.ph_hi;
#define IN(k) (lo <= (k) && (k) < hi)
#define REPS(k) (((k) == DUP_PHASE) ? DUP_N : 1)
#define REP(k) for (int rep_ = 0; rep_ < REPS(k); ++rep_)
#define REPBAR(k) do { if (rep_ + 1 < REPS(k)) GRID_BAR(); } while (0)
#define SEAM(k) do { if (IN(k) && IN((k) + 1)) GRID_BAR(); } while (0)
    typedef pg8::bf16_t pb;

    if (IN(0)) REP(0) { p0_prep(F); REPBAR(0); } SEAM(0);
    if (IN(1)) REP(1) { rows_phase<0>(F); REPBAR(1); } SEAM(1);
    if (IN(2)) REP(2) {
        fcum_items(F);
        pg8::Gemm g{(const pb*)(ws + WS_HY), (const pb*)(ws + WS_WIN), NTOK, NIN, DM, DM, DM}; pg8::StaticOrder S; S.init(NTOK, NIN, F.G, F.bid);
        pg8::EpiIn E{(pb*)(ws + WS_QKV), (pb*)F.out, (const float*)(ws + WS_GAINS), (float*)(ws + ((rep_ + 1 < REPS(2)) ? WS_EG : WS_KMEAN))};
        pg8::gemm_phase<pg8::EpiIn, pg8::StaticOrder, true, true>(F.lds, g, S, E);
        REPBAR(2);
    } SEAM(2);
    if (IN(3)) REP(3) {
        const pb* qkv = (const pb*)(ws + WS_QKV); constexpr size_t TS = (size_t)NTOK * 512;
        for (int it = F.bid; it < 256; it += F.G) {
            const int bh = it >> 2, s = it & 3, b = bh >> 3, h = bh & 7;
            att::attn_unit<0>(b, h, 7 - s, qkv, qkv + TS, qkv + 2 * TS, (const float*)(ws + WS_FC), nullptr, (pb*)(ws + WS_HY), (__attribute__((address_space(3))) char*)F.lds);
            att::attn_unit<1>(b, h, 7 - s, qkv + 3 * TS, qkv + 4 * TS, qkv + 5 * TS, nullptr, (const float*)(ws + WS_KMEAN), (pb*)(ws + WS_HY), (__attribute__((address_space(3))) char*)F.lds);
            att::attn_unit<0>(b, h, s, qkv, qkv + TS, qkv + 2 * TS, (const float*)(ws + WS_FC), nullptr, (pb*)(ws + WS_HY), (__attribute__((address_space(3))) char*)F.lds);
            att::attn_unit<1>(b, h, s, qkv + 3 * TS, qkv + 4 * TS, qkv + 5 * TS, nullptr, (const float*)(ws + WS_KMEAN), (pb*)(ws + WS_HY), (__attribute__((address_space(3))) char*)F.lds);
        }
        REPBAR(3);
    } SEAM(3);
    if (IN(4)) {
        pg8::StaticOrder S; S.init(NTOK, DM, F.G, F.bid);
        { pg8::Gemm g{(const pb*)(ws + WS_HY), (const pb*)(ws + WS_WFT), NTOK, DM, 512, DM, 512};
          pg8::EpiUp<0> E{(const pb*)F.out, (pb*)(ws + WS_MIX)}; pg8::gemm_phase<pg8::EpiUp<0>, pg8::StaticOrder, true, true>(F.lds, g, S, E); }
        VM_WAIT(); __syncthreads();
        { pg8::Gemm g{(const pb*)(ws + WS_HY) + 512, (const pb*)(ws + WS_WMT), NTOK, DM, 512, DM, 512};
          pg8::EpiUp<1> E{(const pb*)F.out, (pb*)(ws + WS_MIX)}; pg8::gemm_phase<pg8::EpiUp<1>, pg8::StaticOrder, true, true>(F.lds, g, S, E); }
    } SEAM(4);
    if (IN(5)) {
        pg8::Gemm g{(const pb*)(ws + WS_MIX), (const pb*)(ws + WS_WOT), NTOK, DM, DM, DM, DM}; pg8::StaticOrder S; S.init(NTOK, DM, F.G, F.bid);
        pg8::EpiOut E{F.x, (const float*)(ws + WS_MOD), F.out, (float*)(ws + WS_PARTS)};
        pg8::gemm_phase<pg8::EpiOut, pg8::StaticOrder, true, true>(F.lds, g, S, E);
    } SEAM(5);
    if (IN(6)) { rows_phase<1>(F); } SEAM(6);
    if (IN(7)) REP(7) {
        pg8::Gemm g{(const pb*)(ws + WS_HY), (const pb*)(ws + WS_WEFF), NTOK, NSC, DM, DM, DM}; pg8::StaticOrder S; S.init(NTOK, NSC, F.G, F.bid);
        pg8::EpiSc E{(float*)(ws + WS_SC)};
        pg8::gemm_phase<pg8::EpiSc, pg8::StaticOrder, true, true>(F.lds, g, S, E);
        REPBAR(7);
    } SEAM(7);
    if (IN(8)) REP(8) { topk_phase(F); REPBAR(8); } SEAM(8);
    if (IN(9)) REP(9) { peer_u_phase(F); REPBAR(9); } SEAM(9);
    if (IN(10)) REP(10) { peer_v_phase(F, rep_ + 1 < REPS(10)); REPBAR(10); }
#undef IN
#undef SEAM
}

extern "C" void kernel_launch(void* const* d_in, const int* in_sizes, int n_in, void* d_out, int out_size, void* d_ws, size_t ws_size, hipStream_t stream) {
    static int grid = 0;
    if (grid == 0) {
        if (n_in != 19 || out_size != NTOK * DM || ws_size < WS_END) { fprintf(stderr, "kernel_launch: unexpected shapes (n_in %d, out %d, ws %zu); nothing launched\n", n_in, out_size, ws_size); grid = -1; return; }
        int dev = 0, cus = 0, per_cu = 0;
        if (hipGetDevice(&dev) != hipSuccess || hipDeviceGetAttribute(&cus, hipDeviceAttributeMultiprocessorCount, dev) != hipSuccess) { grid = -1; return; }
        if (hipFuncSetAttribute((const void*)fwd_kernel, hipFuncAttributeMaxDynamicSharedMemorySize, LDS_BYTES) != hipSuccess) { fprintf(stderr, "kernel_launch: hipFuncSetAttribute failed\n"); grid = -1; return; }
        if (hipOccupancyMaxActiveBlocksPerMultiprocessor(&per_cu, (const void*)fwd_kernel, NWAVES * 64, LDS_BYTES) != hipSuccess || per_cu < 1) { fprintf(stderr, "kernel_launch: occupancy query says %d blocks per CU\n", per_cu); per_cu = 1; }
        (void)hipGetLastError();
        grid = cus;
    }
    if (grid < 0) return;
    (void)hipMemsetAsync((char*)d_ws + WS_CTL, 0, CTL_ZERO_BYTES, stream);
    Args a{};
    for (int i = 0; i < 19; ++i) a.in[i] = (const float*)d_in[i];
    a.out = (float*)d_out; a.ws = (unsigned char*)d_ws;
#if MK_PER_PHASE
    for (int ph = 0; ph < N_PHASES; ++ph) { a.ph_lo = ph; a.ph_hi = ph + 1; hipLaunchKernelGGL(fwd_kernel, dim3(grid), dim3(NWAVES * 64), LDS_BYTES, stream, a); }
#else
    a.ph_lo = 0; a.ph_hi = N_PHASES;
    hipLaunchKernelGGL(fwd_kernel, dim3(grid), dim3(NWAVES * 64), LDS_BYTES, stream, a);
#endif
}
```

```cpp
#include <hip/hip_runtime.h>
#include <hip/hip_bf16.h>
#include <cstdio>
#include <cstdint>
#include <cmath>

#ifndef DUP_PHASE
#define DUP_PHASE -1
#endif
#define DUP_N 2
#ifndef MK_PER_PHASE
#define MK_PER_PHASE 0
#endif

constexpr int NB = 8, SEQ = 2048, DM = 1024, NTOK = NB * SEQ, NHEAD = 8, HDIM = 64;
constexpr int IN_COLS = 5128, NIN = 5120, NSC = 2048, NEXP = 16384;
constexpr float RMS_EPS = 1e-6f;
constexpr float LOG2E = 1.4426950408889634f;
constexpr float QSCALE = 0.125f * LOG2E;

namespace pg8 {
#define PG8_LAS __attribute__((address_space(3)))
typedef unsigned short bf16_t;
typedef short bf16x8 __attribute__((ext_vector_type(8)));
typedef float f32x4 __attribute__((ext_vector_type(4)));
typedef unsigned u32x4 __attribute__((ext_vector_type(4)));
constexpr int BM = 256, BK = 64, HALF = 128, HTB = HALF * BK * 2  , STAGE_BYTES = 8 * HTB, NXCD = 8, WGM = 8;

__host__ __device__ __forceinline__ int lds_byte(int r, int c) { const int st = (r >> 4) * 2 + (c >> 5), rr = r & 15, cc = c & 31, ob = rr * 64 + cc * 2; return st * 1024 + (ob ^ (((ob >> 9) & 1) << 5)); }
__host__ __device__ __forceinline__ void stage_rc(int b, int& R, int& C) { const int st = b / 1024, sb = b % 1024, swz = sb ^ (((sb >> 9) & 1) << 5); R = (st >> 1) * 16 + swz / 64; C = (st & 1) * 32 + (swz % 64) / 2; }
__host__ __device__ __forceinline__ int perm32(int rho) { const int n = rho >> 4, i = rho & 15; return 8 * (i >> 2) + 4 * n + (i & 3); }

struct Unit { int pm, pn; };
struct Gemm { const bf16_t* A; const bf16_t* Bt; int M, N, K, lda, ldb; };

struct StaticOrder {
    int nM, nN, nwg, G, c;
    __host__ __device__ void init(int M, int N, int G_, int c_) { nM = M / BM; nN = N / BM; nwg = nM * nN; G = G_; c = c_; }
    __host__ __device__ bool next(int i, Unit& u) const {
        const long L = (long)i * G + c; if (L >= nwg) return false;
        int wgid = (int)L; { const int q = nwg / NXCD, r = nwg % NXCD, xcd = wgid % NXCD, off = wgid / NXCD; wgid = (xcd < r ? xcd * (q + 1) : r * (q + 1) + (xcd - r) * q) + off; }
        const int nig = WGM * nN, gid = wgid / nig, fm = gid * WGM, gsz = (nM - fm) < WGM ? (nM - fm) : WGM;
        u.pm = fm + ((wgid % nig) % gsz); u.pn = (wgid % nig) / gsz; return true;
    }
    __device__ __forceinline__ void a_ready(const Unit&) const {}
    __device__ __forceinline__ void done(const Unit&) const {}
};

__device__ __forceinline__ unsigned cvt_pk_bf16(float lo, float hi) { unsigned r; asm volatile("v_cvt_pk_bf16_f32 %0, %1, %2" : "=v"(r) : "v"(lo), "v"(hi)); return r; }
__device__ __forceinline__ float bf_lo(unsigned w) { return __uint_as_float(w << 16); }
__device__ __forceinline__ float bf_hi(unsigned w) { return __uint_as_float(w & 0xffff0000u); }
__device__ __forceinline__ float sigmoidf_(float x) { return 1.0f / (1.0f + __expf(-x)); }

struct EpiIn {
    static constexpr bool PERM = true, AFTER_DRAIN = false;
    bf16_t* qkv;
    bf16_t* G;
    const float* gains;
    float* kmean;
    __device__ __forceinline__ void operator()(const f32x4 (&acc)[2][2][4][2], const Unit& u, int wr, int wc, int fr, int fq) const {
        const int pn = u.pn;
        if (pn < 12) {
            const int sec = pn >> 1, head = (pn & 1) * 4 + wc;
            const bool isq = (sec == 0 || sec == 3), isk = (sec == 1 || sec == 4);
            const float* gp = gains + ((sec >= 3 ? sec - 1 : sec) & 3) * 64;
            f32x4 gv[2][2];
#pragma unroll
            for (int bj = 0; bj < 2; ++bj)
#pragma unroll
                for (int n = 0; n < 2; ++n) { gv[bj][n] = (f32x4){1.f, 1.f, 1.f, 1.f}; if (isq || isk) gv[bj][n] = *(const f32x4*)(gp + 32 * bj + 8 * fq + 4 * n) * (isq ? QSCALE : 1.0f); }
            bf16_t* base = qkv + (size_t)sec * ((size_t)NTOK * 512);
            f32x4 cs[2][2];
#pragma unroll
            for (int bj = 0; bj < 2; ++bj)
#pragma unroll
                for (int n = 0; n < 2; ++n) cs[bj][n] = (f32x4){0.f, 0.f, 0.f, 0.f};
#pragma unroll
            for (int ai = 0; ai < 2; ++ai)
#pragma unroll
                for (int m = 0; m < 4; ++m) {
                    const int row = u.pm * BM + ai * HALF + wr * 64 + m * 16 + fr; const int b = row >> 11, s = row & 2047;
                    f32x4 v[2][2];
#pragma unroll
                    for (int bj = 0; bj < 2; ++bj)
#pragma unroll
                        for (int n = 0; n < 2; ++n) v[bj][n] = acc[ai][bj][m][n];
                    if (isq || isk) {
                        float ss = 0.f;
#pragma unroll
                        for (int bj = 0; bj < 2; ++bj)
#pragma unroll
                            for (int n = 0; n < 2; ++n) { const f32x4 x = v[bj][n]; ss += (x[0] * x[0] + x[1] * x[1]) + (x[2] * x[2] + x[3] * x[3]); }
                        ss += __shfl_xor(ss, 16); ss += __shfl_xor(ss, 32);
                        const float rstd = rsqrtf(ss * (1.0f / 64.0f) + RMS_EPS);
#pragma unroll
                        for (int bj = 0; bj < 2; ++bj)
#pragma unroll
                            for (int n = 0; n < 2; ++n) v[bj][n] = v[bj][n] * rstd * gv[bj][n];
                    }
                    if (sec == 4) {
#pragma unroll
                        for (int bj = 0; bj < 2; ++bj)
#pragma unroll
                            for (int n = 0; n < 2; ++n) cs[bj][n] += v[bj][n];
                    }
                    bf16_t* dst = base + ((size_t)(b * NHEAD + head) * SEQ + s) * HDIM + 8 * fq;
#pragma unroll
                    for (int bj = 0; bj < 2; ++bj) { u32x4 w; w.x = cvt_pk_bf16(v[bj][0][0], v[bj][0][1]); w.y = cvt_pk_bf16(v[bj][0][2], v[bj][0][3]); w.z = cvt_pk_bf16(v[bj][1][0], v[bj][1][1]); w.w = cvt_pk_bf16(v[bj][1][2], v[bj][1][3]);
                        *(u32x4*)(dst + 32 * bj) = w; }
                }
            if (sec == 4) {
                const int b = (u.pm * BM) >> 11, blk = u.pm & 7;
                float* km = kmean + ((size_t)(b * NHEAD + head) * 8 + blk) * HDIM + 8 * fq;
#pragma unroll
                for (int bj = 0; bj < 2; ++bj)
#pragma unroll
                    for (int n = 0; n < 2; ++n)
#pragma unroll
                        for (int e = 0; e < 4; ++e) { float x = cs[bj][n][e]; x += __shfl_xor(x, 1); x += __shfl_xor(x, 2); x += __shfl_xor(x, 4); x += __shfl_xor(x, 8);
                            if (fr == 0) atomicAdd(km + 32 * bj + 4 * n + e, x * (1.0f / 256.0f)); }
            }
        } else {
            const int gc0 = (pn - 12) * 256 + 64 * wc + 8 * fq;
#pragma unroll
            for (int ai = 0; ai < 2; ++ai)
#pragma unroll
                for (int m = 0; m < 4; ++m) {
                    const int row = u.pm * BM + ai * HALF + wr * 64 + m * 16 + fr;
                    bf16_t* dst = G + (size_t)row * 2048 + gc0;
#pragma unroll
                    for (int bj = 0; bj < 2; ++bj) { const f32x4 a = acc[ai][bj][m][0], c = acc[ai][bj][m][1]; u32x4 w;
                        w.x = cvt_pk_bf16(sigmoidf_(a[0]), sigmoidf_(a[1])); w.y = cvt_pk_bf16(sigmoidf_(a[2]), sigmoidf_(a[3])); w.z = cvt_pk_bf16(sigmoidf_(c[0]), sigmoidf_(c[1])); w.w = cvt_pk_bf16(sigmoidf_(c[2]), sigmoidf_(c[3]));
                        *(u32x4*)(dst + 32 * bj) = w; }
                }
        }
    }
};

template <int SECOND> struct EpiUp {
    static constexpr bool PERM = true, AFTER_DRAIN = false;
    const bf16_t* G; bf16_t* MIX;
    __device__ __forceinline__ void operator()(const f32x4 (&acc)[2][2][4][2], const Unit& u, int wr, int wc, int fr, int fq) const {
        const int col0 = u.pn * BM + wc * 32 + 8 * fq;
#pragma unroll
        for (int ai = 0; ai < 2; ++ai)
#pragma unroll
            for (int m = 0; m < 4; ++m) {
                const int row = u.pm * BM + ai * HALF + wr * 64 + m * 16 + fr;
#pragma unroll
                for (int bj = 0; bj < 2; ++bj) {
                    const int col = col0 + bj * HALF;
                    const u32x4 g = *(const u32x4*)(G + (size_t)row * 2048 + SECOND * 1024 + col);
                    const f32x4 a = acc[ai][bj][m][0], c = acc[ai][bj][m][1];
                    float v[8] = {a[0] * bf_lo(g.x), a[1] * bf_hi(g.x), a[2] * bf_lo(g.y), a[3] * bf_hi(g.y), c[0] * bf_lo(g.z), c[1] * bf_hi(g.z), c[2] * bf_lo(g.w), c[3] * bf_hi(g.w)};
                    bf16_t* p = MIX + (size_t)row * 1024 + col;
                    if (SECOND) { const u32x4 o = __builtin_nontemporal_load((const u32x4*)p);
                        v[0] += bf_lo(o.x); v[1] += bf_hi(o.x); v[2] += bf_lo(o.y); v[3] += bf_hi(o.y); v[4] += bf_lo(o.z); v[5] += bf_hi(o.z); v[6] += bf_lo(o.w); v[7] += bf_hi(o.w); }
                    u32x4 w; w.x = cvt_pk_bf16(v[0], v[1]); w.y = cvt_pk_bf16(v[2], v[3]); w.z = cvt_pk_bf16(v[4], v[5]); w.w = cvt_pk_bf16(v[6], v[7]);
                    *(u32x4*)p = w;
                }
            }
    }
};

struct EpiOut {
    static constexpr bool PERM = true, AFTER_DRAIN = false;
    const float* x; const float* mod; float* out; float* parts;
    __device__ __forceinline__ void operator()(const f32x4 (&acc)[2][2][4][2], const Unit& u, int wr, int wc, int fr, int fq) const {
        const int col0 = u.pn * BM + wc * 32 + 8 * fq;
        const int b = (u.pm * BM) >> 11;
        const float* g1 = mod + (size_t)b * 6144 + 2048;
        f32x4 gt[2][2];
#pragma unroll
        for (int bj = 0; bj < 2; ++bj)
#pragma unroll
            for (int n = 0; n < 2; ++n) gt[bj][n] = *(const f32x4*)(g1 + col0 + bj * HALF + 4 * n);
#pragma unroll
        for (int ai = 0; ai < 2; ++ai)
#pragma unroll
            for (int m = 0; m < 4; ++m) {
                const int row = u.pm * BM + ai * HALF + wr * 64 + m * 16 + fr; const size_t off = (size_t)row * 1024 + col0;
                float ss = 0.f;
#pragma unroll
                for (int bj = 0; bj < 2; ++bj)
#pragma unroll
                    for (int n = 0; n < 2; ++n) { const f32x4 xv = *(const f32x4*)(x + off + bj * HALF + 4 * n); const f32x4 o = xv + gt[bj][n] * acc[ai][bj][m][n];
                        ss += (o[0] * o[0] + o[1] * o[1]) + (o[2] * o[2] + o[3] * o[3]); *(f32x4*)(out + off + bj * HALF + 4 * n) = o; }
                ss += __shfl_xor(ss, 16); ss += __shfl_xor(ss, 32);
                if (fq == 0) parts[(size_t)row * 16 + u.pn * 4 + wc] = ss;
            }
    }
};

struct EpiSc {
    static constexpr bool PERM = true, AFTER_DRAIN = false;
    float* SC;
    __device__ __forceinline__ void operator()(const f32x4 (&acc)[2][2][4][2], const Unit& u, int wr, int wc, int fr, int fq) const {
        const int col0 = u.pn * BM + wc * 32 + 8 * fq;
#pragma unroll
        for (int ai = 0; ai < 2; ++ai)
#pragma unroll
            for (int m = 0; m < 4; ++m) {
                const int row = u.pm * BM + ai * HALF + wr * 64 + m * 16 + fr; const size_t off = (size_t)row * 2048 + col0;
#pragma unroll
                for (int bj = 0; bj < 2; ++bj)
#pragma unroll
                    for (int n = 0; n < 2; ++n) *(f32x4*)(SC + off + bj * HALF + 4 * n) = acc[ai][bj][m][n];
            }
    }
};

template <class Epi, class Sched, bool ALIGN_EPI = false, bool SP2 = false>
__device__ __forceinline__ void gemm_phase(PG8_LAS unsigned char* lds, const Gemm g, const Sched& S, const Epi& E) {
    const int tid = threadIdx.x, wid = __builtin_amdgcn_readfirstlane(tid >> 6), lane = tid & 63, wr = wid >> 2, wc = wid & 3, fr = lane & 15, fq = lane >> 4;
    const int K = g.K, nt = K / BK;
    unsigned voffA[2], voffB[2];
#pragma unroll
    for (int i = 0; i < 2; ++i) { int R, C; stage_rc(tid * 16 + i * 8192, R, C); const int Rb = Epi::PERM ? ((R & ~31) + perm32(R & 31)) : R;
        voffA[i] = (unsigned)(R * g.lda + C) * 2u; voffB[i] = (unsigned)(Rb * g.ldb + C) * 2u; }
    const size_t kstep = (size_t)(BK * 2);
    const size_t hstepA = (size_t)HALF * g.lda * 2, hstepB = (size_t)HALF * g.ldb * 2;
    const size_t tstepA = 2 * hstepA, tstepB = 2 * hstepB;
    const unsigned ldsw = (unsigned)wid * 1024u;
    const int aoff = lds_byte(wr * 64 + fr, fq * 8), boff = lds_byte(wc * 32 + fr, fq * 8);
#define PG8_SA(b, h) (((b) * 2 + (h)) * HTB)
#define PG8_SB(b, h) ((4 + (b) * 2 + (h)) * HTB)
#define PG8_STAGE(bufoff, gbase, voff) do { _Pragma("unroll") for (int _i = 0; _i < 2; ++_i) \
        __builtin_amdgcn_global_load_lds((const unsigned*)((const char*)(gbase) + (voff)[_i]), (PG8_LAS unsigned*)(lds + (bufoff) + ldsw + _i * 8192), 16, 0, 0); } while (0)
#define PG8_LDA(dst, b, h) do { _Pragma("unroll") for (int m = 0; m < 4; ++m) _Pragma("unroll") for (int k = 0; k < 2; ++k) dst[m][k] = *(const PG8_LAS bf16x8*)(lds + PG8_SA(b, h) + aoff + m * 2048 + k * 1024); } while (0)
#define PG8_LDB(dst, b, h) do { _Pragma("unroll") for (int n = 0; n < 2; ++n) _Pragma("unroll") for (int k = 0; k < 2; ++k) dst[n][k] = *(const PG8_LAS bf16x8*)(lds + PG8_SB(b, h) + boff + n * 2048 + k * 1024); } while (0)
#define PG8_MMA(ai, bj, At, Bt) do { __builtin_amdgcn_s_setprio(1); _Pragma("unroll") for (int m = 0; m < 4; ++m) _Pragma("unroll") for (int n = 0; n < 2; ++n) _Pragma("unroll") for (int k = 0; k < 2; ++k) \
        acc[ai][bj][m][n] = __builtin_amdgcn_mfma_f32_16x16x32_bf16(Bt[n][k], At[m][k], acc[ai][bj][m][n], 0, 0, 0); __builtin_amdgcn_s_setprio(0); } while (0)
#define PG8_WAIT_V(n) asm volatile("s_waitcnt vmcnt(" #n ")" ::: "memory")
#define PG8_WAIT_L(n) asm volatile("s_waitcnt lgkmcnt(" #n ")" ::: "memory")
#define PG8_BAR __builtin_amdgcn_s_barrier()
#define PG8_SCHED __builtin_amdgcn_sched_barrier(0)
    Unit cur, nxt; int ui = 0;
    if (!S.next(0, cur)) return;
    f32x4 acc[2][2][4][2];
#pragma unroll
    for (int a = 0; a < 2; ++a)
#pragma unroll
        for (int b = 0; b < 2; ++b)
#pragma unroll
            for (int m = 0; m < 4; ++m)
#pragma unroll
                for (int n = 0; n < 2; ++n) acc[a][b][m][n] = (f32x4){0.f, 0.f, 0.f, 0.f};
    bf16x8 At[4][2], B0[2][2], B1[2][2];
    const char* cA = (const char*)g.A + (size_t)cur.pm * tstepA; const char* cB = (const char*)g.Bt + (size_t)cur.pn * tstepB;
    S.a_ready(cur);
    if constexpr (SP2) {
        PG8_STAGE(PG8_SB(0, 0), cB, voffB); PG8_STAGE(PG8_SB(0, 1), cB + hstepB, voffB); PG8_STAGE(PG8_SA(0, 0), cA, voffA); PG8_STAGE(PG8_SA(0, 1), cA + hstepA, voffA);
        if (wr == 1) PG8_BAR;
        PG8_WAIT_V(2); PG8_BAR;
        PG8_STAGE(PG8_SB(1, 0), cB + kstep, voffB); PG8_STAGE(PG8_SA(1, 0), cA + kstep, voffA); PG8_STAGE(PG8_SB(1, 1), cB + hstepB + kstep, voffB);
        PG8_WAIT_V(6); PG8_BAR;
    } else {
        PG8_STAGE(PG8_SB(0, 0), cB, voffB); PG8_STAGE(PG8_SA(0, 0), cA, voffA); PG8_STAGE(PG8_SB(0, 1), cB + hstepB, voffB); PG8_STAGE(PG8_SA(0, 1), cA + hstepA, voffA);
        if (wr == 1) PG8_BAR;
        PG8_WAIT_V(4); PG8_BAR;
        PG8_STAGE(PG8_SB(1, 0), cB + kstep, voffB); PG8_STAGE(PG8_SA(1, 0), cA + kstep, voffA); PG8_STAGE(PG8_SB(1, 1), cB + hstepB + kstep, voffB);
        PG8_WAIT_V(6); PG8_BAR;
    }
    for (;;) {
        const bool has_next = S.next(ui + 1, nxt);
        const char* nA = has_next ? (const char*)g.A + (size_t)nxt.pm * tstepA : cA; const char* nB = has_next ? (const char*)g.Bt + (size_t)nxt.pn * tstepB : cB;
        for (int t = 0; t < nt; t += 2) {
            const bool last = (t == nt - 2);
            const char* a1 = cA + (size_t)(t + 1) * kstep;
            const char* a2 = last ? nA : cA + (size_t)(t + 2) * kstep; const char* b2 = last ? nB : cB + (size_t)(t + 2) * kstep;
            const char* a3 = a2 + kstep; const char* b3 = b2 + kstep;
            if (last && has_next) S.a_ready(nxt);
            if constexpr (SP2) {
            PG8_LDB(B0, 0, 0); PG8_LDB(B1, 0, 1); PG8_SCHED; PG8_LDA(At, 0, 0); PG8_STAGE(PG8_SA(1, 1), a1 + hstepA, voffA);
            PG8_WAIT_V(8); PG8_WAIT_L(0); PG8_BAR; PG8_MMA(0, 0, At, B0); PG8_MMA(0, 1, At, B1); PG8_BAR; PG8_SCHED;
            PG8_LDA(At, 0, 1); PG8_STAGE(PG8_SB(0, 0), b2, voffB); PG8_STAGE(PG8_SB(0, 1), b2 + hstepB, voffB); PG8_STAGE(PG8_SA(0, 0), a2, voffA);
            PG8_WAIT_V(8); PG8_WAIT_L(0); PG8_BAR; PG8_MMA(1, 0, At, B0); PG8_MMA(1, 1, At, B1); PG8_BAR; PG8_SCHED;
            PG8_LDB(B0, 1, 0); PG8_LDB(B1, 1, 1); PG8_SCHED; PG8_LDA(At, 1, 0); PG8_STAGE(PG8_SA(0, 1), a2 + hstepA, voffA);
            PG8_WAIT_V(8); PG8_WAIT_L(0); PG8_BAR; PG8_MMA(0, 0, At, B0); PG8_MMA(0, 1, At, B1); PG8_BAR; PG8_SCHED;
            PG8_LDA(At, 1, 1); PG8_STAGE(PG8_SB(1, 0), b3, voffB); PG8_STAGE(PG8_SB(1, 1), b3 + hstepB, voffB); PG8_STAGE(PG8_SA(1, 0), a3, voffA);
            PG8_WAIT_V(8); PG8_WAIT_L(0); PG8_BAR; PG8_MMA(1, 0, At, B0); PG8_MMA(1, 1, At, B1); PG8_BAR; PG8_SCHED;
            } else {
            PG8_LDB(B0, 0, 0); PG8_SCHED; PG8_LDA(At, 0, 0); PG8_STAGE(PG8_SA(1, 1), a1 + hstepA, voffA);
            PG8_WAIT_L(8); PG8_BAR; PG8_WAIT_L(0); PG8_MMA(0, 0, At, B0); PG8_BAR; PG8_SCHED;
            PG8_LDB(B1, 0, 1); PG8_STAGE(PG8_SB(0, 0), b2, voffB);
            PG8_BAR; PG8_WAIT_L(0); PG8_MMA(0, 1, At, B1); PG8_BAR;
            PG8_LDA(At, 0, 1); PG8_STAGE(PG8_SA(0, 0), a2, voffA);
            PG8_BAR; PG8_WAIT_L(0); PG8_MMA(1, 0, At, B0); PG8_BAR; PG8_SCHED;
            PG8_STAGE(PG8_SB(0, 1), b2 + hstepB, voffB);
            PG8_WAIT_V(6); PG8_BAR; PG8_MMA(1, 1, At, B1); PG8_BAR;
            PG8_LDB(B0, 1, 0); PG8_SCHED; PG8_LDA(At, 1, 0); PG8_STAGE(PG8_SA(0, 1), a2 + hstepA, voffA);
            PG8_WAIT_L(8); PG8_BAR; PG8_WAIT_L(0); PG8_MMA(0, 0, At, B0); PG8_BAR; PG8_SCHED;
            PG8_LDB(B1, 1, 1); PG8_STAGE(PG8_SB(1, 0), b3, voffB);
            PG8_BAR; PG8_WAIT_L(0); PG8_MMA(0, 1, At, B1); PG8_BAR;
            PG8_LDA(At, 1, 1); PG8_STAGE(PG8_SA(1, 0), a3, voffA);
            PG8_BAR; PG8_WAIT_L(0); PG8_MMA(1, 0, At, B0); PG8_BAR; PG8_SCHED;
            PG8_STAGE(PG8_SB(1, 1), b3 + hstepB, voffB);
            PG8_WAIT_V(6); PG8_BAR; PG8_MMA(1, 1, At, B1); PG8_BAR;
            }
        }
        if constexpr (ALIGN_EPI) { if (wr == 0) PG8_BAR; }
        if constexpr (!Epi::AFTER_DRAIN) { E(acc, cur, wr, wc, fr, fq); S.done(cur); }
        if (!has_next) break;
#pragma unroll
        for (int a = 0; a < 2; ++a)
#pragma unroll
            for (int b = 0; b < 2; ++b)
#pragma unroll
                for (int m = 0; m < 4; ++m)
#pragma unroll
                    for (int n = 0; n < 2; ++n) acc[a][b][m][n] = (f32x4){0.f, 0.f, 0.f, 0.f};
        cur = nxt; cA = nA; cB = nB; ++ui;
        if constexpr (ALIGN_EPI) { if (wr == 1) PG8_BAR; }
    }
    PG8_WAIT_V(0);
    if constexpr (!ALIGN_EPI) { if (wr == 0) PG8_BAR; }
    PG8_BAR;
    if constexpr (Epi::AFTER_DRAIN) { E.fused(acc, cur, wr, wc, fr, fq, lds, wid, lane); S.done(cur); }
#undef PG8_SA
#undef PG8_SB
#undef PG8_STAGE
#undef PG8_LDA
#undef PG8_LDB
#undef PG8_MMA
#undef PG8_WAIT_V
#undef PG8_WAIT_L
#undef PG8_BAR
#undef PG8_SCHED
}
}

namespace att {
#define ALAS __attribute__((address_space(3)))
typedef unsigned short bf16_t;
typedef short bf16x8 __attribute__((ext_vector_type(8)));
typedef short s16x4 __attribute__((ext_vector_type(4)));
typedef short v4i16_t __attribute__((ext_vector_type(4)));
typedef float f32x16 __attribute__((ext_vector_type(16)));
typedef float f32x4 __attribute__((ext_vector_type(4)));
typedef unsigned u32x4 __attribute__((ext_vector_type(4)));
constexpr int L_K = 0, L_V = 16384, L_KB = 32768, L_WSF = 40960, L_KM = 43008, L_STG = 45056, L_END = L_STG + 8 * 4096;
__device__ __forceinline__ s16x4 vtr(const ALAS char* p) { return __builtin_bit_cast(s16x4, __builtin_amdgcn_ds_read_tr16_b64_v4i16((ALAS v4i16_t*)p)); }
__device__ __forceinline__ unsigned cvtpk(float lo, float hi) { typedef float f2 __attribute__((ext_vector_type(2))); typedef __bf16 b2 __attribute__((ext_vector_type(2))); f2 v = {lo, hi}; b2 b = __builtin_convertvector(v, b2); return __builtin_bit_cast(unsigned, b); }
__device__ __forceinline__ float swap32f(float v) { return __shfl_xor(v, 32); }

template <int TYPE>
__device__ __forceinline__ void attn_unit(int b, int h, int qb, const bf16_t* Q, const bf16_t* K, const bf16_t* V, const float* Fcum, const float* kmean, bf16_t* Y, ALAS char* lds) {
    const int tid = threadIdx.x, lane = tid & 63, r32 = lane & 31, hi = lane >> 5; const int wid = __builtin_amdgcn_readfirstlane(tid >> 6);
    const size_t headbase = (size_t)(b * NHEAD + h) * SEQ * HDIM;
    const char* Kh = (const char*)(K + headbase); const char* Vh = (const char*)(V + headbase); const bf16_t* Qh = Q + headbase;
    const int q0 = qb * 256, NT = 4 * (qb + 1);
    ALAS float* kbias = (ALAS float*)(lds + L_KB);
    ALAS float* wsf = (ALAS float*)(lds + L_WSF) + wid * 64;
    ALAS float* km = (ALAS float*)(lds + L_KM);
    {
        const float slope = exp2f(-(float)(h + 1));
        for (int s = tid; s < q0 + 256; s += 512) kbias[s] = (TYPE == 0) ? (-Fcum[(size_t)(b * NHEAD + h) * SEQ + s] * LOG2E) : (slope * (float)s * LOG2E);
        if (TYPE == 1) km[tid] = kmean[(size_t)(b * NHEAD + h) * 512 + tid];
    }
    bf16x8 qr[4];
    { const bf16_t* qrow = Qh + (size_t)(q0 + wid * 32 + r32) * HDIM;
#pragma unroll
      for (int d0 = 0; d0 < 4; ++d0) qr[d0] = *(const bf16x8*)(qrow + d0 * 16 + hi * 8); }
    const int koff = lane * 128 + wid * 16;
    const int voff = (16 * (wid & 3) + (lane >> 2)) * 128 + (wid >> 2) * 64 + (lane & 3) * 16;
    const int ldst = wid * 1024 + lane * 16;
    u32x4 kreg = *(const u32x4*)(Kh + koff), vreg = *(const u32x4*)(Vh + voff);
    *(ALAS u32x4*)(lds + L_K + ldst) = kreg; *(ALAS u32x4*)(lds + L_V + ldst) = vreg;
    if (NT > 1) { kreg = *(const u32x4*)(Kh + 8192 + koff); vreg = *(const u32x4*)(Vh + 8192 + voff); }
    __syncthreads();
    unsigned sel = 0xffu;
    if (TYPE == 1) {
        float gate[7];
#pragma unroll
        for (int jb = 0; jb < 7; ++jb) {
            float g = 0.f;
#pragma unroll
            for (int d0 = 0; d0 < 4; ++d0) {
                const f32x4 k0 = *(const ALAS f32x4*)(km + jb * 64 + d0 * 16 + hi * 8), k1 = *(const ALAS f32x4*)(km + jb * 64 + d0 * 16 + hi * 8 + 4);
#pragma unroll
                for (int e = 0; e < 4; ++e) { g += __uint_as_float((unsigned)(unsigned short)qr[d0][e] << 16) * k0[e]; g += __uint_as_float((unsigned)(unsigned short)qr[d0][4 + e] << 16) * k1[e]; }
            }
            gate[jb] = g + swap32f(g);
        }
        if (qb <= 3) sel = (1u << qb) - 1u;
        else { sel = 0u;
#pragma unroll
            for (int it = 0; it < 3; ++it) { float best = -INFINITY; int bi = 0;
#pragma unroll
                for (int jb = 0; jb < 7; ++jb) { const bool ok = (jb < qb) && !((sel >> jb) & 1u) && (gate[jb] > best); best = ok ? gate[jb] : best; bi = ok ? jb : bi; }
                sel |= 1u << bi; } }
    }
    float m_run = -1e30f, l_run = 0.f; f32x16 o[2]; o[0] = f32x16{}; o[1] = f32x16{};
    const int qrel = wid * 32 + r32;
    for (int t = 0; t < NT; ++t) {
        const int buf = t & 1, jband = t - (NT - 4);
        bool active = true;
        if (jband >= 0) active = (64 * jband <= wid * 32 + 31);
        else if (TYPE == 1) active = __any((int)((sel >> (t >> 2)) & 1u)) != 0;
        if (active) {
            f32x16 p0 = f32x16{}, p1 = f32x16{};
            { const ALAS char* kb = lds + L_K + buf * 8192 + hi * 1024 + r32 * 16;
#pragma unroll
              for (int d0 = 0; d0 < 4; ++d0) { const bf16x8 b0 = *(const ALAS bf16x8*)(kb + d0 * 2048), b1 = *(const ALAS bf16x8*)(kb + d0 * 2048 + 512);
                  p0 = __builtin_amdgcn_mfma_f32_32x32x16_bf16(b0, qr[d0], p0, 0, 0, 0); p1 = __builtin_amdgcn_mfma_f32_32x32x16_bf16(b1, qr[d0], p1, 0, 0, 0); } }
            { const ALAS float* kbt = kbias + 64 * t + 4 * hi;
#pragma unroll
              for (int rq = 0; rq < 4; ++rq) { const f32x4 b0 = *(const ALAS f32x4*)(kbt + 8 * rq), b1 = *(const ALAS f32x4*)(kbt + 32 + 8 * rq);
#pragma unroll
                  for (int e = 0; e < 4; ++e) { p0[4 * rq + e] += b0[e]; p1[4 * rq + e] += b1[e]; } } }
            if (jband >= 0) { const int kb0 = 64 * jband + 4 * hi;
#pragma unroll
                for (int r = 0; r < 16; ++r) { const int kv = kb0 + (r & 3) + 8 * (r >> 2); if (kv > qrel) p0[r] = -INFINITY; if (kv + 32 > qrel) p1[r] = -INFINITY; } }
            else if (TYPE == 1) { if (!((sel >> (t >> 2)) & 1u)) {
#pragma unroll
                for (int r = 0; r < 16; ++r) { p0[r] = -INFINITY; p1[r] = -INFINITY; } } }
            float rm = fmaxf(p0[0], p1[0]);
#pragma unroll
            for (int r = 1; r < 16; ++r) rm = fmaxf(rm, fmaxf(p0[r], p1[r]));
            rm = fmaxf(rm, swap32f(rm));
            const float mn = fmaxf(m_run, rm), alpha = __builtin_amdgcn_exp2f(m_run - mn); m_run = mn;
            float rs = 0.f;
#pragma unroll
            for (int r = 0; r < 16; ++r) { p0[r] = __builtin_amdgcn_exp2f(p0[r] - mn); p1[r] = __builtin_amdgcn_exp2f(p1[r] - mn); rs += p0[r] + p1[r]; }
            l_run = l_run * alpha + rs;
            if (__any(alpha != 1.0f)) {
                if (hi == 0) wsf[r32] = alpha;
                asm volatile("s_waitcnt lgkmcnt(0)" ::: "memory");
#pragma unroll
                for (int rq = 0; rq < 4; ++rq) { const f32x4 a4 = *(const ALAS f32x4*)(wsf + 8 * rq + 4 * hi);
#pragma unroll
                    for (int e = 0; e < 4; ++e) { o[0][4 * rq + e] *= a4[e]; o[1][4 * rq + e] *= a4[e]; } }
                asm volatile("s_waitcnt lgkmcnt(0)" ::: "memory");
            }
            u32x4 pw[4];
            pw[0] = (u32x4){cvtpk(p0[0], p0[1]), cvtpk(p0[2], p0[3]), cvtpk(p0[4], p0[5]), cvtpk(p0[6], p0[7])};
            pw[1] = (u32x4){cvtpk(p0[8], p0[9]), cvtpk(p0[10], p0[11]), cvtpk(p0[12], p0[13]), cvtpk(p0[14], p0[15])};
            pw[2] = (u32x4){cvtpk(p1[0], p1[1]), cvtpk(p1[2], p1[3]), cvtpk(p1[4], p1[5]), cvtpk(p1[6], p1[7])};
            pw[3] = (u32x4){cvtpk(p1[8], p1[9]), cvtpk(p1[10], p1[11]), cvtpk(p1[12], p1[13]), cvtpk(p1[14], p1[15])};
            const ALAS char* vp = lds + L_V + buf * 8192 + ((lane >> 4) & 1) * 32 + (lane & 3) * 8 + (4 * hi + ((lane & 15) >> 2)) * 64;
#pragma unroll
            for (int d0 = 0; d0 < 2; ++d0)
#pragma unroll
                for (int ks = 0; ks < 4; ++ks) { const s16x4 lo = vtr(vp + d0 * 4096 + ks * 1024), hh = vtr(vp + d0 * 4096 + ks * 1024 + 512);
                    const bf16x8 vf = (bf16x8){lo[0], lo[1], lo[2], lo[3], hh[0], hh[1], hh[2], hh[3]};
                    o[d0] = __builtin_amdgcn_mfma_f32_32x32x16_bf16(__builtin_bit_cast(bf16x8, pw[ks]), vf, o[d0], 0, 0, 0); }
        }
        if (t + 1 < NT) {
            *(ALAS u32x4*)(lds + L_K + (buf ^ 1) * 8192 + ldst) = kreg; *(ALAS u32x4*)(lds + L_V + (buf ^ 1) * 8192 + ldst) = vreg;
            if (t + 2 < NT) { kreg = *(const u32x4*)(Kh + (size_t)(t + 2) * 8192 + koff); vreg = *(const u32x4*)(Vh + (size_t)(t + 2) * 8192 + voff); }
        }
        __syncthreads();
    }
    l_run += swap32f(l_run);
    if (hi == 0) wsf[32 + r32] = l_run;
    asm volatile("s_waitcnt lgkmcnt(0)" ::: "memory");
    ALAS bf16_t* stg = (ALAS bf16_t*)(lds + L_STG) + wid * 2048;
#pragma unroll
    for (int rq = 0; rq < 4; ++rq) { const f32x4 l4 = *(const ALAS f32x4*)(wsf + 32 + 8 * rq + 4 * hi);
#pragma unroll
        for (int e = 0; e < 4; ++e) { const float rl = 1.0f / l4[e]; const int orow = 8 * rq + 4 * hi + e;
#pragma unroll
            for (int d0 = 0; d0 < 2; ++d0) stg[orow * 64 + d0 * 32 + r32] = (bf16_t)(cvtpk(o[d0][4 * rq + e] * rl, 0.f) & 0xffffu); } }
    asm volatile("s_waitcnt lgkmcnt(0)" ::: "memory");
    bf16_t* Yw = Y + (size_t)(b * SEQ + q0 + wid * 32) * 1024 + TYPE * 512 + h * 64;
#pragma unroll
    for (int i = 0; i < 4; ++i) { const int row = i * 8 + (lane >> 3), ch = lane & 7; const u32x4 v = *(const ALAS u32x4*)(stg + row * 64 + ch * 8); *(u32x4*)(Yw + (size_t)row * 1024 + ch * 8) = v; }
    __syncthreads();
}
#undef ALAS
}

constexpr int NWAVES = 8;
constexpr size_t MiB = 1u << 20;
constexpr size_t WS_CTL = 0, CTL_ZERO_BYTES = 256 * 1024;
constexpr size_t WS_KMEAN = 64 * 1024;
constexpr size_t WS_MOD = 256 * 1024;
constexpr size_t WS_WFG = 448 * 1024;
constexpr size_t WS_GAINS = 480 * 1024;
constexpr size_t WS_LF = 512 * 1024;
constexpr size_t WS_FC = 1 * MiB;
constexpr size_t WS_PARTS = 2 * MiB;
constexpr size_t WS_WIN = 4 * MiB;
constexpr size_t WS_WFT = 14 * MiB, WS_WMT = 15 * MiB;
constexpr size_t WS_WOT = 16 * MiB;
constexpr size_t WS_WEFF = 18 * MiB;
constexpr size_t WS_HY = 24 * MiB;
constexpr size_t WS_QKV = 56 * MiB;
constexpr size_t WS_MIX = 152 * MiB;
constexpr size_t WS_U8 = 184 * MiB, WS_V8 = 200 * MiB;
constexpr size_t WS_SU = 216 * MiB, WS_SV = 216 * MiB + 65536;
constexpr size_t WS_PP = 56 * MiB;
constexpr size_t WS_WT = 220 * MiB;
constexpr size_t WS_EG = 248 * MiB;
constexpr size_t WS_SC = 56 * MiB;
constexpr size_t WS_END = 256 * MiB;
constexpr int CW_BAR = 4096;
constexpr int RING_BYTES = 131072, LDSCTL_OFF = RING_BYTES, MISC_OFF = LDSCTL_OFF + 320, LDS_BYTES = 147456;

#define GAS __attribute__((address_space(1)))
#define LAS __attribute__((address_space(3)))
typedef unsigned short bf16;
typedef unsigned v4u __attribute__((ext_vector_type(4)));
typedef unsigned v2u __attribute__((ext_vector_type(2)));
typedef float f32x4 __attribute__((ext_vector_type(4)));
typedef GAS unsigned gu32;
#define RLX_AGENT __ATOMIC_RELAXED, __HIP_MEMORY_SCOPE_AGENT
#define LDS_WAIT() asm volatile("s_waitcnt lgkmcnt(0)" ::: "memory")
#define VM_WAIT() asm volatile("s_waitcnt vmcnt(0)" ::: "memory")
__device__ __forceinline__ unsigned f2bf(float f) { unsigned u = __builtin_bit_cast(unsigned, f); return (u + 0x7fffu + ((u >> 16) & 1u)) >> 16; }
__device__ __forceinline__ unsigned pk2(float lo, float hi) { return f2bf(lo) | (f2bf(hi) << 16); }
__device__ __forceinline__ float wave_sum(float v) {
#pragma unroll
    for (int o = 1; o < 64; o <<= 1) v += __shfl_xor(v, o);
    return v;
}
#define XB_TMO      128
#define XB_XCNT(j)  (256  + 64 * (j))
#define XB_XSUB(j)  (1280 + 64 * (j))
#define XB_XGEN(j)  (2304 + 64 * (j))
#define XB_TOP      3328
#define XB_TOPGEN   3392
#define XCD_BAR_WORDS 3456
#define XB_SPIN_CAP (1u << 18)

__device__ __forceinline__ unsigned xb_ld(unsigned* p)              { return __hip_atomic_load(p, __ATOMIC_RELAXED, __HIP_MEMORY_SCOPE_AGENT); }
__device__ __forceinline__ unsigned xb_add(unsigned* p, unsigned v) { return __hip_atomic_fetch_add(p, v, __ATOMIC_RELAXED, __HIP_MEMORY_SCOPE_AGENT); }
__device__ __forceinline__ unsigned xb_xcc_id() { return (unsigned)__builtin_amdgcn_s_getreg((3 << 11) | 20) & 0xFu; }
#define XB_SPIN(cond, bar) do { unsigned _sp = 0; while (cond) { __builtin_amdgcn_s_sleep(1); \
    if ((++_sp & 255u) == 0u) { if (xb_ld(&(bar)[XB_TMO])) break; if (_sp > XB_SPIN_CAP) { atomicAdd(&(bar)[XB_TMO], 1u); break; } } } } while (0)

struct XcdBarrier {
    unsigned* bar; unsigned x;
    volatile LAS unsigned* st;
};

__device__ __forceinline__ XcdBarrier xcd_barrier_post(unsigned* bar, volatile LAS unsigned* st) {
    XcdBarrier b; b.bar = bar; b.x = xb_xcc_id(); b.st = st;
    if (threadIdx.x == 0) (void)xb_add(&bar[XB_XCNT(b.x)], 1u);
    return b;
}
__device__ __forceinline__ void xcd_barrier_complete(unsigned* bar, unsigned x, unsigned& nloc, unsigned& nx) {
    const unsigned G = gridDim.x * gridDim.y * gridDim.z;
    unsigned sum, cnt, mine, sp = 0u;
    for (;;) {
        sum = 0u; cnt = 0u; mine = 0u;
#pragma unroll
        for (unsigned j = 0; j < 16; ++j) { const unsigned c = xb_ld(&bar[XB_XCNT(j)]); sum += c; cnt += (c > 0u) ? 1u : 0u; mine = (j == x) ? c : mine; }
        if (sum == G) break;
        __builtin_amdgcn_s_sleep(1);
        if ((++sp & 255u) == 0u) { if (xb_ld(&bar[XB_TMO])) break; if (sp > XB_SPIN_CAP) { atomicAdd(&bar[XB_TMO], 1u); break; } }
    }
    nloc = mine > 0u ? mine : 1u; nx = cnt > 0u ? cnt : 1u;
}

__device__ __forceinline__ void xcd_barrier(const XcdBarrier& b) {
    asm volatile("s_waitcnt vmcnt(0)" ::: "memory");
    __syncthreads();
    if (threadIdx.x == 0) {
        unsigned* bar = b.bar;
        __builtin_amdgcn_s_waitcnt(0);
        unsigned nloc = b.st[0], nx = b.st[1];
        if (nloc == 0u) { xcd_barrier_complete(bar, b.x, nloc, nx); b.st[0] = nloc; b.st[1] = nx; }
        const unsigned old = xb_add(&bar[XB_XSUB(b.x)], 1u);
        const unsigned gen = old / nloc;
        if (old + 1u == (gen + 1u) * nloc) {
            __builtin_amdgcn_fence(__ATOMIC_RELEASE, "agent");
            asm volatile("s_waitcnt vmcnt(0)" ::: "memory");
            const unsigned og = xb_add(&bar[XB_TOP], 1u);
            const unsigned tg = og / nx;
            if (og + 1u == (tg + 1u) * nx) xb_add(&bar[XB_TOPGEN], 1u);
            else XB_SPIN(xb_ld(&bar[XB_TOPGEN]) == tg, bar);
            __builtin_amdgcn_fence(__ATOMIC_ACQUIRE, "agent");
            xb_add(&bar[XB_XGEN(b.x)], 1u);
            asm volatile("s_waitcnt vmcnt(0)" ::: "memory");
        } else {
            XB_SPIN(xb_ld(&bar[XB_XGEN(b.x)]) == gen, bar);
            __builtin_amdgcn_fence(__ATOMIC_ACQUIRE, "agent");
            asm volatile("s_waitcnt vmcnt(0)" ::: "memory");
        }
    }
    __syncthreads();
}

struct Frame {
    LAS unsigned char* lds; int tid, lane, wave, G, bid;
    const float *x, *c, *w_ada, *b_ada, *norm1_g, *w_in, *b_fgate, *fox_q_g, *fox_k_g, *moba_q_g, *moba_k_g, *w_up_fox, *w_up_moba, *w_out, *norm2_g, *w_peer_q, *sub_keys, *peer_u, *peer_v;
    float* out; unsigned char* ws;
};

__device__ __forceinline__ void tr_item(const float* W, int ldw, int col0, int k0, bf16* WT, int ldt, int row0, LAS float* scr, int lane) {
#pragma unroll 8
    for (int i = 0; i < 32; ++i) { const int kk = 2 * i + (lane >> 5); scr[kk * 33 + (lane & 31)] = W[(size_t)(k0 + kk) * ldw + col0 + (lane & 31)]; }
    LDS_WAIT(); asm volatile("" ::: "memory");
    const int c = lane & 7;
#pragma unroll
    for (int j = 0; j < 4; ++j) { const int n = (lane >> 3) + 8 * j; const LAS float* s = scr + (8 * c) * 33 + n;
        v4u o; o.x = pk2(s[0 * 33], s[1 * 33]); o.y = pk2(s[2 * 33], s[3 * 33]); o.z = pk2(s[4 * 33], s[5 * 33]); o.w = pk2(s[6 * 33], s[7 * 33]);
        *(GAS v4u*)(WT + (size_t)(row0 + n) * ldt + k0 + 8 * c) = o; }
    LDS_WAIT(); asm volatile("" ::: "memory");
}

__device__ __forceinline__ void p0_prep(Frame& F) {
    const int tid = F.tid, lane = F.lane, wave = F.wave, G = F.G;
    float* mod = (float*)(F.ws + WS_MOD);
    {
        LAS float* Kt = (LAS float*)F.lds; LAS float* Wt = Kt + 128 * 128;
        bf16* WeffT = (bf16*)(F.ws + WS_WEFF);
        for (int it = F.bid; it < 256; it += G) {
            const int hp = it >> 4, d0 = (it & 15) * 64;
            const float* keys = F.sub_keys + (size_t)hp * 128 * 128;
#pragma unroll
            for (int i = 0; i < 8; ++i) { const int idx = (i * 512 + tid) * 4, n = idx >> 7, cc = idx & 127; const f32x4 v = *(const f32x4*)(keys + idx);
                Kt[(cc + 0) * 128 + n] = v[0]; Kt[(cc + 1) * 128 + n] = v[1]; Kt[(cc + 2) * 128 + n] = v[2]; Kt[(cc + 3) * 128 + n] = v[3]; }
#pragma unroll
            for (int i = 0; i < 4; ++i) { const int idx = (i * 512 + tid) * 4, dd = idx >> 7, cc = idx & 127; const f32x4 v = *(const f32x4*)(F.w_peer_q + (size_t)(d0 + dd) * 2048 + hp * 128 + cc);
                Wt[(cc + 0) * 64 + dd] = v[0]; Wt[(cc + 1) * 64 + dd] = v[1]; Wt[(cc + 2) * 64 + dd] = v[2]; Wt[(cc + 3) * 64 + dd] = v[3]; }
            __syncthreads();
            const int tn = tid & 31, td = tid >> 5;
            float acc[4][4];
#pragma unroll
            for (int i = 0; i < 4; ++i)
#pragma unroll
                for (int j = 0; j < 4; ++j) acc[i][j] = 0.f;
            for (int cc = 0; cc < 128; ++cc) { const f32x4 kv = *(const LAS f32x4*)(Kt + cc * 128 + 4 * tn), wv = *(const LAS f32x4*)(Wt + cc * 64 + 4 * td);
#pragma unroll
                for (int i = 0; i < 4; ++i)
#pragma unroll
                    for (int j = 0; j < 4; ++j) acc[i][j] += kv[i] * wv[j]; }
#pragma unroll
            for (int i = 0; i < 4; ++i) { v2u o; o.x = pk2(acc[i][0], acc[i][1]); o.y = pk2(acc[i][2], acc[i][3]); *(GAS v2u*)(WeffT + (size_t)(hp * 128 + 4 * tn + i) * 1024 + d0 + 4 * td) = o; }
            __syncthreads();
        }
    }
    {
        LAS float* sc = (LAS float*)F.lds; LAS float* red = sc + 8192;
        for (int it = F.bid; it < 96; it += G) {
            for (int i = tid; i < 8192; i += 512) { const int bb = i >> 10, k = i & 1023; const float v = F.c[i]; sc[k * 8 + bb] = v / (1.0f + expf(-v)); }
            __syncthreads();
            const int n = it * 64 + lane; float a[8];
#pragma unroll
            for (int bb = 0; bb < 8; ++bb) a[bb] = 0.f;
#pragma unroll 4
            for (int k = wave * 128; k < wave * 128 + 128; ++k) { const float w = F.w_ada[(size_t)k * 6144 + n]; const f32x4 s0 = *(const LAS f32x4*)(sc + k * 8), s1 = *(const LAS f32x4*)(sc + k * 8 + 4);
                a[0] += w * s0[0]; a[1] += w * s0[1]; a[2] += w * s0[2]; a[3] += w * s0[3]; a[4] += w * s1[0]; a[5] += w * s1[1]; a[6] += w * s1[2]; a[7] += w * s1[3]; }
#pragma unroll
            for (int bb = 0; bb < 8; ++bb) red[(wave * 8 + bb) * 64 + lane] = a[bb];
            __syncthreads();
            { const int bb = tid >> 6; float s = 0.f;
#pragma unroll
              for (int w = 0; w < 8; ++w) s += red[(w * 8 + bb) * 64 + lane];
              mod[bb * 6144 + it * 64 + lane] = s + F.b_ada[it * 64 + lane]; }
            __syncthreads();
        }
    }
    {
        LAS float* scr = (LAS float*)(F.lds + wave * 16384);
        const int gw = F.bid * NWAVES + wave, NGW = G * NWAVES;
        constexpr int I_IN = 16 * 160, I_UP = 8 * 32, I_OUT = 16 * 32;
        for (int it = gw; it < I_IN + 2 * I_UP + I_OUT; it += NGW) {
            int r = it;
            if (r < I_IN) { const int kb = r / 160, rb = r % 160, tile = rb >> 3, bj = (rb >> 2) & 1, wc = rb & 3; const int Lg = tile * 256 + 64 * wc + 32 * bj; const int src = Lg < 1536 ? Lg : Lg + 8;
                tr_item(F.w_in, IN_COLS, src, kb * 64, (bf16*)(F.ws + WS_WIN), 1024, rb * 32, scr, lane); continue; }
            r -= I_IN;
            if (r < I_UP) { tr_item(F.w_up_fox, 1024, (r & 31) * 32, (r >> 5) * 64, (bf16*)(F.ws + WS_WFT), 512, (r & 31) * 32, scr, lane); continue; }
            r -= I_UP;
            if (r < I_UP) { tr_item(F.w_up_moba, 1024, (r & 31) * 32, (r >> 5) * 64, (bf16*)(F.ws + WS_WMT), 512, (r & 31) * 32, scr, lane); continue; }
            r -= I_UP;
            tr_item(F.w_out, 1024, (r & 31) * 32, (r >> 5) * 64, (bf16*)(F.ws + WS_WOT), 1024, (r & 31) * 32, scr, lane);
        }
    }
    {
        const size_t gt = (size_t)F.bid * 512 + tid, NT_ = (size_t)G * 512;
        float* wfg = (float*)(F.ws + WS_WFG);
        for (size_t i = gt; i < 8192; i += NT_) { const int j = (int)(i >> 10), k = (int)(i & 1023); wfg[i] = F.w_in[(size_t)k * IN_COLS + 1536 + j]; }
        if (gt < 64) { float* gn = (float*)(F.ws + WS_GAINS); gn[gt] = F.fox_q_g[gt]; gn[64 + gt] = F.fox_k_g[gt]; gn[128 + gt] = F.moba_q_g[gt]; gn[192 + gt] = F.moba_k_g[gt]; }
    }
    {
        const int gw = F.bid * NWAVES + wave, NGW = G * NWAVES;
        for (int r = gw; r < 2 * NEXP; r += NGW) {
            const bool isu = r < NEXP; const int rr = isu ? r : r - NEXP;
            const GAS f32x4* src = (const GAS f32x4*)((isu ? F.peer_u : F.peer_v) + (size_t)rr * 1024) + lane;
            f32x4 v[4]; float mx = 0.f;
#pragma unroll
            for (int j = 0; j < 4; ++j) { v[j] = src[64 * j]; mx = fmaxf(mx, fmaxf(fmaxf(fabsf(v[j][0]), fabsf(v[j][1])), fmaxf(fabsf(v[j][2]), fabsf(v[j][3])))); }
#pragma unroll
            for (int o = 1; o < 64; o <<= 1) mx = fmaxf(mx, __shfl_xor(mx, o));
            const float sc = mx > 0.f ? mx * (1.0f / 384.0f) : 1.0f, inv = 1.0f / sc;
            GAS unsigned* dst = (GAS unsigned*)(F.ws + (isu ? WS_U8 : WS_V8) + (size_t)rr * 1024) + lane;
#pragma unroll
            for (int j = 0; j < 4; ++j) { int w = 0; w = __builtin_amdgcn_cvt_pk_fp8_f32(v[j][0] * inv, v[j][1] * inv, w, false); w = __builtin_amdgcn_cvt_pk_fp8_f32(v[j][2] * inv, v[j][3] * inv, w, true); dst[64 * j] = (unsigned)w; }
            if (lane == 0) ((float*)(F.ws + (isu ? WS_SU : WS_SV)))[rr] = sc;
        }
    }
}

template <int SECOND>
__device__ __forceinline__ void rows_phase(Frame& F) {
    const int tid = F.tid, lane = F.lane, wave = F.wave;
    LAS float* Ac = (LAS float*)F.lds; LAS float* Bc = Ac + 1024; LAS float* wfs = Bc + 1024;
    const float* mod = (const float*)(F.ws + WS_MOD);
    const float* src = SECOND ? F.out : F.x;
    const float* gain = SECOND ? F.norm2_g : F.norm1_g;
    bf16* dst = (bf16*)(F.ws + WS_HY);
    if (!SECOND) { const float* wfg = (const float*)(F.ws + WS_WFG); for (int i = tid; i < 8192; i += 512) wfs[i] = wfg[i]; }
    for (int it = F.bid; it < 256; it += F.G) {
        const int b = it >> 5;
        const float* shift = mod + (size_t)b * 6144 + (SECOND ? 3072 : 0); const float* scale = shift + 1024;
        __syncthreads();
        for (int i = tid; i < 1024; i += 512) { Ac[i] = gain[i] * (1.0f + scale[i]); Bc[i] = shift[i]; }
        __syncthreads();
        for (int i = 0; i < 8; ++i) {
            const int row = it * 64 + wave * 8 + i;
            const GAS f32x4* xr = (const GAS f32x4*)(src + (size_t)row * 1024) + lane;
            f32x4 v[4]; float ss = 0.f;
#pragma unroll
            for (int j = 0; j < 4; ++j) { v[j] = xr[64 * j]; ss += (v[j][0] * v[j][0] + v[j][1] * v[j][1]) + (v[j][2] * v[j][2] + v[j][3] * v[j][3]); }
            float rstd;
            if (SECOND) { const float* pp = (const float*)(F.ws + WS_PARTS) + (size_t)row * 16; float s = 0.f;
#pragma unroll
                for (int q = 0; q < 16; ++q) s += pp[q];
                rstd = rsqrtf(s * (1.0f / 1024.0f) + RMS_EPS); }
            else rstd = rsqrtf(wave_sum(ss) * (1.0f / 1024.0f) + RMS_EPS);
            float p[8];
#pragma unroll
            for (int q = 0; q < 8; ++q) p[q] = 0.f;
            GAS v2u* o8 = (GAS v2u*)(dst + (size_t)row * 1024) + lane;
#pragma unroll
            for (int j = 0; j < 4; ++j) {
                const int col = 4 * (64 * j + lane);
                const f32x4 a = *(const LAS f32x4*)(Ac + col), bb = *(const LAS f32x4*)(Bc + col);
                const f32x4 hv = v[j] * rstd * a + bb;
                v2u o; o.x = pk2(hv[0], hv[1]); o.y = pk2(hv[2], hv[3]); o8[64 * j] = o;
                if (!SECOND) {
#pragma unroll
                    for (int q = 0; q < 8; ++q) { const f32x4 w = *(const LAS f32x4*)(wfs + q * 1024 + col); p[q] += (hv[0] * w[0] + hv[1] * w[1]) + (hv[2] * w[2] + hv[3] * w[3]); }
                }
            }
            if (!SECOND) {
                float mine = 0.f;
#pragma unroll
                for (int q = 0; q < 8; ++q) { const float s = wave_sum(p[q]); mine = (lane == q) ? s : mine; }
                if (lane < 8) { const float z = mine + F.b_fgate[lane]; const float ls = fminf(z, 0.f) - log1pf(expf(-fabsf(z))); ((float*)(F.ws + WS_LF))[(size_t)row * 8 + lane] = ls; }
            }
        }
    }
    __syncthreads();
}

__device__ __forceinline__ void fcum_items(Frame& F) {
    LAS float* wtot = (LAS float*)F.lds;
    const float* LFp = (const float*)(F.ws + WS_LF); float* Fc = (float*)(F.ws + WS_FC);
    for (int it = F.bid; it < 64; it += F.G) {
        const int b = it >> 3, h = it & 7, s0 = 4 * F.tid;
        float v[4];
#pragma unroll
        for (int i = 0; i < 4; ++i) v[i] = LFp[((size_t)b * SEQ + s0 + i) * 8 + h];
        v[1] += v[0]; v[2] += v[1]; v[3] += v[2];
        float inc = v[3];
#pragma unroll
        for (int o = 1; o < 64; o <<= 1) { const float t = __shfl_up(inc, o); if (F.lane >= o) inc += t; }
        __syncthreads();
        if (F.lane == 63) wtot[F.wave] = inc;
        __syncthreads();
        float base = inc - v[3];
        for (int w = 0; w < F.wave; ++w) base += wtot[w];
        float* o = Fc + (size_t)(b * NHEAD + h) * SEQ + s0;
#pragma unroll
        for (int i = 0; i < 4; ++i) o[i] = base + v[i];
    }
    __syncthreads();
}

__device__ __forceinline__ unsigned okey(float f) { const unsigned u = __float_as_uint(f); return (u & 0x80000000u) ? ~u : (u | 0x80000000u); }
__device__ __forceinline__ float okey_inv(unsigned k) { return __uint_as_float((k & 0x80000000u) ? (k ^ 0x80000000u) : ~k); }
__device__ __forceinline__ void chain16(unsigned (&L)[16], unsigned x) {
#pragma unroll
    for (int k = 0; k < 16; ++k) { const unsigned hi = L[k] > x ? L[k] : x; x = L[k] > x ? x : L[k]; L[k] = hi; }
}
__device__ __forceinline__ void top16_of_128(const float* p, unsigned (&L)[16]) {
#pragma unroll
    for (int k = 0; k < 16; ++k) L[k] = 0u;
    for (int c = 0; c < 4; ++c) {
        f32x4 v[8];
#pragma unroll
        for (int j = 0; j < 8; ++j) v[j] = *(const f32x4*)(p + c * 32 + j * 4);
#pragma unroll
        for (int j = 0; j < 8; ++j)
#pragma unroll
            for (int e = 0; e < 4; ++e) chain16(L, (okey(v[j][e]) & ~127u) | (unsigned)(127 - (c * 32 + j * 4 + e)));
    }
}
__device__ __forceinline__ void topk_phase(Frame& F) {
    const float* SC = (const float*)(F.ws + WS_SC); unsigned* EG = (unsigned*)(F.ws + WS_EG);
    LAS unsigned char* tab = F.lds + F.tid * 32;
    for (int th = F.bid * 512 + F.tid; th < NTOK * 8; th += F.G * 512) {
        const float* p = SC + (size_t)th * 256;
        unsigned L1[16], L2[16];
        top16_of_128(p, L1); top16_of_128(p + 128, L2);
        float v1[16], v2[16];
#pragma unroll
        for (int k = 0; k < 16; ++k) { v1[k] = okey_inv(L1[k] & ~127u); tab[k] = (unsigned char)(127u - (L1[k] & 127u)); v2[k] = okey_inv(L2[k] & ~127u); tab[16 + k] = (unsigned char)(127u - (L2[k] & 127u)); }
        unsigned C[16];
#pragma unroll
        for (int j = 0; j < 16; ++j) C[j] = (okey(v1[0] + v2[j]) & ~255u) | (unsigned)(255 - j);
#pragma unroll
        for (int i = 1; i < 16; ++i)
#pragma unroll
            for (int j = 0; j < 16 / (i + 1); ++j) chain16(C, (okey(v1[i] + v2[j]) & ~255u) | (unsigned)(255 - (i * 16 + j)));
        float sv[16]; float sum = 0.f; const float mx = okey_inv(C[0] & ~255u);
#pragma unroll
        for (int k = 0; k < 16; ++k) { sv[k] = expf(okey_inv(C[k] & ~255u) - mx); sum += sv[k]; }
        const float rs = 1.0f / sum;
        unsigned o[16];
#pragma unroll
        for (int k = 0; k < 16; ++k) { const int pos = 255 - (int)(C[k] & 255u); const unsigned eid = (unsigned)tab[pos >> 4] * 128u + (unsigned)tab[16 + (pos & 15)];
            const _Float16 hg = (_Float16)(sv[k] * rs); o[k] = ((unsigned)__builtin_bit_cast(unsigned short, hg) << 16) | eid; }
        GAS v4u* dst = (GAS v4u*)(EG + (size_t)th * 16);
#pragma unroll
        for (int q = 0; q < 4; ++q) dst[q] = (v4u){o[4 * q], o[4 * q + 1], o[4 * q + 2], o[4 * q + 3]};
    }
}

typedef float f32x2v __attribute__((ext_vector_type(2)));
__device__ __forceinline__ float gelu_tanh(float a) { const float y = 0.7978845608028654f * (a + 0.044715f * a * a * a); const float th = 1.0f - 2.0f / (__expf(2.0f * y) + 1.0f); return 0.5f * a * (1.0f + th); }
__device__ __forceinline__ void fp8x16_to_f32(const v4u r, float (&f)[16]) {
#pragma unroll
    for (int q = 0; q < 4; ++q) { const f32x2v lo = __builtin_amdgcn_cvt_pk_f32_fp8((int)r[q], false), hi = __builtin_amdgcn_cvt_pk_f32_fp8((int)r[q], true); f[4 * q] = lo[0]; f[4 * q + 1] = lo[1]; f[4 * q + 2] = hi[0]; f[4 * q + 3] = hi[1]; }
}
__device__ __forceinline__ void peer_u_phase(Frame& F) {
    const int lane = F.lane, wave = F.wave, g = lane >> 3, ch = lane & 7;
    const bool sliced = (F.G % 8) == 0;
    const int x_lo = sliced ? (F.bid & 7) : 0, x_hi = sliced ? x_lo + 1 : 8;
    const int wv = sliced ? (F.bid >> 3) * NWAVES + wave : F.bid * NWAVES + wave, NW = sliced ? (F.G >> 3) * NWAVES : F.G * NWAVES;
    const unsigned* EG = (const unsigned*)(F.ws + WS_EG); const bf16* H2 = (const bf16*)(F.ws + WS_HY);
    const unsigned char* U8 = F.ws + WS_U8; float* Pp = (float*)(F.ws + WS_PP);
    const bool b0 = (lane & 1) != 0, b1 = (lane & 2) != 0, b2 = (lane & 4) != 0;
    for (int x = x_lo; x < x_hi; ++x)
    for (int t = wv; t < NTOK; t += NW) {
        v4u eg[4];
#pragma unroll
        for (int q = 0; q < 4; ++q) eg[q] = *(const GAS v4u*)(EG + (size_t)t * 128 + 16 * g + 4 * q);
        float hf[16];
        { const bf16* hp = H2 + (size_t)t * 1024 + 128 * x + 16 * ch; const v4u ha = *(const GAS v4u*)hp, hb = *(const GAS v4u*)(hp + 8);
#pragma unroll
          for (int q = 0; q < 4; ++q) { hf[2 * q] = pg8::bf_lo(ha[q]); hf[2 * q + 1] = pg8::bf_hi(ha[q]); hf[8 + 2 * q] = pg8::bf_lo(hb[q]); hf[8 + 2 * q + 1] = pg8::bf_hi(hb[q]); } }
        v4u r[16];
#pragma unroll
        for (int i = 0; i < 16; ++i) { const unsigned e = eg[i >> 2][i & 3] & 0xffffu; r[i] = *(const GAS v4u*)(U8 + (size_t)e * 1024 + 128 * x + 16 * ch); }
        float p[16];
#pragma unroll
        for (int i = 0; i < 16; ++i) { float f[16]; fp8x16_to_f32(r[i], f); float a = 0.f;
#pragma unroll
            for (int c = 0; c < 16; ++c) a += f[c] * hf[c];
            p[i] = a; __builtin_amdgcn_sched_barrier(0); }
        float r8[8], r4[4], r2[2];
#pragma unroll
        for (int c = 0; c < 8; ++c) { const float keep = b0 ? p[8 + c] : p[c], send = b0 ? p[c] : p[8 + c]; r8[c] = keep + __shfl_xor(send, 1); }
#pragma unroll
        for (int c = 0; c < 4; ++c) { const float keep = b1 ? r8[4 + c] : r8[c], send = b1 ? r8[c] : r8[4 + c]; r4[c] = keep + __shfl_xor(send, 2); }
#pragma unroll
        for (int c = 0; c < 2; ++c) { const float keep = b2 ? r4[2 + c] : r4[c], send = b2 ? r4[c] : r4[2 + c]; r2[c] = keep + __shfl_xor(send, 4); }
        const int slot = 16 * g + (b0 ? 8 : 0) + (b1 ? 4 : 0) + (b2 ? 2 : 0);
        *(GAS f32x2v*)(Pp + ((size_t)x * NTOK + t) * 128 + slot) = (f32x2v){r2[0], r2[1]};
    }
}
__device__ __forceinline__ void peer_w_phase(Frame& F) {
    const unsigned* EG = (const unsigned*)(F.ws + WS_EG); const float* Pp = (const float*)(F.ws + WS_PP);
    const float* SU = (const float*)(F.ws + WS_SU); const float* SV = (const float*)(F.ws + WS_SV); float* Wt = (float*)(F.ws + WS_WT);
    for (size_t i = (size_t)F.bid * 512 + F.tid; i < (size_t)NTOK * 128; i += (size_t)F.G * 512) {
        float a = 0.f;
#pragma unroll
        for (int x = 0; x < 8; ++x) a += Pp[(size_t)x * NTOK * 128 + i];
        const unsigned egv = EG[i]; const unsigned e = egv & 0xffffu;
        Wt[i] = (float)__builtin_bit_cast(_Float16, (unsigned short)(egv >> 16)) * gelu_tanh(a * SU[e]) * SV[e];
    }
}
__device__ __forceinline__ void peer_v_phase(Frame& F, bool dry) {
    const int lane = F.lane, wave = F.wave, g = lane >> 3, ch = lane & 7;
    const bool sliced = (F.G % 8) == 0;
    const int x_lo = sliced ? (F.bid & 7) : 0, x_hi = sliced ? x_lo + 1 : 8;
    const int wv = sliced ? (F.bid >> 3) * NWAVES + wave : F.bid * NWAVES + wave, NW = sliced ? (F.G >> 3) * NWAVES : F.G * NWAVES;
    const unsigned* EG = (const unsigned*)(F.ws + WS_EG); const float* Wt = (const float*)(F.ws + WS_WT);
    const unsigned char* V8 = F.ws + WS_V8; const float* mod = (const float*)(F.ws + WS_MOD);
    const bool b5 = (lane & 32) != 0, b4 = (lane & 16) != 0, b3 = (lane & 8) != 0;
    for (int x = x_lo; x < x_hi; ++x)
    for (int t = wv; t < NTOK; t += NW) {
        v4u eg[4]; f32x4 wk[4];
#pragma unroll
        for (int q = 0; q < 4; ++q) { eg[q] = *(const GAS v4u*)(EG + (size_t)t * 128 + 16 * g + 4 * q); wk[q] = *(const GAS f32x4*)(Wt + (size_t)t * 128 + 16 * g + 4 * q); }
        v4u r[16];
#pragma unroll
        for (int i = 0; i < 16; ++i) { const unsigned e = eg[i >> 2][i & 3] & 0xffffu; r[i] = *(const GAS v4u*)(V8 + (size_t)e * 1024 + 128 * x + 16 * ch); }
        float acc[16];
#pragma unroll
        for (int c = 0; c < 16; ++c) acc[c] = 0.f;
#pragma unroll
        for (int i = 0; i < 16; ++i) { float f[16]; fp8x16_to_f32(r[i], f); const float w = wk[i >> 2][i & 3];
#pragma unroll
            for (int c = 0; c < 16; ++c) acc[c] += w * f[c]; }
        float r8[8], r4[4], r2[2];
#pragma unroll
        for (int c = 0; c < 8; ++c) { const float keep = b3 ? acc[8 + c] : acc[c], send = b3 ? acc[c] : acc[8 + c]; r8[c] = keep + __shfl_xor(send, 8); }
#pragma unroll
        for (int c = 0; c < 4; ++c) { const float keep = b4 ? r8[4 + c] : r8[c], send = b4 ? r8[c] : r8[4 + c]; r4[c] = keep + __shfl_xor(send, 16); }
#pragma unroll
        for (int c = 0; c < 2; ++c) { const float keep = b5 ? r4[2 + c] : r4[c], send = b5 ? r4[c] : r4[2 + c]; r2[c] = keep + __shfl_xor(send, 32); }
        const int col = 128 * x + 16 * ch + (b3 ? 8 : 0) + (b4 ? 4 : 0) + (b5 ? 2 : 0);
        const int b = t >> 11; const float* g2 = mod + (size_t)b * 6144 + 5120;
        float* orow = F.out + (size_t)t * 1024;
        const f32x2v xv = *(const GAS f32x2v*)(orow + col), gvv = *(const GAS f32x2v*)(g2 + col);
        f32x2v o; o[0] = xv[0] + gvv[0] * r2[0]; o[1] = xv[1] + gvv[1] * r2[1];
        *(GAS f32x2v*)((dry ? (float*)(F.ws + WS_SC) + (size_t)t * 1024 : orow) + col) = o;
    }
}

constexpr int N_PHASES = 12;
struct Args { const float* in[19]; float* out; unsigned char* ws; int ph_lo, ph_hi; };
__global__ void __launch_bounds__(NWAVES * 64, 2) fwd_kernel(Args args) {
    extern __shared__ __attribute__((aligned(16))) unsigned char lds_raw[];
    Frame F;
    F.lds = (LAS unsigned char*)lds_raw;
    F.tid = threadIdx.x; F.lane = F.tid & 63; F.wave = __builtin_amdgcn_readfirstlane(F.tid >> 6); F.G = gridDim.x; F.bid = blockIdx.x;
    F.x = args.in[0]; F.c = args.in[1]; F.w_ada = args.in[2]; F.b_ada = args.in[3]; F.norm1_g = args.in[4]; F.w_in = args.in[5]; F.b_fgate = args.in[6];
    F.fox_q_g = args.in[7]; F.fox_k_g = args.in[8]; F.moba_q_g = args.in[9]; F.moba_k_g = args.in[10]; F.w_up_fox = args.in[11]; F.w_up_moba = args.in[12];
    F.w_out = args.in[13]; F.norm2_g = args.in[14]; F.w_peer_q = args.in[15]; F.sub_keys = args.in[16]; F.peer_u = args.in[17]; F.peer_v = args.in[18];
    F.out = args.out; F.ws = args.ws;
    unsigned char* ws = args.ws;
    volatile LAS unsigned* MISC = (volatile LAS unsigned*)(F.lds + MISC_OFF);
    for (int u = F.tid; u < (LDS_BYTES - LDSCTL_OFF) / 4; u += NWAVES * 64) ((LAS unsigned*)(F.lds + LDSCTL_OFF))[u] = 0u;
    __syncthreads();
#if !MK_PER_PHASE
    XcdBarrier bar = xcd_barrier_post((unsigned*)(ws + WS_CTL) + CW_BAR, MISC + 8);
#define GRID_BAR() xcd_barrier(bar)
#else
    (void)MISC;
#define GRID_BAR() do {} while (0)
#endif
    const int lo = args.ph_lo, hi = args.ph_hi;
#define IN(k) (lo <= (k) && (k) < hi)
#define REPS(k) (((k) == DUP_PHASE) ? DUP_N : 1)
#define REP(k) for (int rep_ = 0; rep_ < REPS(k); ++rep_)
#define REPBAR(k) do { if (rep_ + 1 < REPS(k)) GRID_BAR(); } while (0)
#define SEAM(k) do { if (IN(k) && IN((k) + 1)) GRID_BAR(); } while (0)
    typedef pg8::bf16_t pb;

    if (IN(0)) REP(0) { p0_prep(F); REPBAR(0); } SEAM(0);
    if (IN(1)) REP(1) { rows_phase<0>(F); REPBAR(1); } SEAM(1);
    if (IN(2)) REP(2) {
        fcum_items(F);
        pg8::Gemm g{(const pb*)(ws + WS_HY), (const pb*)(ws + WS_WIN), NTOK, NIN, DM, DM, DM}; pg8::StaticOrder S; S.init(NTOK, NIN, F.G, F.bid);
        pg8::EpiIn E{(pb*)(ws + WS_QKV), (pb*)F.out, (const float*)(ws + WS_GAINS), (float*)(ws + ((rep_ + 1 < REPS(2)) ? WS_EG : WS_KMEAN))};
        pg8::gemm_phase<pg8::EpiIn, pg8::StaticOrder, true, true>(F.lds, g, S, E);
        REPBAR(2);
    } SEAM(2);
    if (IN(3)) REP(3) {
        const pb* qkv = (const pb*)(ws + WS_QKV); constexpr size_t TS = (size_t)NTOK * 512;
        for (int it = F.bid; it < 256; it += F.G) {
            const int bh = it >> 2, s = it & 3, b = bh >> 3, h = bh & 7;
            att::attn_unit<0>(b, h, 7 - s, qkv, qkv + TS, qkv + 2 * TS, (const float*)(ws + WS_FC), nullptr, (pb*)(ws + WS_HY), (__attribute__((address_space(3))) char*)F.lds);
            att::attn_unit<1>(b, h, 7 - s, qkv + 3 * TS, qkv + 4 * TS, qkv + 5 * TS, nullptr, (const float*)(ws + WS_KMEAN), (pb*)(ws + WS_HY), (__attribute__((address_space(3))) char*)F.lds);
            att::attn_unit<0>(b, h, s, qkv, qkv + TS, qkv + 2 * TS, (const float*)(ws + WS_FC), nullptr, (pb*)(ws + WS_HY), (__attribute__((address_space(3))) char*)F.lds);
            att::attn_unit<1>(b, h, s, qkv + 3 * TS, qkv + 4 * TS, qkv + 5 * TS, nullptr, (const float*)(ws + WS_KMEAN), (pb*)(ws + WS_HY), (__attribute__((address_space(3))) char*)F.lds);
        }
        REPBAR(3);
    } SEAM(3);
    if (IN(4)) {
        pg8::StaticOrder S; S.init(NTOK, DM, F.G, F.bid);
        { pg8::Gemm g{(const pb*)(ws + WS_HY), (const pb*)(ws + WS_WFT), NTOK, DM, 512, DM, 512};
          pg8::EpiUp<0> E{(const pb*)F.out, (pb*)(ws + WS_MIX)}; pg8::gemm_phase<pg8::EpiUp<0>, pg8::StaticOrder, true, true>(F.lds, g, S, E); }
        VM_WAIT(); __syncthreads();
        { pg8::Gemm g{(const pb*)(ws + WS_HY) + 512, (const pb*)(ws + WS_WMT), NTOK, DM, 512, DM, 512};
          pg8::EpiUp<1> E{(const pb*)F.out, (pb*)(ws + WS_MIX)}; pg8::gemm_phase<pg8::EpiUp<1>, pg8::StaticOrder, true, true>(F.lds, g, S, E); }
    } SEAM(4);
    if (IN(5)) {
        pg8::Gemm g{(const pb*)(ws + WS_MIX), (const pb*)(ws + WS_WOT), NTOK, DM, DM, DM, DM}; pg8::StaticOrder S; S.init(NTOK, DM, F.G, F.bid);
        pg8::EpiOut E{F.x, (const float*)(ws + WS_MOD), F.out, (float*)(ws + WS_PARTS)};
        pg8::gemm_phase<pg8::EpiOut, pg8::StaticOrder, true, true>(F.lds, g, S, E);
    } SEAM(5);
    if (IN(6)) { rows_phase<1>(F); } SEAM(6);
    if (IN(7)) REP(7) {
        pg8::Gemm g{(const pb*)(ws + WS_HY), (const pb*)(ws + WS_WEFF), NTOK, NSC, DM, DM, DM}; pg8::StaticOrder S; S.init(NTOK, NSC, F.G, F.bid);
        pg8::EpiSc E{(float*)(ws + WS_SC)};
        pg8::gemm_phase<pg8::EpiSc, pg8::StaticOrder, true, true>(F.lds, g, S, E);
        REPBAR(7);
    } SEAM(7);
    if (IN(8)) REP(8) { topk_phase(F); REPBAR(8); } SEAM(8);
    if (IN(9)) REP(9) { peer_u_phase(F); REPBAR(9); } SEAM(9);
    if (IN(10)) REP(10) { peer_w_phase(F); REPBAR(10); } SEAM(10);
    if (IN(11)) REP(11) { peer_v_phase(F, rep_ + 1 < REPS(11)); REPBAR(11); }
#undef IN
#undef SEAM
}

extern "C" void kernel_launch(void* const* d_in, const int* in_sizes, int n_in, void* d_out, int out_size, void* d_ws, size_t ws_size, hipStream_t stream) {
    static int grid = 0;
    if (grid == 0) {
        if (n_in != 19 || out_size != NTOK * DM || ws_size < WS_END) { fprintf(stderr, "kernel_launch: unexpected shapes (n_in %d, out %d, ws %zu); nothing launched\n", n_in, out_size, ws_size); grid = -1; return; }
        int dev = 0, cus = 0, per_cu = 0;
        if (hipGetDevice(&dev) != hipSuccess || hipDeviceGetAttribute(&cus, hipDeviceAttributeMultiprocessorCount, dev) != hipSuccess) { grid = -1; return; }
        if (hipFuncSetAttribute((const void*)fwd_kernel, hipFuncAttributeMaxDynamicSharedMemorySize, LDS_BYTES) != hipSuccess) { fprintf(stderr, "kernel_launch: hipFuncSetAttribute failed\n"); grid = -1; return; }
        if (hipOccupancyMaxActiveBlocksPerMultiprocessor(&per_cu, (const void*)fwd_kernel, NWAVES * 64, LDS_BYTES) != hipSuccess || per_cu < 1) { fprintf(stderr, "kernel_launch: occupancy query says %d blocks per CU\n", per_cu); per_cu = 1; }
        (void)hipGetLastError();
        grid = cus;
    }
    if (grid < 0) return;
    (void)hipMemsetAsync((char*)d_ws + WS_CTL, 0, CTL_ZERO_BYTES, stream);
    Args a{};
    for (int i = 0; i < 19; ++i) a.in[i] = (const float*)d_in[i];
    a.out = (float*)d_out; a.ws = (unsigned char*)d_ws;
#if MK_PER_PHASE
    for (int ph = 0; ph < N_PHASES; ++ph) { a.ph_lo = ph; a.ph_hi = ph + 1; hipLaunchKernelGGL(fwd_kernel, dim3(grid), dim3(NWAVES * 64), LDS_BYTES, stream, a); }
#else
    a.ph_lo = 0; a.ph_hi = N_PHASES;
    hipLaunchKernelGGL(fwd_kernel, dim3(grid), dim3(NWAVES * 64), LDS_BYTES, stream, a);
#endif
}
```

```cpp
#include <hip/hip_runtime.h>
#include <hip/hip_bf16.h>
#include <cstdio>
#include <cstdint>
#include <cmath>

#ifndef DUP_PHASE
#define DUP_PHASE -1
#endif
#define DUP_N 2
#ifndef MK_PER_PHASE
#define MK_PER_PHASE 0
#endif

constexpr int NB = 8, SEQ = 2048, DM = 1024, NTOK = NB * SEQ, NHEAD = 8, HDIM = 64;
constexpr int IN_COLS = 5128, NIN = 5120, NSC = 2048, NEXP = 16384;
constexpr float RMS_EPS = 1e-6f;
constexpr float LOG2E = 1.4426950408889634f;
constexpr float QSCALE = 0.125f * LOG2E;

namespace pg8 {
#define PG8_LAS __attribute__((address_space(3)))
typedef unsigned short bf16_t;
typedef short bf16x8 __attribute__((ext_vector_type(8)));
typedef float f32x4 __attribute__((ext_vector_type(4)));
typedef unsigned u32x4 __attribute__((ext_vector_type(4)));
constexpr int BM = 256, BK = 64, HALF = 128, HTB = HALF * BK * 2  , STAGE_BYTES = 8 * HTB, NXCD = 8, WGM = 8;

__host__ __device__ __forceinline__ int lds_byte(int r, int c) { const int st = (r >> 4) * 2 + (c >> 5), rr = r & 15, cc = c & 31, ob = rr * 64 + cc * 2; return st * 1024 + (ob ^ (((ob >> 9) & 1) << 5)); }
__host__ __device__ __forceinline__ void stage_rc(int b, int& R, int& C) { const int st = b / 1024, sb = b % 1024, swz = sb ^ (((sb >> 9) & 1) << 5); R = (st >> 1) * 16 + swz / 64; C = (st & 1) * 32 + (swz % 64) / 2; }
__host__ __device__ __forceinline__ int perm32(int rho) { const int n = rho >> 4, i = rho & 15; return 8 * (i >> 2) + 4 * n + (i & 3); }

struct Unit { int pm, pn; };
struct Gemm { const bf16_t* A; const bf16_t* Bt; int M, N, K, lda, ldb; };

struct StaticOrder {
    int nM, nN, nwg, G, c;
    __host__ __device__ void init(int M, int N, int G_, int c_) { nM = M / BM; nN = N / BM; nwg = nM * nN; G = G_; c = c_; }
    __host__ __device__ bool next(int i, Unit& u) const {
        const long L = (long)i * G + c; if (L >= nwg) return false;
        int wgid = (int)L; { const int q = nwg / NXCD, r = nwg % NXCD, xcd = wgid % NXCD, off = wgid / NXCD; wgid = (xcd < r ? xcd * (q + 1) : r * (q + 1) + (xcd - r) * q) + off; }
        const int nig = WGM * nN, gid = wgid / nig, fm = gid * WGM, gsz = (nM - fm) < WGM ? (nM - fm) : WGM;
        u.pm = fm + ((wgid % nig) % gsz); u.pn = (wgid % nig) / gsz; return true;
    }
    __device__ __forceinline__ void a_ready(const Unit&) const {}
    __device__ __forceinline__ void done(const Unit&) const {}
};

__device__ __forceinline__ unsigned cvt_pk_bf16(float lo, float hi) { unsigned r; asm volatile("v_cvt_pk_bf16_f32 %0, %1, %2" : "=v"(r) : "v"(lo), "v"(hi)); return r; }
__device__ __forceinline__ float bf_lo(unsigned w) { return __uint_as_float(w << 16); }
__device__ __forceinline__ float bf_hi(unsigned w) { return __uint_as_float(w & 0xffff0000u); }
__device__ __forceinline__ float sigmoidf_(float x) { return 1.0f / (1.0f + __expf(-x)); }

struct EpiIn {
    static constexpr bool PERM = true, AFTER_DRAIN = false;
    bf16_t* qkv;
    bf16_t* G;
    const float* gains;
    float* kmean;
    __device__ __forceinline__ void operator()(const f32x4 (&acc)[2][2][4][2], const Unit& u, int wr, int wc, int fr, int fq) const {
        const int pn = u.pn;
        if (pn < 12) {
            const int sec = pn >> 1, head = (pn & 1) * 4 + wc;
            const bool isq = (sec == 0 || sec == 3), isk = (sec == 1 || sec == 4);
            const float* gp = gains + ((sec >= 3 ? sec - 1 : sec) & 3) * 64;
            f32x4 gv[2][2];
#pragma unroll
            for (int bj = 0; bj < 2; ++bj)
#pragma unroll
                for (int n = 0; n < 2; ++n) { gv[bj][n] = (f32x4){1.f, 1.f, 1.f, 1.f}; if (isq || isk) gv[bj][n] = *(const f32x4*)(gp + 32 * bj + 8 * fq + 4 * n) * (isq ? QSCALE : 1.0f); }
            bf16_t* base = qkv + (size_t)sec * ((size_t)NTOK * 512);
            f32x4 cs[2][2];
#pragma unroll
            for (int bj = 0; bj < 2; ++bj)
#pragma unroll
                for (int n = 0; n < 2; ++n) cs[bj][n] = (f32x4){0.f, 0.f, 0.f, 0.f};
#pragma unroll
            for (int ai = 0; ai < 2; ++ai)
#pragma unroll
                for (int m = 0; m < 4; ++m) {
                    const int row = u.pm * BM + ai * HALF + wr * 64 + m * 16 + fr; const int b = row >> 11, s = row & 2047;
                    f32x4 v[2][2];
#pragma unroll
                    for (int bj = 0; bj < 2; ++bj)
#pragma unroll
                        for (int n = 0; n < 2; ++n) v[bj][n] = acc[ai][bj][m][n];
                    if (isq || isk) {
                        float ss = 0.f;
#pragma unroll
                        for (int bj = 0; bj < 2; ++bj)
#pragma unroll
                            for (int n = 0; n < 2; ++n) { const f32x4 x = v[bj][n]; ss += (x[0] * x[0] + x[1] * x[1]) + (x[2] * x[2] + x[3] * x[3]); }
                        ss += __shfl_xor(ss, 16); ss += __shfl_xor(ss, 32);
                        const float rstd = rsqrtf(ss * (1.0f / 64.0f) + RMS_EPS);
#pragma unroll
                        for (int bj = 0; bj < 2; ++bj)
#pragma unroll
                            for (int n = 0; n < 2; ++n) v[bj][n] = v[bj][n] * rstd * gv[bj][n];
                    }
                    if (sec == 4) {
#pragma unroll
                        for (int bj = 0; bj < 2; ++bj)
#pragma unroll
                            for (int n = 0; n < 2; ++n) cs[bj][n] += v[bj][n];
                    }
                    bf16_t* dst = base + ((size_t)(b * NHEAD + head) * SEQ + s) * HDIM + 8 * fq;
#pragma unroll
                    for (int bj = 0; bj < 2; ++bj) { u32x4 w; w.x = cvt_pk_bf16(v[bj][0][0], v[bj][0][1]); w.y = cvt_pk_bf16(v[bj][0][2], v[bj][0][3]); w.z = cvt_pk_bf16(v[bj][1][0], v[bj][1][1]); w.w = cvt_pk_bf16(v[bj][1][2], v[bj][1][3]);
                        *(u32x4*)(dst + 32 * bj) = w; }
                }
            if (sec == 4) {
                const int b = (u.pm * BM) >> 11, blk = u.pm & 7;
                float* km = kmean + ((size_t)(b * NHEAD + head) * 8 + blk) * HDIM + 8 * fq;
#pragma unroll
                for (int bj = 0; bj < 2; ++bj)
#pragma unroll
                    for (int n = 0; n < 2; ++n)
#pragma unroll
                        for (int e = 0; e < 4; ++e) { float x = cs[bj][n][e]; x += __shfl_xor(x, 1); x += __shfl_xor(x, 2); x += __shfl_xor(x, 4); x += __shfl_xor(x, 8);
                            if (fr == 0) atomicAdd(km + 32 * bj + 4 * n + e, x * (1.0f / 256.0f)); }
            }
        } else {
            const int gc0 = (pn - 12) * 256 + 64 * wc + 8 * fq;
#pragma unroll
            for (int ai = 0; ai < 2; ++ai)
#pragma unroll
                for (int m = 0; m < 4; ++m) {
                    const int row = u.pm * BM + ai * HALF + wr * 64 + m * 16 + fr;
                    bf16_t* dst = G + (size_t)row * 2048 + gc0;
#pragma unroll
                    for (int bj = 0; bj < 2; ++bj) { const f32x4 a = acc[ai][bj][m][0], c = acc[ai][bj][m][1]; u32x4 w;
                        w.x = cvt_pk_bf16(sigmoidf_(a[0]), sigmoidf_(a[1])); w.y = cvt_pk_bf16(sigmoidf_(a[2]), sigmoidf_(a[3])); w.z = cvt_pk_bf16(sigmoidf_(c[0]), sigmoidf_(c[1])); w.w = cvt_pk_bf16(sigmoidf_(c[2]), sigmoidf_(c[3]));
                        *(u32x4*)(dst + 32 * bj) = w; }
                }
        }
    }
};

template <int SECOND> struct EpiUp {
    static constexpr bool PERM = true, AFTER_DRAIN = false;
    const bf16_t* G; bf16_t* MIX;
    __device__ __forceinline__ void operator()(const f32x4 (&acc)[2][2][4][2], const Unit& u, int wr, int wc, int fr, int fq) const {
        const int col0 = u.pn * BM + wc * 32 + 8 * fq;
#pragma unroll
        for (int ai = 0; ai < 2; ++ai)
#pragma unroll
            for (int m = 0; m < 4; ++m) {
                const int row = u.pm * BM + ai * HALF + wr * 64 + m * 16 + fr;
#pragma unroll
                for (int bj = 0; bj < 2; ++bj) {
                    const int col = col0 + bj * HALF;
                    const u32x4 g = *(const u32x4*)(G + (size_t)row * 2048 + SECOND * 1024 + col);
                    const f32x4 a = acc[ai][bj][m][0], c = acc[ai][bj][m][1];
                    float v[8] = {a[0] * bf_lo(g.x), a[1] * bf_hi(g.x), a[2] * bf_lo(g.y), a[3] * bf_hi(g.y), c[0] * bf_lo(g.z), c[1] * bf_hi(g.z), c[2] * bf_lo(g.w), c[3] * bf_hi(g.w)};
                    bf16_t* p = MIX + (size_t)row * 1024 + col;
                    if (SECOND) { const u32x4 o = __builtin_nontemporal_load((const u32x4*)p);
                        v[0] += bf_lo(o.x); v[1] += bf_hi(o.x); v[2] += bf_lo(o.y); v[3] += bf_hi(o.y); v[4] += bf_lo(o.z); v[5] += bf_hi(o.z); v[6] += bf_lo(o.w); v[7] += bf_hi(o.w); }
                    u32x4 w; w.x = cvt_pk_bf16(v[0], v[1]); w.y = cvt_pk_bf16(v[2], v[3]); w.z = cvt_pk_bf16(v[4], v[5]); w.w = cvt_pk_bf16(v[6], v[7]);
                    *(u32x4*)p = w;
                }
            }
    }
};

struct EpiOut {
    static constexpr bool PERM = true, AFTER_DRAIN = false;
    const float* x; const float* mod; float* out; float* parts;
    __device__ __forceinline__ void operator()(const f32x4 (&acc)[2][2][4][2], const Unit& u, int wr, int wc, int fr, int fq) const {
        const int col0 = u.pn * BM + wc * 32 + 8 * fq;
        const int b = (u.pm * BM) >> 11;
        const float* g1 = mod + (size_t)b * 6144 + 2048;
        f32x4 gt[2][2];
#pragma unroll
        for (int bj = 0; bj < 2; ++bj)
#pragma unroll
            for (int n = 0; n < 2; ++n) gt[bj][n] = *(const f32x4*)(g1 + col0 + bj * HALF + 4 * n);
#pragma unroll
        for (int ai = 0; ai < 2; ++ai)
#pragma unroll
            for (int m = 0; m < 4; ++m) {
                const int row = u.pm * BM + ai * HALF + wr * 64 + m * 16 + fr; const size_t off = (size_t)row * 1024 + col0;
                float ss = 0.f;
#pragma unroll
                for (int bj = 0; bj < 2; ++bj)
#pragma unroll
                    for (int n = 0; n < 2; ++n) { const f32x4 xv = *(const f32x4*)(x + off + bj * HALF + 4 * n); const f32x4 o = xv + gt[bj][n] * acc[ai][bj][m][n];
                        ss += (o[0] * o[0] + o[1] * o[1]) + (o[2] * o[2] + o[3] * o[3]); *(f32x4*)(out + off + bj * HALF + 4 * n) = o; }
                ss += __shfl_xor(ss, 16); ss += __shfl_xor(ss, 32);
                if (fq == 0) parts[(size_t)row * 16 + u.pn * 4 + wc] = ss;
            }
    }
};

struct EpiSc {
    static constexpr bool PERM = true, AFTER_DRAIN = false;
    float* SC;
    __device__ __forceinline__ void operator()(const f32x4 (&acc)[2][2][4][2], const Unit& u, int wr, int wc, int fr, int fq) const {
        const int col0 = u.pn * BM + wc * 32 + 8 * fq;
#pragma unroll
        for (int ai = 0; ai < 2; ++ai)
#pragma unroll
            for (int m = 0; m < 4; ++m) {
                const int row = u.pm * BM + ai * HALF + wr * 64 + m * 16 + fr; const size_t off = (size_t)row * 2048 + col0;
#pragma unroll
                for (int bj = 0; bj < 2; ++bj)
#pragma unroll
                    for (int n = 0; n < 2; ++n) *(f32x4*)(SC + off + bj * HALF + 4 * n) = acc[ai][bj][m][n];
            }
    }
};

template <class Epi, class Sched, bool ALIGN_EPI = false, bool SP2 = false>
__device__ __forceinline__ void gemm_phase(PG8_LAS unsigned char* lds, const Gemm g, const Sched& S, const Epi& E) {
    const int tid = threadIdx.x, wid = __builtin_amdgcn_readfirstlane(tid >> 6), lane = tid & 63, wr = wid >> 2, wc = wid & 3, fr = lane & 15, fq = lane >> 4;
    const int K = g.K, nt = K / BK;
    unsigned voffA[2], voffB[2];
#pragma unroll
    for (int i = 0; i < 2; ++i) { int R, C; stage_rc(tid * 16 + i * 8192, R, C); const int Rb = Epi::PERM ? ((R & ~31) + perm32(R & 31)) : R;
        voffA[i] = (unsigned)(R * g.lda + C) * 2u; voffB[i] = (unsigned)(Rb * g.ldb + C) * 2u; }
    const size_t kstep = (size_t)(BK * 2);
    const size_t hstepA = (size_t)HALF * g.lda * 2, hstepB = (size_t)HALF * g.ldb * 2;
    const size_t tstepA = 2 * hstepA, tstepB = 2 * hstepB;
    const unsigned ldsw = (unsigned)wid * 1024u;
    const int aoff = lds_byte(wr * 64 + fr, fq * 8), boff = lds_byte(wc * 32 + fr, fq * 8);
#define PG8_SA(b, h) (((b) * 2 + (h)) * HTB)
#define PG8_SB(b, h) ((4 + (b) * 2 + (h)) * HTB)
#define PG8_STAGE(bufoff, gbase, voff) do { _Pragma("unroll") for (int _i = 0; _i < 2; ++_i) \
        __builtin_amdgcn_global_load_lds((const unsigned*)((const char*)(gbase) + (voff)[_i]), (PG8_LAS unsigned*)(lds + (bufoff) + ldsw + _i * 8192), 16, 0, 0); } while (0)
#define PG8_LDA(dst, b, h) do { _Pragma("unroll") for (int m = 0; m < 4; ++m) _Pragma("unroll") for (int k = 0; k < 2; ++k) dst[m][k] = *(const PG8_LAS bf16x8*)(lds + PG8_SA(b, h) + aoff + m * 2048 + k * 1024); } while (0)
#define PG8_LDB(dst, b, h) do { _Pragma("unroll") for (int n = 0; n < 2; ++n) _Pragma("unroll") for (int k = 0; k < 2; ++k) dst[n][k] = *(const PG8_LAS bf16x8*)(lds + PG8_SB(b, h) + boff + n * 2048 + k * 1024); } while (0)
#define PG8_MMA(ai, bj, At, Bt) do { __builtin_amdgcn_s_setprio(1); _Pragma("unroll") for (int m = 0; m < 4; ++m) _Pragma("unroll") for (int n = 0; n < 2; ++n) _Pragma("unroll") for (int k = 0; k < 2; ++k) \
        acc[ai][bj][m][n] = __builtin_amdgcn_mfma_f32_16x16x32_bf16(Bt[n][k], At[m][k], acc[ai][bj][m][n], 0, 0, 0); __builtin_amdgcn_s_setprio(0); } while (0)
#define PG8_WAIT_V(n) asm volatile("s_waitcnt vmcnt(" #n ")" ::: "memory")
#define PG8_WAIT_L(n) asm volatile("s_waitcnt lgkmcnt(" #n ")" ::: "memory")
#define PG8_BAR __builtin_amdgcn_s_barrier()
#define PG8_SCHED __builtin_amdgcn_sched_barrier(0)
    Unit cur, nxt; int ui = 0;
    if (!S.next(0, cur)) return;
    f32x4 acc[2][2][4][2];
#pragma unroll
    for (int a = 0; a < 2; ++a)
#pragma unroll
        for (int b = 0; b < 2; ++b)
#pragma unroll
            for (int m = 0; m < 4; ++m)
#pragma unroll
                for (int n = 0; n < 2; ++n) acc[a][b][m][n] = (f32x4){0.f, 0.f, 0.f, 0.f};
    bf16x8 At[4][2], B0[2][2], B1[2][2];
    const char* cA = (const char*)g.A + (size_t)cur.pm * tstepA; const char* cB = (const char*)g.Bt + (size_t)cur.pn * tstepB;
    S.a_ready(cur);
    if constexpr (SP2) {
        PG8_STAGE(PG8_SB(0, 0), cB, voffB); PG8_STAGE(PG8_SB(0, 1), cB + hstepB, voffB); PG8_STAGE(PG8_SA(0, 0), cA, voffA); PG8_STAGE(PG8_SA(0, 1), cA + hstepA, voffA);
        if (wr == 1) PG8_BAR;
        PG8_WAIT_V(2); PG8_BAR;
        PG8_STAGE(PG8_SB(1, 0), cB + kstep, voffB); PG8_STAGE(PG8_SA(1, 0), cA + kstep, voffA); PG8_STAGE(PG8_SB(1, 1), cB + hstepB + kstep, voffB);
        PG8_WAIT_V(6); PG8_BAR;
    } else {
        PG8_STAGE(PG8_SB(0, 0), cB, voffB); PG8_STAGE(PG8_SA(0, 0), cA, voffA); PG8_STAGE(PG8_SB(0, 1), cB + hstepB, voffB); PG8_STAGE(PG8_SA(0, 1), cA + hstepA, voffA);
        if (wr == 1) PG8_BAR;
        PG8_WAIT_V(4); PG8_BAR;
        PG8_STAGE(PG8_SB(1, 0), cB + kstep, voffB); PG8_STAGE(PG8_SA(1, 0), cA + kstep, voffA); PG8_STAGE(PG8_SB(1, 1), cB + hstepB + kstep, voffB);
        PG8_WAIT_V(6); PG8_BAR;
    }
    for (;;) {
        const bool has_next = S.next(ui + 1, nxt);
        const char* nA = has_next ? (const char*)g.A + (size_t)nxt.pm * tstepA : cA; const char* nB = has_next ? (const char*)g.Bt + (size_t)nxt.pn * tstepB : cB;
        for (int t = 0; t < nt; t += 2) {
            const bool last = (t == nt - 2);
            const char* a1 = cA + (size_t)(t + 1) * kstep;
            const char* a2 = last ? nA : cA + (size_t)(t + 2) * kstep; const char* b2 = last ? nB : cB + (size_t)(t + 2) * kstep;
            const char* a3 = a2 + kstep; const char* b3 = b2 + kstep;
            if (last && has_next) S.a_ready(nxt);
            if constexpr (SP2) {
            PG8_LDB(B0, 0, 0); PG8_LDB(B1, 0, 1); PG8_SCHED; PG8_LDA(At, 0, 0); PG8_STAGE(PG8_SA(1, 1), a1 + hstepA, voffA);
            PG8_WAIT_V(8); PG8_WAIT_L(0); PG8_BAR; PG8_MMA(0, 0, At, B0); PG8_MMA(0, 1, At, B1); PG8_BAR; PG8_SCHED;
            PG8_LDA(At, 0, 1); PG8_STAGE(PG8_SB(0, 0), b2, voffB); PG8_STAGE(PG8_SB(0, 1), b2 + hstepB, voffB); PG8_STAGE(PG8_SA(0, 0), a2, voffA);
            PG8_WAIT_V(8); PG8_WAIT_L(0); PG8_BAR; PG8_MMA(1, 0, At, B0); PG8_MMA(1, 1, At, B1); PG8_BAR; PG8_SCHED;
            PG8_LDB(B0, 1, 0); PG8_LDB(B1, 1, 1); PG8_SCHED; PG8_LDA(At, 1, 0); PG8_STAGE(PG8_SA(0, 1), a2 + hstepA, voffA);
            PG8_WAIT_V(8); PG8_WAIT_L(0); PG8_BAR; PG8_MMA(0, 0, At, B0); PG8_MMA(0, 1, At, B1); PG8_BAR; PG8_SCHED;
            PG8_LDA(At, 1, 1); PG8_STAGE(PG8_SB(1, 0), b3, voffB); PG8_STAGE(PG8_SB(1, 1), b3 + hstepB, voffB); PG8_STAGE(PG8_SA(1, 0), a3, voffA);
            PG8_WAIT_V(8); PG8_WAIT_L(0); PG8_BAR; PG8_MMA(1, 0, At, B0); PG8_MMA(1, 1, At, B1); PG8_BAR; PG8_SCHED;
            } else {
            PG8_LDB(B0, 0, 0); PG8_SCHED; PG8_LDA(At, 0, 0); PG8_STAGE(PG8_SA(1, 1), a1 + hstepA, voffA);
            PG8_WAIT_L(8); PG8_BAR; PG8_WAIT_L(0); PG8_MMA(0, 0, At, B0); PG8_BAR; PG8_SCHED;
            PG8_LDB(B1, 0, 1); PG8_STAGE(PG8_SB(0, 0), b2, voffB);
            PG8_BAR; PG8_WAIT_L(0); PG8_MMA(0, 1, At, B1); PG8_BAR;
            PG8_LDA(At, 0, 1); PG8_STAGE(PG8_SA(0, 0), a2, voffA);
            PG8_BAR; PG8_WAIT_L(0); PG8_MMA(1, 0, At, B0); PG8_BAR; PG8_SCHED;
            PG8_STAGE(PG8_SB(0, 1), b2 + hstepB, voffB);
            PG8_WAIT_V(6); PG8_BAR; PG8_MMA(1, 1, At, B1); PG8_BAR;
            PG8_LDB(B0, 1, 0); PG8_SCHED; PG8_LDA(At, 1, 0); PG8_STAGE(PG8_SA(0, 1), a2 + hstepA, voffA);
            PG8_WAIT_L(8); PG8_BAR; PG8_WAIT_L(0); PG8_MMA(0, 0, At, B0); PG8_BAR; PG8_SCHED;
            PG8_LDB(B1, 1, 1); PG8_STAGE(PG8_SB(1, 0), b3, voffB);
            PG8_BAR; PG8_WAIT_L(0); PG8_MMA(0, 1, At, B1); PG8_BAR;
            PG8_LDA(At, 1, 1); PG8_STAGE(PG8_SA(1, 0), a3, voffA);
            PG8_BAR; PG8_WAIT_L(0); PG8_MMA(1, 0, At, B0); PG8_BAR; PG8_SCHED;
            PG8_STAGE(PG8_SB(1, 1), b3 + hstepB, voffB);
            PG8_WAIT_V(6); PG8_BAR; PG8_MMA(1, 1, At, B1); PG8_BAR;
            }
        }
        if constexpr (ALIGN_EPI) { if (wr == 0) PG8_BAR; }
        if constexpr (!Epi::AFTER_DRAIN) { E(acc, cur, wr, wc, fr, fq); S.done(cur); }
        if (!has_next) break;
#pragma unroll
        for (int a = 0; a < 2; ++a)
#pragma unroll
            for (int b = 0; b < 2; ++b)
#pragma unroll
                for (int m = 0; m < 4; ++m)
#pragma unroll
                    for (int n = 0; n < 2; ++n) acc[a][b][m][n] = (f32x4){0.f, 0.f, 0.f, 0.f};
        cur = nxt; cA = nA; cB = nB; ++ui;
        if constexpr (ALIGN_EPI) { if (wr == 1) PG8_BAR; }
    }
    PG8_WAIT_V(0);
    if constexpr (!ALIGN_EPI) { if (wr == 0) PG8_BAR; }
    PG8_BAR;
    if constexpr (Epi::AFTER_DRAIN) { E.fused(acc, cur, wr, wc, fr, fq, lds, wid, lane); S.done(cur); }
#undef PG8_SA
#undef PG8_SB
#undef PG8_STAGE
#undef PG8_LDA
#undef PG8_LDB
#undef PG8_MMA
#undef PG8_WAIT_V
#undef PG8_WAIT_L
#undef PG8_BAR
#undef PG8_SCHED
}
}

namespace att {
#define ALAS __attribute__((address_space(3)))
typedef unsigned short bf16_t;
typedef short bf16x8 __attribute__((ext_vector_type(8)));
typedef short s16x4 __attribute__((ext_vector_type(4)));
typedef short v4i16_t __attribute__((ext_vector_type(4)));
typedef float f32x16 __attribute__((ext_vector_type(16)));
typedef float f32x4 __attribute__((ext_vector_type(4)));
typedef unsigned u32x4 __attribute__((ext_vector_type(4)));
constexpr int L_K = 0, L_V = 16384, L_KB = 32768, L_WSF = 40960, L_KM = 43008, L_STG = 45056, L_END = L_STG + 8 * 4096;
__device__ __forceinline__ s16x4 vtr(const ALAS char* p) { return __builtin_bit_cast(s16x4, __builtin_amdgcn_ds_read_tr16_b64_v4i16((ALAS v4i16_t*)p)); }
__device__ __forceinline__ unsigned cvtpk(float lo, float hi) { typedef float f2 __attribute__((ext_vector_type(2))); typedef __bf16 b2 __attribute__((ext_vector_type(2))); f2 v = {lo, hi}; b2 b = __builtin_convertvector(v, b2); return __builtin_bit_cast(unsigned, b); }
__device__ __forceinline__ float swap32f(float v) { return __shfl_xor(v, 32); }

template <int TYPE>
__device__ __forceinline__ void attn_unit(int b, int h, int qb, const bf16_t* Q, const bf16_t* K, const bf16_t* V, const float* Fcum, const float* kmean, bf16_t* Y, ALAS char* lds) {
    const int tid = threadIdx.x, lane = tid & 63, r32 = lane & 31, hi = lane >> 5; const int wid = __builtin_amdgcn_readfirstlane(tid >> 6);
    const size_t headbase = (size_t)(b * NHEAD + h) * SEQ * HDIM;
    const char* Kh = (const char*)(K + headbase); const char* Vh = (const char*)(V + headbase); const bf16_t* Qh = Q + headbase;
    const int q0 = qb * 256, NT = 4 * (qb + 1);
    ALAS float* kbias = (ALAS float*)(lds + L_KB);
    ALAS float* wsf = (ALAS float*)(lds + L_WSF) + wid * 64;
    ALAS float* km = (ALAS float*)(lds + L_KM);
    {
        const float slope = exp2f(-(float)(h + 1));
        for (int s = tid; s < q0 + 256; s += 512) kbias[s] = (TYPE == 0) ? (-Fcum[(size_t)(b * NHEAD + h) * SEQ + s] * LOG2E) : (slope * (float)s * LOG2E);
        if (TYPE == 1) km[tid] = kmean[(size_t)(b * NHEAD + h) * 512 + tid];
    }
    bf16x8 qr[4];
    { const bf16_t* qrow = Qh + (size_t)(q0 + wid * 32 + r32) * HDIM;
#pragma unroll
      for (int d0 = 0; d0 < 4; ++d0) qr[d0] = *(const bf16x8*)(qrow + d0 * 16 + hi * 8); }
    const int koff = lane * 128 + wid * 16;
    const int voff = (16 * (wid & 3) + (lane >> 2)) * 128 + (wid >> 2) * 64 + (lane & 3) * 16;
    const int ldst = wid * 1024 + lane * 16;
    u32x4 kreg = *(const u32x4*)(Kh + koff), vreg = *(const u32x4*)(Vh + voff);
    *(ALAS u32x4*)(lds + L_K + ldst) = kreg; *(ALAS u32x4*)(lds + L_V + ldst) = vreg;
    if (NT > 1) { kreg = *(const u32x4*)(Kh + 8192 + koff); vreg = *(const u32x4*)(Vh + 8192 + voff); }
    __syncthreads();
    unsigned sel = 0xffu;
    if (TYPE == 1) {
        float gate[7];
#pragma unroll
        for (int jb = 0; jb < 7; ++jb) {
            float g = 0.f;
#pragma unroll
            for (int d0 = 0; d0 < 4; ++d0) {
                const f32x4 k0 = *(const ALAS f32x4*)(km + jb * 64 + d0 * 16 + hi * 8), k1 = *(const ALAS f32x4*)(km + jb * 64 + d0 * 16 + hi * 8 + 4);
#pragma unroll
                for (int e = 0; e < 4; ++e) { g += __uint_as_float((unsigned)(unsigned short)qr[d0][e] << 16) * k0[e]; g += __uint_as_float((unsigned)(unsigned short)qr[d0][4 + e] << 16) * k1[e]; }
            }
            gate[jb] = g + swap32f(g);
        }
        if (qb <= 3) sel = (1u << qb) - 1u;
        else { sel = 0u;
#pragma unroll
            for (int it = 0; it < 3; ++it) { float best = -INFINITY; int bi = 0;
#pragma unroll
                for (int jb = 0; jb < 7; ++jb) { const bool ok = (jb < qb) && !((sel >> jb) & 1u) && (gate[jb] > best); best = ok ? gate[jb] : best; bi = ok ? jb : bi; }
                sel |= 1u << bi; } }
    }
    float m_run = -1e30f, l_run = 0.f; f32x16 o[2]; o[0] = f32x16{}; o[1] = f32x16{};
    const int qrel = wid * 32 + r32;
    for (int t = 0; t < NT; ++t) {
        const int buf = t & 1, jband = t - (NT - 4);
        bool active = true;
        if (jband >= 0) active = (64 * jband <= wid * 32 + 31);
        else if (TYPE == 1) active = __any((int)((sel >> (t >> 2)) & 1u)) != 0;
        if (active) {
            f32x16 p0 = f32x16{}, p1 = f32x16{};
            { const ALAS char* kb = lds + L_K + buf * 8192 + hi * 1024 + r32 * 16;
#pragma unroll
              for (int d0 = 0; d0 < 4; ++d0) { const bf16x8 b0 = *(const ALAS bf16x8*)(kb + d0 * 2048), b1 = *(const ALAS bf16x8*)(kb + d0 * 2048 + 512);
                  p0 = __builtin_amdgcn_mfma_f32_32x32x16_bf16(b0, qr[d0], p0, 0, 0, 0); p1 = __builtin_amdgcn_mfma_f32_32x32x16_bf16(b1, qr[d0], p1, 0, 0, 0); } }
            { const ALAS float* kbt = kbias + 64 * t + 4 * hi;
#pragma unroll
              for (int rq = 0; rq < 4; ++rq) { const f32x4 b0 = *(const ALAS f32x4*)(kbt + 8 * rq), b1 = *(const ALAS f32x4*)(kbt + 32 + 8 * rq);
#pragma unroll
                  for (int e = 0; e < 4; ++e) { p0[4 * rq + e] += b0[e]; p1[4 * rq + e] += b1[e]; } } }
            if (jband >= 0) { const int kb0 = 64 * jband + 4 * hi;
#pragma unroll
                for (int r = 0; r < 16; ++r) { const int kv = kb0 + (r & 3) + 8 * (r >> 2); if (kv > qrel) p0[r] = -INFINITY; if (kv + 32 > qrel) p1[r] = -INFINITY; } }
            else if (TYPE == 1) { if (!((sel >> (t >> 2)) & 1u)) {
#pragma unroll
                for (int r = 0; r < 16; ++r) { p0[r] = -INFINITY; p1[r] = -INFINITY; } } }
            float rm = fmaxf(p0[0], p1[0]);
#pragma unroll
            for (int r = 1; r < 16; ++r) rm = fmaxf(rm, fmaxf(p0[r], p1[r]));
            rm = fmaxf(rm, swap32f(rm));
            const float mn = fmaxf(m_run, rm), alpha = __builtin_amdgcn_exp2f(m_run - mn); m_run = mn;
            float rs = 0.f;
#pragma unroll
            for (int r = 0; r < 16; ++r) { p0[r] = __builtin_amdgcn_exp2f(p0[r] - mn); p1[r] = __builtin_amdgcn_exp2f(p1[r] - mn); rs += p0[r] + p1[r]; }
            l_run = l_run * alpha + rs;
            if (__any(alpha != 1.0f)) {
                if (hi == 0) wsf[r32] = alpha;
                asm volatile("s_waitcnt lgkmcnt(0)" ::: "memory");
#pragma unroll
                for (int rq = 0; rq < 4; ++rq) { const f32x4 a4 = *(const ALAS f32x4*)(wsf + 8 * rq + 4 * hi);
#pragma unroll
                    for (int e = 0; e < 4; ++e) { o[0][4 * rq + e] *= a4[e]; o[1][4 * rq + e] *= a4[e]; } }
                asm volatile("s_waitcnt lgkmcnt(0)" ::: "memory");
            }
            u32x4 pw[4];
            pw[0] = (u32x4){cvtpk(p0[0], p0[1]), cvtpk(p0[2], p0[3]), cvtpk(p0[4], p0[5]), cvtpk(p0[6], p0[7])};
            pw[1] = (u32x4){cvtpk(p0[8], p0[9]), cvtpk(p0[10], p0[11]), cvtpk(p0[12], p0[13]), cvtpk(p0[14], p0[15])};
            pw[2] = (u32x4){cvtpk(p1[0], p1[1]), cvtpk(p1[2], p1[3]), cvtpk(p1[4], p1[5]), cvtpk(p1[6], p1[7])};
            pw[3] = (u32x4){cvtpk(p1[8], p1[9]), cvtpk(p1[10], p1[11]), cvtpk(p1[12], p1[13]), cvtpk(p1[14], p1[15])};
            const ALAS char* vp = lds + L_V + buf * 8192 + ((lane >> 4) & 1) * 32 + (lane & 3) * 8 + (4 * hi + ((lane & 15) >> 2)) * 64;
#pragma unroll
            for (int d0 = 0; d0 < 2; ++d0)
#pragma unroll
                for (int ks = 0; ks < 4; ++ks) { const s16x4 lo = vtr(vp + d0 * 4096 + ks * 1024), hh = vtr(vp + d0 * 4096 + ks * 1024 + 512);
                    const bf16x8 vf = (bf16x8){lo[0], lo[1], lo[2], lo[3], hh[0], hh[1], hh[2], hh[3]};
                    o[d0] = __builtin_amdgcn_mfma_f32_32x32x16_bf16(__builtin_bit_cast(bf16x8, pw[ks]), vf, o[d0], 0, 0, 0); }
        }
        if (t + 1 < NT) {
            *(ALAS u32x4*)(lds + L_K + (buf ^ 1) * 8192 + ldst) = kreg; *(ALAS u32x4*)(lds + L_V + (buf ^ 1) * 8192 + ldst) = vreg;
            if (t + 2 < NT) { kreg = *(const u32x4*)(Kh + (size_t)(t + 2) * 8192 + koff); vreg = *(const u32x4*)(Vh + (size_t)(t + 2) * 8192 + voff); }
        }
        __syncthreads();
    }
    l_run += swap32f(l_run);
    if (hi == 0) wsf[32 + r32] = l_run;
    asm volatile("s_waitcnt lgkmcnt(0)" ::: "memory");
    ALAS bf16_t* stg = (ALAS bf16_t*)(lds + L_STG) + wid * 2048;
#pragma unroll
    for (int rq = 0; rq < 4; ++rq) { const f32x4 l4 = *(const ALAS f32x4*)(wsf + 32 + 8 * rq + 4 * hi);
#pragma unroll
        for (int e = 0; e < 4; ++e) { const float rl = 1.0f / l4[e]; const int orow = 8 * rq + 4 * hi + e;
#pragma unroll
            for (int d0 = 0; d0 < 2; ++d0) stg[orow * 64 + d0 * 32 + r32] = (bf16_t)(cvtpk(o[d0][4 * rq + e] * rl, 0.f) & 0xffffu); } }
    asm volatile("s_waitcnt lgkmcnt(0)" ::: "memory");
    bf16_t* Yw = Y + (size_t)(b * SEQ + q0 + wid * 32) * 1024 + TYPE * 512 + h * 64;
#pragma unroll
    for (int i = 0; i < 4; ++i) { const int row = i * 8 + (lane >> 3), ch = lane & 7; const u32x4 v = *(const ALAS u32x4*)(stg + row * 64 + ch * 8); *(u32x4*)(Yw + (size_t)row * 1024 + ch * 8) = v; }
    __syncthreads();
}
#undef ALAS
}

constexpr int NWAVES = 8;
constexpr size_t MiB = 1u << 20;
constexpr size_t WS_CTL = 0, CTL_ZERO_BYTES = 256 * 1024;
constexpr size_t WS_KMEAN = 64 * 1024;
constexpr size_t WS_MOD = 256 * 1024;
constexpr size_t WS_WFG = 448 * 1024;
constexpr size_t WS_GAINS = 480 * 1024;
constexpr size_t WS_LF = 512 * 1024;
constexpr size_t WS_FC = 1 * MiB;
constexpr size_t WS_PARTS = 2 * MiB;
constexpr size_t WS_WIN = 4 * MiB;
constexpr size_t WS_WFT = 14 * MiB, WS_WMT = 15 * MiB;
constexpr size_t WS_WOT = 16 * MiB;
constexpr size_t WS_WEFF = 18 * MiB;
constexpr size_t WS_HY = 24 * MiB;
constexpr size_t WS_QKV = 56 * MiB;
constexpr size_t WS_MIX = 152 * MiB;
constexpr size_t WS_U8 = 184 * MiB, WS_V8 = 200 * MiB;
constexpr size_t WS_SU = 216 * MiB, WS_SV = 216 * MiB + 65536;
constexpr size_t WS_PP = 56 * MiB;
constexpr size_t WS_WT = 220 * MiB;
constexpr size_t WS_EG = 248 * MiB;
constexpr size_t WS_SC = 56 * MiB;
constexpr size_t WS_END = 256 * MiB;
constexpr int CW_BAR = 4096;
constexpr int RING_BYTES = 131072, LDSCTL_OFF = RING_BYTES, MISC_OFF = LDSCTL_OFF + 320, LDS_BYTES = 147456;

#define GAS __attribute__((address_space(1)))
#define LAS __attribute__((address_space(3)))
typedef unsigned short bf16;
typedef unsigned v4u __attribute__((ext_vector_type(4)));
typedef unsigned v2u __attribute__((ext_vector_type(2)));
typedef float f32x4 __attribute__((ext_vector_type(4)));
typedef GAS unsigned gu32;
#define RLX_AGENT __ATOMIC_RELAXED, __HIP_MEMORY_SCOPE_AGENT
#define LDS_WAIT() asm volatile("s_waitcnt lgkmcnt(0)" ::: "memory")
#define VM_WAIT() asm volatile("s_waitcnt vmcnt(0)" ::: "memory")
__device__ __forceinline__ unsigned f2bf(float f) { unsigned u = __builtin_bit_cast(unsigned, f); return (u + 0x7fffu + ((u >> 16) & 1u)) >> 16; }
__device__ __forceinline__ unsigned pk2(float lo, float hi) { return f2bf(lo) | (f2bf(hi) << 16); }
__device__ __forceinline__ float wave_sum(float v) {
#pragma unroll
    for (int o = 1; o < 64; o <<= 1) v += __shfl_xor(v, o);
    return v;
}
#define XB_TMO      128
#define XB_XCNT(j)  (256  + 64 * (j))
#define XB_XSUB(j)  (1280 + 64 * (j))
#define XB_XGEN(j)  (2304 + 64 * (j))
#define XB_TOP      3328
#define XB_TOPGEN   3392
#define XCD_BAR_WORDS 3456
#define XB_SPIN_CAP (1u << 18)

__device__ __forceinline__ unsigned xb_ld(unsigned* p)              { return __hip_atomic_load(p, __ATOMIC_RELAXED, __HIP_MEMORY_SCOPE_AGENT); }
__device__ __forceinline__ unsigned xb_add(unsigned* p, unsigned v) { return __hip_atomic_fetch_add(p, v, __ATOMIC_RELAXED, __HIP_MEMORY_SCOPE_AGENT); }
__device__ __forceinline__ unsigned xb_xcc_id() { return (unsigned)__builtin_amdgcn_s_getreg((3 << 11) | 20) & 0xFu; }
#define XB_SPIN(cond, bar) do { unsigned _sp = 0; while (cond) { __builtin_amdgcn_s_sleep(1); \
    if ((++_sp & 255u) == 0u) { if (xb_ld(&(bar)[XB_TMO])) break; if (_sp > XB_SPIN_CAP) { atomicAdd(&(bar)[XB_TMO], 1u); break; } } } } while (0)

struct XcdBarrier {
    unsigned* bar; unsigned x;
    volatile LAS unsigned* st;
};

__device__ __forceinline__ XcdBarrier xcd_barrier_post(unsigned* bar, volatile LAS unsigned* st) {
    XcdBarrier b; b.bar = bar; b.x = xb_xcc_id(); b.st = st;
    if (threadIdx.x == 0) (void)xb_add(&bar[XB_XCNT(b.x)], 1u);
    return b;
}
__device__ __forceinline__ void xcd_barrier_complete(unsigned* bar, unsigned x, unsigned& nloc, unsigned& nx) {
    const unsigned G = gridDim.x * gridDim.y * gridDim.z;
    unsigned sum, cnt, mine, sp = 0u;
    for (;;) {
        sum = 0u; cnt = 0u; mine = 0u;
#pragma unroll
        for (unsigned j = 0; j < 16; ++j) { const unsigned c = xb_ld(&bar[XB_XCNT(j)]); sum += c; cnt += (c > 0u) ? 1u : 0u; mine = (j == x) ? c : mine; }
        if (sum == G) break;
        __builtin_amdgcn_s_sleep(1);
        if ((++sp & 255u) == 0u) { if (xb_ld(&bar[XB_TMO])) break; if (sp > XB_SPIN_CAP) { atomicAdd(&bar[XB_TMO], 1u); break; } }
    }
    nloc = mine > 0u ? mine : 1u; nx = cnt > 0u ? cnt : 1u;
}

__device__ __forceinline__ void xcd_barrier(const XcdBarrier& b) {
    asm volatile("s_waitcnt vmcnt(0)" ::: "memory");
    __syncthreads();
    if (threadIdx.x == 0) {
        unsigned* bar = b.bar;
        __builtin_amdgcn_s_waitcnt(0);
        unsigned nloc = b.st[0], nx = b.st[1];
        if (nloc == 0u) { xcd_barrier_complete(bar, b.x, nloc, nx); b.st[0] = nloc; b.st[1] = nx; }
        const unsigned old = xb_add(&bar[XB_XSUB(b.x)], 1u);
        const unsigned gen = old / nloc;
        if (old + 1u == (gen + 1u) * nloc) {
            __builtin_amdgcn_fence(__ATOMIC_RELEASE, "agent");
            asm volatile("s_waitcnt vmcnt(0)" ::: "memory");
            const unsigned og = xb_add(&bar[XB_TOP], 1u);
            const unsigned tg = og / nx;
            if (og + 1u == (tg + 1u) * nx) xb_add(&bar[XB_TOPGEN], 1u);
            else XB_SPIN(xb_ld(&bar[XB_TOPGEN]) == tg, bar);
            __builtin_amdgcn_fence(__ATOMIC_ACQUIRE, "agent");
            xb_add(&bar[XB_XGEN(b.x)], 1u);
            asm volatile("s_waitcnt vmcnt(0)" ::: "memory");
        } else {
            XB_SPIN(xb_ld(&bar[XB_XGEN(b.x)]) == gen, bar);
            __builtin_amdgcn_fence(__ATOMIC_ACQUIRE, "agent");
            asm volatile("s_waitcnt vmcnt(0)" ::: "memory");
        }
    }
    __syncthreads();
}

struct Frame {
    LAS unsigned char* lds; int tid, lane, wave, G, bid;
    const float *x, *c, *w_ada, *b_ada, *norm1_g, *w_in, *b_fgate, *fox_q_g, *fox_k_g, *moba_q_g, *moba_k_g, *w_up_fox, *w_up_moba, *w_out, *norm2_g, *w_peer_q, *sub_keys, *peer_u, *peer_v;
    float* out; unsigned char* ws;
};

__device__ __forceinline__ void tr_item(const float* W, int ldw, int col0, int k0, bf16* WT, int ldt, int row0, LAS float* scr, int lane) {
#pragma unroll 8
    for (int i = 0; i < 32; ++i) { const int kk = 2 * i + (lane >> 5); scr[kk * 33 + (lane & 31)] = W[(size_t)(k0 + kk) * ldw + col0 + (lane & 31)]; }
    LDS_WAIT(); asm volatile("" ::: "memory");
    const int c = lane & 7;
#pragma unroll
    for (int j = 0; j < 4; ++j) { const int n = (lane >> 3) + 8 * j; const LAS float* s = scr + (8 * c) * 33 + n;
        v4u o; o.x = pk2(s[0 * 33], s[1 * 33]); o.y = pk2(s[2 * 33], s[3 * 33]); o.z = pk2(s[4 * 33], s[5 * 33]); o.w = pk2(s[6 * 33], s[7 * 33]);
        *(GAS v4u*)(WT + (size_t)(row0 + n) * ldt + k0 + 8 * c) = o; }
    LDS_WAIT(); asm volatile("" ::: "memory");
}

__device__ __forceinline__ void p0_prep(Frame& F) {
    const int tid = F.tid, lane = F.lane, wave = F.wave, G = F.G;
    float* mod = (float*)(F.ws + WS_MOD);
    {
        LAS float* Kt = (LAS float*)F.lds; LAS float* Wt = Kt + 128 * 128;
        bf16* WeffT = (bf16*)(F.ws + WS_WEFF);
        for (int it = F.bid; it < 256; it += G) {
            const int hp = it >> 4, d0 = (it & 15) * 64;
            const float* keys = F.sub_keys + (size_t)hp * 128 * 128;
#pragma unroll
            for (int i = 0; i < 8; ++i) { const int idx = (i * 512 + tid) * 4, n = idx >> 7, cc = idx & 127; const f32x4 v = *(const f32x4*)(keys + idx);
                Kt[(cc + 0) * 128 + n] = v[0]; Kt[(cc + 1) * 128 + n] = v[1]; Kt[(cc + 2) * 128 + n] = v[2]; Kt[(cc + 3) * 128 + n] = v[3]; }
#pragma unroll
            for (int i = 0; i < 4; ++i) { const int idx = (i * 512 + tid) * 4, dd = idx >> 7, cc = idx & 127; const f32x4 v = *(const f32x4*)(F.w_peer_q + (size_t)(d0 + dd) * 2048 + hp * 128 + cc);
                Wt[(cc + 0) * 64 + dd] = v[0]; Wt[(cc + 1) * 64 + dd] = v[1]; Wt[(cc + 2) * 64 + dd] = v[2]; Wt[(cc + 3) * 64 + dd] = v[3]; }
            __syncthreads();
            const int tn = tid & 31, td = tid >> 5;
            float acc[4][4];
#pragma unroll
            for (int i = 0; i < 4; ++i)
#pragma unroll
                for (int j = 0; j < 4; ++j) acc[i][j] = 0.f;
            for (int cc = 0; cc < 128; ++cc) { const f32x4 kv = *(const LAS f32x4*)(Kt + cc * 128 + 4 * tn), wv = *(const LAS f32x4*)(Wt + cc * 64 + 4 * td);
#pragma unroll
                for (int i = 0; i < 4; ++i)
#pragma unroll
                    for (int j = 0; j < 4; ++j) acc[i][j] += kv[i] * wv[j]; }
#pragma unroll
            for (int i = 0; i < 4; ++i) { v2u o; o.x = pk2(acc[i][0], acc[i][1]); o.y = pk2(acc[i][2], acc[i][3]); *(GAS v2u*)(WeffT + (size_t)(hp * 128 + 4 * tn + i) * 1024 + d0 + 4 * td) = o; }
            __syncthreads();
        }
    }
    {
        LAS float* sc = (LAS float*)F.lds; LAS float* red = sc + 8192;
        for (int it = F.bid; it < 96; it += G) {
            for (int i = tid; i < 8192; i += 512) { const int bb = i >> 10, k = i & 1023; const float v = F.c[i]; sc[k * 8 + bb] = v / (1.0f + expf(-v)); }
            __syncthreads();
            const int n = it * 64 + lane; float a[8];
#pragma unroll
            for (int bb = 0; bb < 8; ++bb) a[bb] = 0.f;
#pragma unroll 4
            for (int k = wave * 128; k < wave * 128 + 128; ++k) { const float w = F.w_ada[(size_t)k * 6144 + n]; const f32x4 s0 = *(const LAS f32x4*)(sc + k * 8), s1 = *(const LAS f32x4*)(sc + k * 8 + 4);
                a[0] += w * s0[0]; a[1] += w * s0[1]; a[2] += w * s0[2]; a[3] += w * s0[3]; a[4] += w * s1[0]; a[5] += w * s1[1]; a[6] += w * s1[2]; a[7] += w * s1[3]; }
#pragma unroll
            for (int bb = 0; bb < 8; ++bb) red[(wave * 8 + bb) * 64 + lane] = a[bb];
            __syncthreads();
            { const int bb = tid >> 6; float s = 0.f;
#pragma unroll
              for (int w = 0; w < 8; ++w) s += red[(w * 8 + bb) * 64 + lane];
              mod[bb * 6144 + it * 64 + lane] = s + F.b_ada[it * 64 + lane]; }
            __syncthreads();
        }
    }
    {
        LAS float* scr = (LAS float*)(F.lds + wave * 16384);
        const int gw = F.bid * NWAVES + wave, NGW = G * NWAVES;
        constexpr int I_IN = 16 * 160, I_UP = 8 * 32, I_OUT = 16 * 32;
        for (int it = gw; it < I_IN + 2 * I_UP + I_OUT; it += NGW) {
            int r = it;
            if (r < I_IN) { const int kb = r / 160, rb = r % 160, tile = rb >> 3, bj = (rb >> 2) & 1, wc = rb & 3; const int Lg = tile * 256 + 64 * wc + 32 * bj; const int src = Lg < 1536 ? Lg : Lg + 8;
                tr_item(F.w_in, IN_COLS, src, kb * 64, (bf16*)(F.ws + WS_WIN), 1024, rb * 32, scr, lane); continue; }
            r -= I_IN;
            if (r < I_UP) { tr_item(F.w_up_fox, 1024, (r & 31) * 32, (r >> 5) * 64, (bf16*)(F.ws + WS_WFT), 512, (r & 31) * 32, scr, lane); continue; }
            r -= I_UP;
            if (r < I_UP) { tr_item(F.w_up_moba, 1024, (r & 31) * 32, (r >> 5) * 64, (bf16*)(F.ws + WS_WMT), 512, (r & 31) * 32, scr, lane); continue; }
            r -= I_UP;
            tr_item(F.w_out, 1024, (r & 31) * 32, (r >> 5) * 64, (bf16*)(F.ws + WS_WOT), 1024, (r & 31) * 32, scr, lane);
        }
    }
    {
        const size_t gt = (size_t)F.bid * 512 + tid, NT_ = (size_t)G * 512;
        float* wfg = (float*)(F.ws + WS_WFG);
        for (size_t i = gt; i < 8192; i += NT_) { const int j = (int)(i >> 10), k = (int)(i & 1023); wfg[i] = F.w_in[(size_t)k * IN_COLS + 1536 + j]; }
        if (gt < 64) { float* gn = (float*)(F.ws + WS_GAINS); gn[gt] = F.fox_q_g[gt]; gn[64 + gt] = F.fox_k_g[gt]; gn[128 + gt] = F.moba_q_g[gt]; gn[192 + gt] = F.moba_k_g[gt]; }
    }
    {
        const int gw = F.bid * NWAVES + wave, NGW = G * NWAVES;
        for (int r = gw; r < 2 * NEXP; r += NGW) {
            const bool isu = r < NEXP; const int rr = isu ? r : r - NEXP;
            const GAS f32x4* src = (const GAS f32x4*)((isu ? F.peer_u : F.peer_v) + (size_t)rr * 1024) + lane;
            f32x4 v[4]; float mx = 0.f;
#pragma unroll
            for (int j = 0; j < 4; ++j) { v[j] = src[64 * j]; mx = fmaxf(mx, fmaxf(fmaxf(fabsf(v[j][0]), fabsf(v[j][1])), fmaxf(fabsf(v[j][2]), fabsf(v[j][3])))); }
#pragma unroll
            for (int o = 1; o < 64; o <<= 1) mx = fmaxf(mx, __shfl_xor(mx, o));
            const float sc = mx > 0.f ? mx * (1.0f / 384.0f) : 1.0f, inv = 1.0f / sc;
            GAS unsigned char* dstb = (GAS unsigned char*)(F.ws + (isu ? WS_U8 : WS_V8)) + (size_t)rr * 128 + 4 * (lane & 31);
#pragma unroll
            for (int j = 0; j < 4; ++j) { int w = 0; w = __builtin_amdgcn_cvt_pk_fp8_f32(v[j][0] * inv, v[j][1] * inv, w, false); w = __builtin_amdgcn_cvt_pk_fp8_f32(v[j][2] * inv, v[j][3] * inv, w, true); *(GAS unsigned*)(dstb + (size_t)(2 * j + (lane >> 5)) * ((size_t)NEXP * 128)) = (unsigned)w; }
            if (lane == 0) ((float*)(F.ws + (isu ? WS_SU : WS_SV)))[rr] = sc;
        }
    }
}

template <int SECOND>
__device__ __forceinline__ void rows_phase(Frame& F) {
    const int tid = F.tid, lane = F.lane, wave = F.wave;
    LAS float* Ac = (LAS float*)F.lds; LAS float* Bc = Ac + 1024; LAS float* wfs = Bc + 1024;
    const float* mod = (const float*)(F.ws + WS_MOD);
    const float* src = SECOND ? F.out : F.x;
    const float* gain = SECOND ? F.norm2_g : F.norm1_g;
    bf16* dst = (bf16*)(F.ws + WS_HY);
    if (!SECOND) { const float* wfg = (const float*)(F.ws + WS_WFG); for (int i = tid; i < 8192; i += 512) wfs[i] = wfg[i]; }
    for (int it = F.bid; it < 256; it += F.G) {
        const int b = it >> 5;
        const float* shift = mod + (size_t)b * 6144 + (SECOND ? 3072 : 0); const float* scale = shift + 1024;
        __syncthreads();
        for (int i = tid; i < 1024; i += 512) { Ac[i] = gain[i] * (1.0f + scale[i]); Bc[i] = shift[i]; }
        __syncthreads();
        for (int i = 0; i < 8; ++i) {
            const int row = it * 64 + wave * 8 + i;
            const GAS f32x4* xr = (const GAS f32x4*)(src + (size_t)row * 1024) + lane;
            f32x4 v[4]; float ss = 0.f;
#pragma unroll
            for (int j = 0; j < 4; ++j) { v[j] = xr[64 * j]; ss += (v[j][0] * v[j][0] + v[j][1] * v[j][1]) + (v[j][2] * v[j][2] + v[j][3] * v[j][3]); }
            float rstd;
            if (SECOND) { const float* pp = (const float*)(F.ws + WS_PARTS) + (size_t)row * 16; float s = 0.f;
#pragma unroll
                for (int q = 0; q < 16; ++q) s += pp[q];
                rstd = rsqrtf(s * (1.0f / 1024.0f) + RMS_EPS); }
            else rstd = rsqrtf(wave_sum(ss) * (1.0f / 1024.0f) + RMS_EPS);
            float p[8];
#pragma unroll
            for (int q = 0; q < 8; ++q) p[q] = 0.f;
            GAS v2u* o8 = (GAS v2u*)(dst + (size_t)row * 1024) + lane;
#pragma unroll
            for (int j = 0; j < 4; ++j) {
                const int col = 4 * (64 * j + lane);
                const f32x4 a = *(const LAS f32x4*)(Ac + col), bb = *(const LAS f32x4*)(Bc + col);
                const f32x4 hv = v[j] * rstd * a + bb;
                v2u o; o.x = pk2(hv[0], hv[1]); o.y = pk2(hv[2], hv[3]); o8[64 * j] = o;
                if (!SECOND) {
#pragma unroll
                    for (int q = 0; q < 8; ++q) { const f32x4 w = *(const LAS f32x4*)(wfs + q * 1024 + col); p[q] += (hv[0] * w[0] + hv[1] * w[1]) + (hv[2] * w[2] + hv[3] * w[3]); }
                }
            }
            if (!SECOND) {
                float mine = 0.f;
#pragma unroll
                for (int q = 0; q < 8; ++q) { const float s = wave_sum(p[q]); mine = (lane == q) ? s : mine; }
                if (lane < 8) { const float z = mine + F.b_fgate[lane]; const float ls = fminf(z, 0.f) - log1pf(expf(-fabsf(z))); ((float*)(F.ws + WS_LF))[(size_t)row * 8 + lane] = ls; }
            }
        }
    }
    __syncthreads();
}

__device__ __forceinline__ void fcum_items(Frame& F) {
    LAS float* wtot = (LAS float*)F.lds;
    const float* LFp = (const float*)(F.ws + WS_LF); float* Fc = (float*)(F.ws + WS_FC);
    for (int it = F.bid; it < 64; it += F.G) {
        const int b = it >> 3, h = it & 7, s0 = 4 * F.tid;
        float v[4];
#pragma unroll
        for (int i = 0; i < 4; ++i) v[i] = LFp[((size_t)b * SEQ + s0 + i) * 8 + h];
        v[1] += v[0]; v[2] += v[1]; v[3] += v[2];
        float inc = v[3];
#pragma unroll
        for (int o = 1; o < 64; o <<= 1) { const float t = __shfl_up(inc, o); if (F.lane >= o) inc += t; }
        __syncthreads();
        if (F.lane == 63) wtot[F.wave] = inc;
        __syncthreads();
        float base = inc - v[3];
        for (int w = 0; w < F.wave; ++w) base += wtot[w];
        float* o = Fc + (size_t)(b * NHEAD + h) * SEQ + s0;
#pragma unroll
        for (int i = 0; i < 4; ++i) o[i] = base + v[i];
    }
    __syncthreads();
}

__device__ __forceinline__ unsigned okey(float f) { const unsigned u = __float_as_uint(f); return (u & 0x80000000u) ? ~u : (u | 0x80000000u); }
__device__ __forceinline__ float okey_inv(unsigned k) { return __uint_as_float((k & 0x80000000u) ? (k ^ 0x80000000u) : ~k); }
__device__ __forceinline__ void chain16(unsigned (&L)[16], unsigned x) {
#pragma unroll
    for (int k = 0; k < 16; ++k) { const unsigned hi = L[k] > x ? L[k] : x; x = L[k] > x ? x : L[k]; L[k] = hi; }
}
__device__ __forceinline__ void top16_of_128(const float* p, unsigned (&L)[16]) {
#pragma unroll
    for (int k = 0; k < 16; ++k) L[k] = 0u;
    for (int c = 0; c < 4; ++c) {
        f32x4 v[8];
#pragma unroll
        for (int j = 0; j < 8; ++j) v[j] = *(const f32x4*)(p + c * 32 + j * 4);
#pragma unroll
        for (int j = 0; j < 8; ++j)
#pragma unroll
            for (int e = 0; e < 4; ++e) chain16(L, (okey(v[j][e]) & ~127u) | (unsigned)(127 - (c * 32 + j * 4 + e)));
    }
}
__device__ __forceinline__ void topk_phase(Frame& F) {
    const float* SC = (const float*)(F.ws + WS_SC); unsigned* EG = (unsigned*)(F.ws + WS_EG);
    LAS unsigned char* tab = F.lds + F.tid * 32;
    for (int th = F.bid * 512 + F.tid; th < NTOK * 8; th += F.G * 512) {
        const float* p = SC + (size_t)th * 256;
        unsigned L1[16], L2[16];
        top16_of_128(p, L1); top16_of_128(p + 128, L2);
        float v1[16], v2[16];
#pragma unroll
        for (int k = 0; k < 16; ++k) { v1[k] = okey_inv(L1[k] & ~127u); tab[k] = (unsigned char)(127u - (L1[k] & 127u)); v2[k] = okey_inv(L2[k] & ~127u); tab[16 + k] = (unsigned char)(127u - (L2[k] & 127u)); }
        unsigned C[16];
#pragma unroll
        for (int j = 0; j < 16; ++j) C[j] = (okey(v1[0] + v2[j]) & ~255u) | (unsigned)(255 - j);
#pragma unroll
        for (int i = 1; i < 16; ++i)
#pragma unroll
            for (int j = 0; j < 16 / (i + 1); ++j) chain16(C, (okey(v1[i] + v2[j]) & ~255u) | (unsigned)(255 - (i * 16 + j)));
        float sv[16]; float sum = 0.f; const float mx = okey_inv(C[0] & ~255u);
#pragma unroll
        for (int k = 0; k < 16; ++k) { sv[k] = expf(okey_inv(C[k] & ~255u) - mx); sum += sv[k]; }
        const float rs = 1.0f / sum;
        unsigned o[16];
#pragma unroll
        for (int k = 0; k < 16; ++k) { const int pos = 255 - (int)(C[k] & 255u); const unsigned eid = (unsigned)tab[pos >> 4] * 128u + (unsigned)tab[16 + (pos & 15)];
            const _Float16 hg = (_Float16)(sv[k] * rs); o[k] = ((unsigned)__builtin_bit_cast(unsigned short, hg) << 16) | eid; }
        GAS v4u* dst = (GAS v4u*)(EG + (size_t)th * 16);
#pragma unroll
        for (int q = 0; q < 4; ++q) dst[q] = (v4u){o[4 * q], o[4 * q + 1], o[4 * q + 2], o[4 * q + 3]};
    }
}

typedef float f32x2v __attribute__((ext_vector_type(2)));
__device__ __forceinline__ float gelu_tanh(float a) { const float y = 0.7978845608028654f * (a + 0.044715f * a * a * a); const float th = 1.0f - 2.0f / (__expf(2.0f * y) + 1.0f); return 0.5f * a * (1.0f + th); }
__device__ __forceinline__ void fp8x16_to_f32(const v4u r, float (&f)[16]) {
#pragma unroll
    for (int q = 0; q < 4; ++q) { const f32x2v lo = __builtin_amdgcn_cvt_pk_f32_fp8((int)r[q], false), hi = __builtin_amdgcn_cvt_pk_f32_fp8((int)r[q], true); f[4 * q] = lo[0]; f[4 * q + 1] = lo[1]; f[4 * q + 2] = hi[0]; f[4 * q + 3] = hi[1]; }
}
template <bool VSIDE>
__device__ __forceinline__ void peer_gather(Frame& F, bool dry) {
    const int lane = F.lane, wave = F.wave, g = lane >> 3, ch = lane & 7;
    const bool sliced = (F.G % 8) == 0;
    const int x_lo = sliced ? (F.bid & 7) : 0, x_hi = sliced ? x_lo + 1 : 8;
    const int wv = sliced ? (F.bid >> 3) * NWAVES + wave : F.bid * NWAVES + wave, NW = sliced ? (F.G >> 3) * NWAVES : F.G * NWAVES;
    const unsigned* EG = (const unsigned*)(F.ws + WS_EG); const bf16* H2 = (const bf16*)(F.ws + WS_HY); const float* Wt = (const float*)(F.ws + WS_WT);
    const unsigned char* TB = F.ws + (VSIDE ? WS_V8 : WS_U8); float* Pp = (float*)(F.ws + WS_PP); const float* mod = (const float*)(F.ws + WS_MOD);
    const bool c0 = VSIDE ? (lane & 8) != 0 : (lane & 1) != 0, c1 = VSIDE ? (lane & 16) != 0 : (lane & 2) != 0, c2 = VSIDE ? (lane & 32) != 0 : (lane & 4) != 0;
    constexpr int X0 = VSIDE ? 8 : 1, X1 = VSIDE ? 16 : 2, X2 = VSIDE ? 32 : 4;
    for (int x = x_lo; x < x_hi; ++x) {
        const unsigned char* tb = TB + (size_t)x * ((size_t)NEXP * 128) + 16 * ch;
#define PG_TOK(tt) ((tt) < NTOK ? (tt) : NTOK - 1)
#define PG_LOAD_EG(tt) do { const unsigned* ep_ = EG + (size_t)PG_TOK(tt) * 128 + 16 * g; _Pragma("unroll") for (int q_ = 0; q_ < 4; ++q_) eg[q_] = *(const GAS v4u*)(ep_ + 4 * q_); } while (0)
#define PG_LOAD_AUX(tt, AUX) do { if (VSIDE) { const float* wp_ = Wt + (size_t)PG_TOK(tt) * 128 + 16 * g; _Pragma("unroll") for (int q_ = 0; q_ < 4; ++q_) AUX[q_] = *(const GAS v4u*)(wp_ + 4 * q_); } \
        else { const bf16* hp_ = H2 + (size_t)PG_TOK(tt) * 1024 + 128 * x + 16 * ch; AUX[0] = *(const GAS v4u*)hp_; AUX[1] = *(const GAS v4u*)(hp_ + 8); } } while (0)
#define PG_ROWS8(R, EGV, H) do { _Pragma("unroll") for (int i_ = 0; i_ < 8; ++i_) { const unsigned e_ = EGV[2 * (H) + (i_ >> 2)][i_ & 3] & 0xffffu; R[i_] = *(const GAS v4u*)(tb + (size_t)e_ * 128); } } while (0)
        v4u eg[4], egC[4], auxC[4], auxN[4], rLo[8], rHi[8];
        float v16[16], hf[16];
        auto half = [&](const v4u (&R)[8], const int H) {
#pragma unroll
            for (int i = 0; i < 8; ++i) { float f[16]; fp8x16_to_f32(R[i], f);
                if (VSIDE) { const float w = __uint_as_float(auxC[2 * H + (i >> 2)][i & 3]);
#pragma unroll
                    for (int c = 0; c < 16; ++c) v16[c] += w * f[c];
                    asm volatile("" : "+v"(v16[0]), "+v"(v16[1]), "+v"(v16[2]), "+v"(v16[3]), "+v"(v16[4]), "+v"(v16[5]), "+v"(v16[6]), "+v"(v16[7]),
                                      "+v"(v16[8]), "+v"(v16[9]), "+v"(v16[10]), "+v"(v16[11]), "+v"(v16[12]), "+v"(v16[13]), "+v"(v16[14]), "+v"(v16[15])); }
                else { float a0 = 0.f, a1 = 0.f;
#pragma unroll
                    for (int c = 0; c < 16; c += 2) { a0 += f[c] * hf[c]; a1 += f[c + 1] * hf[c + 1]; }
                    v16[8 * H + i] = a0 + a1; asm volatile("" : "+v"(v16[8 * H + i])); }
                __builtin_amdgcn_sched_barrier(0); }
        };
        auto finish = [&](int tt) {
            float r8[8], r4[4], r2[2];
#pragma unroll
            for (int c = 0; c < 8; ++c) { const float keep = c0 ? v16[8 + c] : v16[c], send = c0 ? v16[c] : v16[8 + c]; r8[c] = keep + __shfl_xor(send, X0); }
#pragma unroll
            for (int c = 0; c < 4; ++c) { const float keep = c1 ? r8[4 + c] : r8[c], send = c1 ? r8[c] : r8[4 + c]; r4[c] = keep + __shfl_xor(send, X1); }
#pragma unroll
            for (int c = 0; c < 2; ++c) { const float keep = c2 ? r4[2 + c] : r4[c], send = c2 ? r4[c] : r4[2 + c]; r2[c] = keep + __shfl_xor(send, X2); }
            const int sub = (c0 ? 8 : 0) + (c1 ? 4 : 0) + (c2 ? 2 : 0);
            if (tt < NTOK) {
                if (VSIDE) {
                    const int col = 128 * x + 16 * ch + sub; const int b = tt >> 11; const float* g2 = mod + (size_t)b * 6144 + 5120;
                    float* orow = F.out + (size_t)tt * 1024;
                    const f32x2v xv = *(const GAS f32x2v*)(orow + col), gvv = *(const GAS f32x2v*)(g2 + col);
                    f32x2v o; o[0] = xv[0] + gvv[0] * r2[0]; o[1] = xv[1] + gvv[1] * r2[1];
                    *(GAS f32x2v*)((dry ? (float*)(F.ws + WS_SC) + (size_t)tt * 1024 : orow) + col) = o;
                } else {
                    *(GAS f32x2v*)(Pp + ((size_t)x * NTOK + tt) * 128 + 16 * g + sub) = (f32x2v){r2[0], r2[1]};
                }
            }
        };
        int t = wv;
        PG_LOAD_EG(t); PG_LOAD_AUX(t, auxC);
#pragma unroll
        for (int q = 0; q < 4; ++q) egC[q] = eg[q];
        PG_ROWS8(rLo, egC, 0);
        PG_LOAD_EG(t + NW); PG_LOAD_AUX(t + NW, auxN);
        for (; t < NTOK; t += NW) {
            PG_ROWS8(rHi, egC, 1);
            if (VSIDE) {
#pragma unroll
                for (int c = 0; c < 16; ++c) v16[c] = 0.f;
            } else {
#pragma unroll
                for (int q = 0; q < 4; ++q) { hf[2 * q] = pg8::bf_lo(auxC[0][q]); hf[2 * q + 1] = pg8::bf_hi(auxC[0][q]); hf[8 + 2 * q] = pg8::bf_lo(auxC[1][q]); hf[8 + 2 * q + 1] = pg8::bf_hi(auxC[1][q]); }
            }
            half(rLo, 0);
            PG_ROWS8(rLo, eg, 0);
            half(rHi, 1);
            finish(t);
#pragma unroll
            for (int q = 0; q < 4; ++q) { egC[q] = eg[q]; auxC[q] = auxN[q]; }
            PG_LOAD_EG(t + 2 * NW); PG_LOAD_AUX(t + 2 * NW, auxN);
        }
#undef PG_TOK
#undef PG_LOAD_EG
#undef PG_LOAD_AUX
#undef PG_ROWS8
    }
}
__device__ __forceinline__ void peer_w_phase(Frame& F) {
    const unsigned* EG = (const unsigned*)(F.ws + WS_EG); const float* Pp = (const float*)(F.ws + WS_PP);
    const float* SU = (const float*)(F.ws + WS_SU); const float* SV = (const float*)(F.ws + WS_SV); float* Wt = (float*)(F.ws + WS_WT);
    for (size_t i = (size_t)F.bid * 512 + F.tid; i < (size_t)NTOK * 128; i += (size_t)F.G * 512) {
        float a = 0.f;
#pragma unroll
        for (int x = 0; x < 8; ++x) a += Pp[(size_t)x * NTOK * 128 + i];
        const unsigned egv = EG[i]; const unsigned e = egv & 0xffffu;
        Wt[i] = (float)__builtin_bit_cast(_Float16, (unsigned short)(egv >> 16)) * gelu_tanh(a * SU[e]) * SV[e];
    }
}

constexpr int N_PHASES = 12;
struct Args { const float* in[19]; float* out; unsigned char* ws; int ph_lo, ph_hi; };
__global__ void __launch_bounds__(NWAVES * 64, 2) fwd_kernel(Args args) {
    extern __shared__ __attribute__((aligned(16))) unsigned char lds_raw[];
    Frame F;
    F.lds = (LAS unsigned char*)lds_raw;
    F.tid = threadIdx.x; F.lane = F.tid & 63; F.wave = __builtin_amdgcn_readfirstlane(F.tid >> 6); F.G = gridDim.x; F.bid = blockIdx.x;
    F.x = args.in[0]; F.c = args.in[1]; F.w_ada = args.in[2]; F.b_ada = args.in[3]; F.norm1_g = args.in[4]; F.w_in = args.in[5]; F.b_fgate = args.in[6];
    F.fox_q_g = args.in[7]; F.fox_k_g = args.in[8]; F.moba_q_g = args.in[9]; F.moba_k_g = args.in[10]; F.w_up_fox = args.in[11]; F.w_up_moba = args.in[12];
    F.w_out = args.in[13]; F.norm2_g = args.in[14]; F.w_peer_q = args.in[15]; F.sub_keys = args.in[16]; F.peer_u = args.in[17]; F.peer_v = args.in[18];
    F.out = args.out; F.ws = args.ws;
    unsigned char* ws = args.ws;
    volatile LAS unsigned* MISC = (volatile LAS unsigned*)(F.lds + MISC_OFF);
    for (int u = F.tid; u < (LDS_BYTES - LDSCTL_OFF) / 4; u += NWAVES * 64) ((LAS unsigned*)(F.lds + LDSCTL_OFF))[u] = 0u;
    __syncthreads();
#if !MK_PER_PHASE
    XcdBarrier bar = xcd_barrier_post((unsigned*)(ws + WS_CTL) + CW_BAR, MISC + 8);
#define GRID_BAR() xcd_barrier(bar)
#else
    (void)MISC;
#define GRID_BAR() do {} while (0)
#endif
    const int lo = args.ph_lo, hi = args.ph_hi;
#define IN(k) (lo <= (k) && (k) < hi)
#define REPS(k) (((k) == DUP_PHASE) ? DUP_N : 1)
#define REP(k) for (int rep_ = 0; rep_ < REPS(k); ++rep_)
#define REPBAR(k) do { if (rep_ + 1 < REPS(k)) GRID_BAR(); } while (0)
#define SEAM(k) do { if (IN(k) && IN((k) + 1)) GRID_BAR(); } while (0)
    typedef pg8::bf16_t pb;

    if (IN(0)) REP(0) { p0_prep(F); REPBAR(0); } SEAM(0);
    if (IN(1)) REP(1) { rows_phase<0>(F); REPBAR(1); } SEAM(1);
    if (IN(2)) REP(2) {
        fcum_items(F);
        pg8::Gemm g{(const pb*)(ws + WS_HY), (const pb*)(ws + WS_WIN), NTOK, NIN, DM, DM, DM}; pg8::StaticOrder S; S.init(NTOK, NIN, F.G, F.bid);
        pg8::EpiIn E{(pb*)(ws + WS_QKV), (pb*)F.out, (const float*)(ws + WS_GAINS), (float*)(ws + ((rep_ + 1 < REPS(2)) ? WS_EG : WS_KMEAN))};
        pg8::gemm_phase<pg8::EpiIn, pg8::StaticOrder, true, true>(F.lds, g, S, E);
        REPBAR(2);
    } SEAM(2);
    if (IN(3)) REP(3) {
        const pb* qkv = (const pb*)(ws + WS_QKV); constexpr size_t TS = (size_t)NTOK * 512;
        for (int it = F.bid; it < 256; it += F.G) {
            const int bh = it >> 2, s = it & 3, b = bh >> 3, h = bh & 7;
            att::attn_unit<0>(b, h, 7 - s, qkv, qkv + TS, qkv + 2 * TS, (const float*)(ws + WS_FC), nullptr, (pb*)(ws + WS_HY), (__attribute__((address_space(3))) char*)F.lds);
            att::attn_unit<1>(b, h, 7 - s, qkv + 3 * TS, qkv + 4 * TS, qkv + 5 * TS, nullptr, (const float*)(ws + WS_KMEAN), (pb*)(ws + WS_HY), (__attribute__((address_space(3))) char*)F.lds);
            att::attn_unit<0>(b, h, s, qkv, qkv + TS, qkv + 2 * TS, (const float*)(ws + WS_FC), nullptr, (pb*)(ws + WS_HY), (__attribute__((address_space(3))) char*)F.lds);
            att::attn_unit<1>(b, h, s, qkv + 3 * TS, qkv + 4 * TS, qkv + 5 * TS, nullptr, (const float*)(ws + WS_KMEAN), (pb*)(ws + WS_HY), (__attribute__((address_space(3))) char*)F.lds);
        }
        REPBAR(3);
    } SEAM(3);
    if (IN(4)) {
        pg8::StaticOrder S; S.init(NTOK, DM, F.G, F.bid);
        { pg8::Gemm g{(const pb*)(ws + WS_HY), (const pb*)(ws + WS_WFT), NTOK, DM, 512, DM, 512};
          pg8::EpiUp<0> E{(const pb*)F.out, (pb*)(ws + WS_MIX)}; pg8::gemm_phase<pg8::EpiUp<0>, pg8::StaticOrder, true, true>(F.lds, g, S, E); }
        VM_WAIT(); __syncthreads();
        { pg8::Gemm g{(const pb*)(ws + WS_HY) + 512, (const pb*)(ws + WS_WMT), NTOK, DM, 512, DM, 512};
          pg8::EpiUp<1> E{(const pb*)F.out, (pb*)(ws + WS_MIX)}; pg8::gemm_phase<pg8::EpiUp<1>, pg8::StaticOrder, true, true>(F.lds, g, S, E); }
    } SEAM(4);
    if (IN(5)) {
        pg8::Gemm g{(const pb*)(ws + WS_MIX), (const pb*)(ws + WS_WOT), NTOK, DM, DM, DM, DM}; pg8::StaticOrder S; S.init(NTOK, DM, F.G, F.bid);
        pg8::EpiOut E{F.x, (const float*)(ws + WS_MOD), F.out, (float*)(ws + WS_PARTS)};
        pg8::gemm_phase<pg8::EpiOut, pg8::StaticOrder, true, true>(F.lds, g, S, E);
    } SEAM(5);
    if (IN(6)) { rows_phase<1>(F); } SEAM(6);
    if (IN(7)) REP(7) {
        pg8::Gemm g{(const pb*)(ws + WS_HY), (const pb*)(ws + WS_WEFF), NTOK, NSC, DM, DM, DM}; pg8::StaticOrder S; S.init(NTOK, NSC, F.G, F.bid);
        pg8::EpiSc E{(float*)(ws + WS_SC)};
        pg8::gemm_phase<pg8::EpiSc, pg8::StaticOrder, true, true>(F.lds, g, S, E);
        REPBAR(7);
    } SEAM(7);
    if (IN(8)) REP(8) { topk_phase(F); REPBAR(8); } SEAM(8);
    if (IN(9)) REP(9) { peer_gather<false>(F, false); REPBAR(9); } SEAM(9);
    if (IN(10)) REP(10) { peer_w_phase(F); REPBAR(10); } SEAM(10);
    if (IN(11)) REP(11) { peer_gather<true>(F, rep_ + 1 < REPS(11)); REPBAR(11); }
#undef IN
#undef SEAM
}

extern "C" void kernel_launch(void* const* d_in, const int* in_sizes, int n_in, void* d_out, int out_size, void* d_ws, size_t ws_size, hipStream_t stream) {
    static int grid = 0;
    if (grid == 0) {
        if (n_in != 19 || out_size != NTOK * DM || ws_size < WS_END) { fprintf(stderr, "kernel_launch: unexpected shapes (n_in %d, out %d, ws %zu); nothing launched\n", n_in, out_size, ws_size); grid = -1; return; }
        int dev = 0, cus = 0, per_cu = 0;
        if (hipGetDevice(&dev) != hipSuccess || hipDeviceGetAttribute(&cus, hipDeviceAttributeMultiprocessorCount, dev) != hipSuccess) { grid = -1; return; }
        if (hipFuncSetAttribute((const void*)fwd_kernel, hipFuncAttributeMaxDynamicSharedMemorySize, LDS_BYTES) != hipSuccess) { fprintf(stderr, "kernel_launch: hipFuncSetAttribute failed\n"); grid = -1; return; }
        if (hipOccupancyMaxActiveBlocksPerMultiprocessor(&per_cu, (const void*)fwd_kernel, NWAVES * 64, LDS_BYTES) != hipSuccess || per_cu < 1) { fprintf(stderr, "kernel_launch: occupancy query says %d blocks per CU\n", per_cu); per_cu = 1; }
        (void)hipGetLastError();
        grid = cus;
    }
    if (grid < 0) return;
    (void)hipMemsetAsync((char*)d_ws + WS_CTL, 0, CTL_ZERO_BYTES, stream);
    Args a{};
    for (int i = 0; i < 19; ++i) a.in[i] = (const float*)d_in[i];
    a.out = (float*)d_out; a.ws = (unsigned char*)d_ws;
#if MK_PER_PHASE
    for (int ph = 0; ph < N_PHASES; ++ph) { a.ph_lo = ph; a.ph_hi = ph + 1; hipLaunchKernelGGL(fwd_kernel, dim3(grid), dim3(NWAVES * 64), LDS_BYTES, stream, a); }
#else
    a.ph_lo = 0; a.ph_hi = N_PHASES;
    hipLaunchKernelGGL(fwd_kernel, dim3(grid), dim3(NWAVES * 64), LDS_BYTES, stream, a);
#endif
}
```

```cpp
#include <hip/hip_runtime.h>
#include <hip/hip_bf16.h>
#include <cstdio>
#include <cstdint>
#include <cmath>

#ifndef DUP_PHASE
#define DUP_PHASE -1
#endif
#define DUP_N 2
#ifndef MK_PER_PHASE
#define MK_PER_PHASE 0
#endif

constexpr int NB = 8, SEQ = 2048, DM = 1024, NTOK = NB * SEQ, NHEAD = 8, HDIM = 64;
constexpr int IN_COLS = 5128, NIN = 5120, NSC = 2048, NEXP = 16384;
constexpr float RMS_EPS = 1e-6f;
constexpr float LOG2E = 1.4426950408889634f;
constexpr float QSCALE = 0.125f * LOG2E;

namespace pg8 {
#define PG8_LAS __attribute__((address_space(3)))
typedef unsigned short bf16_t;
typedef short bf16x8 __attribute__((ext_vector_type(8)));
typedef float f32x4 __attribute__((ext_vector_type(4)));
typedef unsigned u32x4 __attribute__((ext_vector_type(4)));
constexpr int BM = 256, BK = 64, HALF = 128, HTB = HALF * BK * 2  , STAGE_BYTES = 8 * HTB, NXCD = 8, WGM = 8;

__host__ __device__ __forceinline__ int lds_byte(int r, int c) { const int st = (r >> 4) * 2 + (c >> 5), rr = r & 15, cc = c & 31, ob = rr * 64 + cc * 2; return st * 1024 + (ob ^ (((ob >> 9) & 1) << 5)); }
__host__ __device__ __forceinline__ void stage_rc(int b, int& R, int& C) { const int st = b / 1024, sb = b % 1024, swz = sb ^ (((sb >> 9) & 1) << 5); R = (st >> 1) * 16 + swz / 64; C = (st & 1) * 32 + (swz % 64) / 2; }
__host__ __device__ __forceinline__ int perm32(int rho) { const int n = rho >> 4, i = rho & 15; return 8 * (i >> 2) + 4 * n + (i & 3); }

struct Unit { int pm, pn; };
struct Gemm { const bf16_t* A; const bf16_t* Bt; int M, N, K, lda, ldb; };

struct StaticOrder {
    int nM, nN, nwg, G, c;
    __host__ __device__ void init(int M, int N, int G_, int c_) { nM = M / BM; nN = N / BM; nwg = nM * nN; G = G_; c = c_; }
    __host__ __device__ bool next(int i, Unit& u) const {
        const long L = (long)i * G + c; if (L >= nwg) return false;
        int wgid = (int)L; { const int q = nwg / NXCD, r = nwg % NXCD, xcd = wgid % NXCD, off = wgid / NXCD; wgid = (xcd < r ? xcd * (q + 1) : r * (q + 1) + (xcd - r) * q) + off; }
        const int nig = WGM * nN, gid = wgid / nig, fm = gid * WGM, gsz = (nM - fm) < WGM ? (nM - fm) : WGM;
        u.pm = fm + ((wgid % nig) % gsz); u.pn = (wgid % nig) / gsz; return true;
    }
    __device__ __forceinline__ void a_ready(const Unit&) const {}
    __device__ __forceinline__ void done(const Unit&) const {}
};

__device__ __forceinline__ unsigned cvt_pk_bf16(float lo, float hi) { unsigned r; asm volatile("v_cvt_pk_bf16_f32 %0, %1, %2" : "=v"(r) : "v"(lo), "v"(hi)); return r; }
__device__ __forceinline__ float bf_lo(unsigned w) { return __uint_as_float(w << 16); }
__device__ __forceinline__ float bf_hi(unsigned w) { return __uint_as_float(w & 0xffff0000u); }
__device__ __forceinline__ float sigmoidf_(float x) { return 1.0f / (1.0f + __expf(-x)); }

struct EpiIn {
    static constexpr bool PERM = true, AFTER_DRAIN = false;
    bf16_t* qkv;
    bf16_t* G;
    const float* gains;
    float* kmean;
    __device__ __forceinline__ void operator()(const f32x4 (&acc)[2][2][4][2], const Unit& u, int wr, int wc, int fr, int fq) const {
        const int pn = u.pn;
        if (pn < 12) {
            const int sec = pn >> 1, head = (pn & 1) * 4 + wc;
            const bool isq = (sec == 0 || sec == 3), isk = (sec == 1 || sec == 4);
            const float* gp = gains + ((sec >= 3 ? sec - 1 : sec) & 3) * 64;
            f32x4 gv[2][2];
#pragma unroll
            for (int bj = 0; bj < 2; ++bj)
#pragma unroll
                for (int n = 0; n < 2; ++n) { gv[bj][n] = (f32x4){1.f, 1.f, 1.f, 1.f}; if (isq || isk) gv[bj][n] = *(const f32x4*)(gp + 32 * bj + 8 * fq + 4 * n) * (isq ? QSCALE : 1.0f); }
            bf16_t* base = qkv + (size_t)sec * ((size_t)NTOK * 512);
            f32x4 cs[2][2];
#pragma unroll
            for (int bj = 0; bj < 2; ++bj)
#pragma unroll
                for (int n = 0; n < 2; ++n) cs[bj][n] = (f32x4){0.f, 0.f, 0.f, 0.f};
#pragma unroll
            for (int ai = 0; ai < 2; ++ai)
#pragma unroll
                for (int m = 0; m < 4; ++m) {
                    const int row = u.pm * BM + ai * HALF + wr * 64 + m * 16 + fr; const int b = row >> 11, s = row & 2047;
                    f32x4 v[2][2];
#pragma unroll
                    for (int bj = 0; bj < 2; ++bj)
#pragma unroll
                        for (int n = 0; n < 2; ++n) v[bj][n] = acc[ai][bj][m][n];
                    if (isq || isk) {
                        float ss = 0.f;
#pragma unroll
                        for (int bj = 0; bj < 2; ++bj)
#pragma unroll
                            for (int n = 0; n < 2; ++n) { const f32x4 x = v[bj][n]; ss += (x[0] * x[0] + x[1] * x[1]) + (x[2] * x[2] + x[3] * x[3]); }
                        ss += __shfl_xor(ss, 16); ss += __shfl_xor(ss, 32);
                        const float rstd = rsqrtf(ss * (1.0f / 64.0f) + RMS_EPS);
#pragma unroll
                        for (int bj = 0; bj < 2; ++bj)
#pragma unroll
                            for (int n = 0; n < 2; ++n) v[bj][n] = v[bj][n] * rstd * gv[bj][n];
                    }
                    if (sec == 4) {
#pragma unroll
                        for (int bj = 0; bj < 2; ++bj)
#pragma unroll
                            for (int n = 0; n < 2; ++n) cs[bj][n] += v[bj][n];
                    }
                    bf16_t* dst = base + ((size_t)(b * NHEAD + head) * SEQ + s) * HDIM + 8 * fq;
#pragma unroll
                    for (int bj = 0; bj < 2; ++bj) { u32x4 w; w.x = cvt_pk_bf16(v[bj][0][0], v[bj][0][1]); w.y = cvt_pk_bf16(v[bj][0][2], v[bj][0][3]); w.z = cvt_pk_bf16(v[bj][1][0], v[bj][1][1]); w.w = cvt_pk_bf16(v[bj][1][2], v[bj][1][3]);
                        *(u32x4*)(dst + 32 * bj) = w; }
                }
            if (sec == 4) {
                const int b = (u.pm * BM) >> 11, blk = u.pm & 7;
                float* km = kmean + ((size_t)(b * NHEAD + head) * 8 + blk) * HDIM + 8 * fq;
#pragma unroll
                for (int bj = 0; bj < 2; ++bj)
#pragma unroll
                    for (int n = 0; n < 2; ++n)
#pragma unroll
                        for (int e = 0; e < 4; ++e) { float x = cs[bj][n][e]; x += __shfl_xor(x, 1); x += __shfl_xor(x, 2); x += __shfl_xor(x, 4); x += __shfl_xor(x, 8);
                            if (fr == 0) atomicAdd(km + 32 * bj + 4 * n + e, x * (1.0f / 256.0f)); }
            }
        } else {
            const int gc0 = (pn - 12) * 256 + 64 * wc + 8 * fq;
#pragma unroll
            for (int ai = 0; ai < 2; ++ai)
#pragma unroll
                for (int m = 0; m < 4; ++m) {
                    const int row = u.pm * BM + ai * HALF + wr * 64 + m * 16 + fr;
                    bf16_t* dst = G + (size_t)row * 2048 + gc0;
#pragma unroll
                    for (int bj = 0; bj < 2; ++bj) { const f32x4 a = acc[ai][bj][m][0], c = acc[ai][bj][m][1]; u32x4 w;
                        w.x = cvt_pk_bf16(sigmoidf_(a[0]), sigmoidf_(a[1])); w.y = cvt_pk_bf16(sigmoidf_(a[2]), sigmoidf_(a[3])); w.z = cvt_pk_bf16(sigmoidf_(c[0]), sigmoidf_(c[1])); w.w = cvt_pk_bf16(sigmoidf_(c[2]), sigmoidf_(c[3]));
                        *(u32x4*)(dst + 32 * bj) = w; }
                }
        }
    }
};

template <int SECOND> struct EpiUp {
    static constexpr bool PERM = true, AFTER_DRAIN = false;
    const bf16_t* G; bf16_t* MIX;
    __device__ __forceinline__ void operator()(const f32x4 (&acc)[2][2][4][2], const Unit& u, int wr, int wc, int fr, int fq) const {
        const int col0 = u.pn * BM + wc * 32 + 8 * fq;
#pragma unroll
        for (int ai = 0; ai < 2; ++ai)
#pragma unroll
            for (int m = 0; m < 4; ++m) {
                const int row = u.pm * BM + ai * HALF + wr * 64 + m * 16 + fr;
#pragma unroll
                for (int bj = 0; bj < 2; ++bj) {
                    const int col = col0 + bj * HALF;
                    const u32x4 g = *(const u32x4*)(G + (size_t)row * 2048 + SECOND * 1024 + col);
                    const f32x4 a = acc[ai][bj][m][0], c = acc[ai][bj][m][1];
                    float v[8] = {a[0] * bf_lo(g.x), a[1] * bf_hi(g.x), a[2] * bf_lo(g.y), a[3] * bf_hi(g.y), c[0] * bf_lo(g.z), c[1] * bf_hi(g.z), c[2] * bf_lo(g.w), c[3] * bf_hi(g.w)};
                    bf16_t* p = MIX + (size_t)row * 1024 + col;
                    if (SECOND) { const u32x4 o = __builtin_nontemporal_load((const u32x4*)p);
                        v[0] += bf_lo(o.x); v[1] += bf_hi(o.x); v[2] += bf_lo(o.y); v[3] += bf_hi(o.y); v[4] += bf_lo(o.z); v[5] += bf_hi(o.z); v[6] += bf_lo(o.w); v[7] += bf_hi(o.w); }
                    u32x4 w; w.x = cvt_pk_bf16(v[0], v[1]); w.y = cvt_pk_bf16(v[2], v[3]); w.z = cvt_pk_bf16(v[4], v[5]); w.w = cvt_pk_bf16(v[6], v[7]);
                    *(u32x4*)p = w;
                }
            }
    }
};

struct EpiOut {
    static constexpr bool PERM = true, AFTER_DRAIN = false;
    const float* x; const float* mod; float* out; float* parts;
    __device__ __forceinline__ void operator()(const f32x4 (&acc)[2][2][4][2], const Unit& u, int wr, int wc, int fr, int fq) const {
        const int col0 = u.pn * BM + wc * 32 + 8 * fq;
        const int b = (u.pm * BM) >> 11;
        const float* g1 = mod + (size_t)b * 6144 + 2048;
        f32x4 gt[2][2];
#pragma unroll
        for (int bj = 0; bj < 2; ++bj)
#pragma unroll
            for (int n = 0; n < 2; ++n) gt[bj][n] = *(const f32x4*)(g1 + col0 + bj * HALF + 4 * n);
#pragma unroll
        for (int ai = 0; ai < 2; ++ai)
#pragma unroll
            for (int m = 0; m < 4; ++m) {
                const int row = u.pm * BM + ai * HALF + wr * 64 + m * 16 + fr; const size_t off = (size_t)row * 1024 + col0;
                float ss = 0.f;
#pragma unroll
                for (int bj = 0; bj < 2; ++bj)
#pragma unroll
                    for (int n = 0; n < 2; ++n) { const f32x4 xv = *(const f32x4*)(x + off + bj * HALF + 4 * n); const f32x4 o = xv + gt[bj][n] * acc[ai][bj][m][n];
                        ss += (o[0] * o[0] + o[1] * o[1]) + (o[2] * o[2] + o[3] * o[3]); *(f32x4*)(out + off + bj * HALF + 4 * n) = o; }
                ss += __shfl_xor(ss, 16); ss += __shfl_xor(ss, 32);
                if (fq == 0) parts[(size_t)row * 16 + u.pn * 4 + wc] = ss;
            }
    }
};

struct EpiSc {
    static constexpr bool PERM = true, AFTER_DRAIN = false;
    float* SC;
    __device__ __forceinline__ void operator()(const f32x4 (&acc)[2][2][4][2], const Unit& u, int wr, int wc, int fr, int fq) const {
        const int col0 = u.pn * BM + wc * 32 + 8 * fq;
#pragma unroll
        for (int ai = 0; ai < 2; ++ai)
#pragma unroll
            for (int m = 0; m < 4; ++m) {
                const int row = u.pm * BM + ai * HALF + wr * 64 + m * 16 + fr; const size_t off = (size_t)row * 2048 + col0;
#pragma unroll
                for (int bj = 0; bj < 2; ++bj)
#pragma unroll
                    for (int n = 0; n < 2; ++n) *(f32x4*)(SC + off + bj * HALF + 4 * n) = acc[ai][bj][m][n];
            }
    }
};

template <class Epi, class Sched, bool ALIGN_EPI = false, bool SP2 = false>
__device__ __forceinline__ void gemm_phase(PG8_LAS unsigned char* lds, const Gemm g, const Sched& S, const Epi& E) {
    const int tid = threadIdx.x, wid = __builtin_amdgcn_readfirstlane(tid >> 6), lane = tid & 63, wr = wid >> 2, wc = wid & 3, fr = lane & 15, fq = lane >> 4;
    const int K = g.K, nt = K / BK;
    unsigned voffA[2], voffB[2];
#pragma unroll
    for (int i = 0; i < 2; ++i) { int R, C; stage_rc(tid * 16 + i * 8192, R, C); const int Rb = Epi::PERM ? ((R & ~31) + perm32(R & 31)) : R;
        voffA[i] = (unsigned)(R * g.lda + C) * 2u; voffB[i] = (unsigned)(Rb * g.ldb + C) * 2u; }
    const size_t kstep = (size_t)(BK * 2);
    const size_t hstepA = (size_t)HALF * g.lda * 2, hstepB = (size_t)HALF * g.ldb * 2;
    const size_t tstepA = 2 * hstepA, tstepB = 2 * hstepB;
    const unsigned ldsw = (unsigned)wid * 1024u;
    const int aoff = lds_byte(wr * 64 + fr, fq * 8), boff = lds_byte(wc * 32 + fr, fq * 8);
#define PG8_SA(b, h) (((b) * 2 + (h)) * HTB)
#define PG8_SB(b, h) ((4 + (b) * 2 + (h)) * HTB)
#define PG8_STAGE(bufoff, gbase, voff) do { _Pragma("unroll") for (int _i = 0; _i < 2; ++_i) \
        __builtin_amdgcn_global_load_lds((const unsigned*)((const char*)(gbase) + (voff)[_i]), (PG8_LAS unsigned*)(lds + (bufoff) + ldsw + _i * 8192), 16, 0, 0); } while (0)
#define PG8_LDA(dst, b, h) do { _Pragma("unroll") for (int m = 0; m < 4; ++m) _Pragma("unroll") for (int k = 0; k < 2; ++k) dst[m][k] = *(const PG8_LAS bf16x8*)(lds + PG8_SA(b, h) + aoff + m * 2048 + k * 1024); } while (0)
#define PG8_LDB(dst, b, h) do { _Pragma("unroll") for (int n = 0; n < 2; ++n) _Pragma("unroll") for (int k = 0; k < 2; ++k) dst[n][k] = *(const PG8_LAS bf16x8*)(lds + PG8_SB(b, h) + boff + n * 2048 + k * 1024); } while (0)
#define PG8_MMA(ai, bj, At, Bt) do { __builtin_amdgcn_s_setprio(1); _Pragma("unroll") for (int m = 0; m < 4; ++m) _Pragma("unroll") for (int n = 0; n < 2; ++n) _Pragma("unroll") for (int k = 0; k < 2; ++k) \
        acc[ai][bj][m][n] = __builtin_amdgcn_mfma_f32_16x16x32_bf16(Bt[n][k], At[m][k], acc[ai][bj][m][n], 0, 0, 0); __builtin_amdgcn_s_setprio(0); } while (0)
#define PG8_WAIT_V(n) asm volatile("s_waitcnt vmcnt(" #n ")" ::: "memory")
#define PG8_WAIT_L(n) asm volatile("s_waitcnt lgkmcnt(" #n ")" ::: "memory")
#define PG8_BAR __builtin_amdgcn_s_barrier()
#define PG8_SCHED __builtin_amdgcn_sched_barrier(0)
    Unit cur, nxt; int ui = 0;
    if (!S.next(0, cur)) return;
    f32x4 acc[2][2][4][2];
#pragma unroll
    for (int a = 0; a < 2; ++a)
#pragma unroll
        for (int b = 0; b < 2; ++b)
#pragma unroll
            for (int m = 0; m < 4; ++m)
#pragma unroll
                for (int n = 0; n < 2; ++n) acc[a][b][m][n] = (f32x4){0.f, 0.f, 0.f, 0.f};
    bf16x8 At[4][2], B0[2][2], B1[2][2];
    const char* cA = (const char*)g.A + (size_t)cur.pm * tstepA; const char* cB = (const char*)g.Bt + (size_t)cur.pn * tstepB;
    S.a_ready(cur);
    if constexpr (SP2) {
        PG8_STAGE(PG8_SB(0, 0), cB, voffB); PG8_STAGE(PG8_SB(0, 1), cB + hstepB, voffB); PG8_STAGE(PG8_SA(0, 0), cA, voffA); PG8_STAGE(PG8_SA(0, 1), cA + hstepA, voffA);
        if (wr == 1) PG8_BAR;
        PG8_WAIT_V(2); PG8_BAR;
        PG8_STAGE(PG8_SB(1, 0), cB + kstep, voffB); PG8_STAGE(PG8_SA(1, 0), cA + kstep, voffA); PG8_STAGE(PG8_SB(1, 1), cB + hstepB + kstep, voffB);
        PG8_WAIT_V(6); PG8_BAR;
    } else {
        PG8_STAGE(PG8_SB(0, 0), cB, voffB); PG8_STAGE(PG8_SA(0, 0), cA, voffA); PG8_STAGE(PG8_SB(0, 1), cB + hstepB, voffB); PG8_STAGE(PG8_SA(0, 1), cA + hstepA, voffA);
        if (wr == 1) PG8_BAR;
        PG8_WAIT_V(4); PG8_BAR;
        PG8_STAGE(PG8_SB(1, 0), cB + kstep, voffB); PG8_STAGE(PG8_SA(1, 0), cA + kstep, voffA); PG8_STAGE(PG8_SB(1, 1), cB + hstepB + kstep, voffB);
        PG8_WAIT_V(6); PG8_BAR;
    }
    for (;;) {
        const bool has_next = S.next(ui + 1, nxt);
        const char* nA = has_next ? (const char*)g.A + (size_t)nxt.pm * tstepA : cA; const char* nB = has_next ? (const char*)g.Bt + (size_t)nxt.pn * tstepB : cB;
        for (int t = 0; t < nt; t += 2) {
            const bool last = (t == nt - 2);
            const char* a1 = cA + (size_t)(t + 1) * kstep;
            const char* a2 = last ? nA : cA + (size_t)(t + 2) * kstep; const char* b2 = last ? nB : cB + (size_t)(t + 2) * kstep;
            const char* a3 = a2 + kstep; const char* b3 = b2 + kstep;
            if (last && has_next) S.a_ready(nxt);
            if constexpr (SP2) {
            PG8_LDB(B0, 0, 0); PG8_LDB(B1, 0, 1); PG8_SCHED; PG8_LDA(At, 0, 0); PG8_STAGE(PG8_SA(1, 1), a1 + hstepA, voffA);
            PG8_WAIT_V(8); PG8_WAIT_L(0); PG8_BAR; PG8_MMA(0, 0, At, B0); PG8_MMA(0, 1, At, B1); PG8_BAR; PG8_SCHED;
            PG8_LDA(At, 0, 1); PG8_STAGE(PG8_SB(0, 0), b2, voffB); PG8_STAGE(PG8_SB(0, 1), b2 + hstepB, voffB); PG8_STAGE(PG8_SA(0, 0), a2, voffA);
            PG8_WAIT_V(8); PG8_WAIT_L(0); PG8_BAR; PG8_MMA(1, 0, At, B0); PG8_MMA(1, 1, At, B1); PG8_BAR; PG8_SCHED;
            PG8_LDB(B0, 1, 0); PG8_LDB(B1, 1, 1); PG8_SCHED; PG8_LDA(At, 1, 0); PG8_STAGE(PG8_SA(0, 1), a2 + hstepA, voffA);
            PG8_WAIT_V(8); PG8_WAIT_L(0); PG8_BAR; PG8_MMA(0, 0, At, B0); PG8_MMA(0, 1, At, B1); PG8_BAR; PG8_SCHED;
            PG8_LDA(At, 1, 1); PG8_STAGE(PG8_SB(1, 0), b3, voffB); PG8_STAGE(PG8_SB(1, 1), b3 + hstepB, voffB); PG8_STAGE(PG8_SA(1, 0), a3, voffA);
            PG8_WAIT_V(8); PG8_WAIT_L(0); PG8_BAR; PG8_MMA(1, 0, At, B0); PG8_MMA(1, 1, At, B1); PG8_BAR; PG8_SCHED;
            } else {
            PG8_LDB(B0, 0, 0); PG8_SCHED; PG8_LDA(At, 0, 0); PG8_STAGE(PG8_SA(1, 1), a1 + hstepA, voffA);
            PG8_WAIT_L(8); PG8_BAR; PG8_WAIT_L(0); PG8_MMA(0, 0, At, B0); PG8_BAR; PG8_SCHED;
            PG8_LDB(B1, 0, 1); PG8_STAGE(PG8_SB(0, 0), b2, voffB);
            PG8_BAR; PG8_WAIT_L(0); PG8_MMA(0, 1, At, B1); PG8_BAR;
            PG8_LDA(At, 0, 1); PG8_STAGE(PG8_SA(0, 0), a2, voffA);
            PG8_BAR; PG8_WAIT_L(0); PG8_MMA(1, 0, At, B0); PG8_BAR; PG8_SCHED;
            PG8_STAGE(PG8_SB(0, 1), b2 + hstepB, voffB);
            PG8_WAIT_V(6); PG8_BAR; PG8_MMA(1, 1, At, B1); PG8_BAR;
            PG8_LDB(B0, 1, 0); PG8_SCHED; PG8_LDA(At, 1, 0); PG8_STAGE(PG8_SA(0, 1), a2 + hstepA, voffA);
            PG8_WAIT_L(8); PG8_BAR; PG8_WAIT_L(0); PG8_MMA(0, 0, At, B0); PG8_BAR; PG8_SCHED;
            PG8_LDB(B1, 1, 1); PG8_STAGE(PG8_SB(1, 0), b3, voffB);
            PG8_BAR; PG8_WAIT_L(0); PG8_MMA(0, 1, At, B1); PG8_BAR;
            PG8_LDA(At, 1, 1); PG8_STAGE(PG8_SA(1, 0), a3, voffA);
            PG8_BAR; PG8_WAIT_L(0); PG8_MMA(1, 0, At, B0); PG8_BAR; PG8_SCHED;
            PG8_STAGE(PG8_SB(1, 1), b3 + hstepB, voffB);
            PG8_WAIT_V(6); PG8_BAR; PG8_MMA(1, 1, At, B1); PG8_BAR;
            }
        }
        if constexpr (ALIGN_EPI) { if (wr == 0) PG8_BAR; }
        if constexpr (!Epi::AFTER_DRAIN) { E(acc, cur, wr, wc, fr, fq); S.done(cur); }
        if (!has_next) break;
#pragma unroll
        for (int a = 0; a < 2; ++a)
#pragma unroll
            for (int b = 0; b < 2; ++b)
#pragma unroll
                for (int m = 0; m < 4; ++m)
#pragma unroll
                    for (int n = 0; n < 2; ++n) acc[a][b][m][n] = (f32x4){0.f, 0.f, 0.f, 0.f};
        cur = nxt; cA = nA; cB = nB; ++ui;
        if constexpr (ALIGN_EPI) { if (wr == 1) PG8_BAR; }
    }
    PG8_WAIT_V(0);
    if constexpr (!ALIGN_EPI) { if (wr == 0) PG8_BAR; }
    PG8_BAR;
    if constexpr (Epi::AFTER_DRAIN) { E.fused(acc, cur, wr, wc, fr, fq, lds, wid, lane); S.done(cur); }
#undef PG8_SA
#undef PG8_SB
#undef PG8_STAGE
#undef PG8_LDA
#undef PG8_LDB
#undef PG8_MMA
#undef PG8_WAIT_V
#undef PG8_WAIT_L
#undef PG8_BAR
#undef PG8_SCHED
}
}

namespace att {
#define ALAS __attribute__((address_space(3)))
typedef unsigned short bf16_t;
typedef short bf16x8 __attribute__((ext_vector_type(8)));
typedef short s16x4 __attribute__((ext_vector_type(4)));
typedef short v4i16_t __attribute__((ext_vector_type(4)));
typedef float f32x16 __attribute__((ext_vector_type(16)));
typedef float f32x4 __attribute__((ext_vector_type(4)));
typedef unsigned u32x4 __attribute__((ext_vector_type(4)));
constexpr int L_K = 0, L_V = 24576, L_KB = 40960, L_KM = 49152, L_STG = 51200, L_END = L_STG + 8 * 4096;
__device__ __forceinline__ s16x4 vtr(const ALAS char* p) { return __builtin_bit_cast(s16x4, __builtin_amdgcn_ds_read_tr16_b64_v4i16((ALAS v4i16_t*)p)); }
__device__ __forceinline__ unsigned cvtpk(float lo, float hi) { typedef float f2 __attribute__((ext_vector_type(2))); typedef __bf16 b2 __attribute__((ext_vector_type(2))); f2 v = {lo, hi}; b2 b = __builtin_convertvector(v, b2); return __builtin_bit_cast(unsigned, b); }
__device__ __forceinline__ float pairsum(float v) { auto rr = __builtin_amdgcn_permlane32_swap(__float_as_uint(v), __float_as_uint(v), false, false); return __uint_as_float(rr[0]) + __uint_as_float(rr[1]); }
__device__ __forceinline__ float max3f(float a, float b, float c) { float r; asm("v_max3_f32 %0, %1, %2, %3" : "=v"(r) : "v"(a), "v"(b), "v"(c)); return r; }

template <int TYPE>
__device__ __forceinline__ void attn_unit(int b, int h, int qb, const bf16_t* Q, const bf16_t* K, const bf16_t* V, const float* Fcum, const float* kmean, bf16_t* Y, ALAS char* lds) {
    const int tid = threadIdx.x, lane = tid & 63, r32 = lane & 31, hi = lane >> 5; const int wid = __builtin_amdgcn_readfirstlane(tid >> 6);
    const size_t headbase = (size_t)(b * NHEAD + h) * SEQ * HDIM;
    const char* Kh = (const char*)(K + headbase); const char* Vh = (const char*)(V + headbase); const bf16_t* Qh = Q + headbase;
    const int q0 = qb * 256, NT = 4 * (qb + 1);
    ALAS float* kbias = (ALAS float*)(lds + L_KB);
    ALAS float* km = (ALAS float*)(lds + L_KM);
    {
        const float slope = exp2f(-(float)(h + 1));
        for (int s = tid; s < q0 + 256; s += 512) kbias[s] = (TYPE == 0) ? (-Fcum[(size_t)(b * NHEAD + h) * SEQ + s] * LOG2E) : (slope * (float)s * LOG2E);
        if (TYPE == 1) km[tid] = kmean[(size_t)(b * NHEAD + h) * 512 + tid];
    }
    bf16x8 qr[4];
    { const bf16_t* qrow = Qh + (size_t)(q0 + wid * 32 + r32) * HDIM;
#pragma unroll
      for (int d0 = 0; d0 < 4; ++d0) qr[d0] = *(const bf16x8*)(qrow + d0 * 16 + hi * 8); }
    const int koff = lane * 128 + wid * 16;
    const int voff = (16 * (wid & 3) + (lane >> 2)) * 128 + (wid >> 2) * 64 + (lane & 3) * 16;
    const int ldst = wid * 1024 + lane * 16;
    { const u32x4 k0 = *(const u32x4*)(Kh + koff), k1 = *(const u32x4*)(Kh + 8192 + koff), v0 = *(const u32x4*)(Vh + voff);
      *(ALAS u32x4*)(lds + L_K + ldst) = k0; *(ALAS u32x4*)(lds + L_K + 8192 + ldst) = k1; *(ALAS u32x4*)(lds + L_V + ldst) = v0; }
    u32x4 kreg = *(const u32x4*)(Kh + 2 * 8192 + koff), vreg = *(const u32x4*)(Vh + 8192 + voff);
    __syncthreads();
    unsigned sel = 0xffu;
    if (TYPE == 1) {
        float gate[7];
#pragma unroll
        for (int jb = 0; jb < 7; ++jb) {
            float g = 0.f;
#pragma unroll
            for (int d0 = 0; d0 < 4; ++d0) {
                const f32x4 k0 = *(const ALAS f32x4*)(km + jb * 64 + d0 * 16 + hi * 8), k1 = *(const ALAS f32x4*)(km + jb * 64 + d0 * 16 + hi * 8 + 4);
#pragma unroll
                for (int e = 0; e < 4; ++e) { g += __uint_as_float((unsigned)(unsigned short)qr[d0][e] << 16) * k0[e]; g += __uint_as_float((unsigned)(unsigned short)qr[d0][4 + e] << 16) * k1[e]; }
            }
            gate[jb] = pairsum(g);
        }
        if (qb <= 3) sel = (1u << qb) - 1u;
        else { sel = 0u;
#pragma unroll
            for (int it = 0; it < 3; ++it) { float best = -INFINITY; int bi = 0;
#pragma unroll
                for (int jb = 0; jb < 7; ++jb) { const bool ok = (jb < qb) && !((sel >> jb) & 1u) && (gate[jb] > best); best = ok ? gate[jb] : best; bi = ok ? jb : bi; }
                sel |= 1u << bi; } }
    }
    float m_run = -1e30f, l_run = 0.f; f32x16 o[2]; o[0] = f32x16{}; o[1] = f32x16{};
    const int qrel = wid * 32 + r32;
    auto qk_tile = [&](int t, int kslot, f32x16& p0, f32x16& p1) {
        { const ALAS float* kbt = kbias + 64 * t + 4 * hi;
#pragma unroll
          for (int rq = 0; rq < 4; ++rq) { const f32x4 b0 = *(const ALAS f32x4*)(kbt + 8 * rq), b1 = *(const ALAS f32x4*)(kbt + 32 + 8 * rq);
#pragma unroll
              for (int e = 0; e < 4; ++e) { p0[4 * rq + e] = b0[e]; p1[4 * rq + e] = b1[e]; } } }
        { const ALAS char* kb = lds + L_K + kslot * 8192 + hi * 1024 + r32 * 16;
#pragma unroll
          for (int d0 = 0; d0 < 4; ++d0) { const bf16x8 b0 = *(const ALAS bf16x8*)(kb + d0 * 2048), b1 = *(const ALAS bf16x8*)(kb + d0 * 2048 + 512);
              p0 = __builtin_amdgcn_mfma_f32_32x32x16_bf16(b0, qr[d0], p0, 0, 0, 0); p1 = __builtin_amdgcn_mfma_f32_32x32x16_bf16(b1, qr[d0], p1, 0, 0, 0); } }
    };
    auto mask_tile = [&](int t, f32x16& p0, f32x16& p1) {
        const int jband = t - (NT - 4);
        if (jband >= 0) { const int kb0 = 64 * jband + 4 * hi;
#pragma unroll
            for (int r = 0; r < 16; ++r) { const int kv = kb0 + (r & 3) + 8 * (r >> 2); if (kv > qrel) p0[r] = -INFINITY; if (kv + 32 > qrel) p1[r] = -INFINITY; } }
        else if (TYPE == 1) { if (!((sel >> (t >> 2)) & 1u)) {
#pragma unroll
            for (int r = 0; r < 16; ++r) { p0[r] = -INFINITY; p1[r] = -INFINITY; } } }
    };
    f32x16 s0, s1;
    qk_tile(0, 0, s0, s1);
    int ks_next = 1, ks_st = 2;
    for (int t = 0; t < NT; ++t) {
        const int buf = t & 1;
        mask_tile(t, s0, s1);
        f32x16 n0, n1;
        qk_tile(t + 1, ks_next, n0, n1);
        {
            float ra = max3f(s0[0], s0[1], s1[0]), rb = max3f(s0[2], s0[3], s1[1]); ra = max3f(ra, s1[2], s1[3]);
#pragma unroll
            for (int r = 4; r < 16; r += 4) { ra = max3f(ra, s0[r], s0[r + 1]); rb = max3f(rb, s0[r + 2], s0[r + 3]); ra = max3f(ra, s1[r], s1[r + 1]); rb = max3f(rb, s1[r + 2], s1[r + 3]); }
            float rm = max3f(ra, rb, rb);
            { auto rr = __builtin_amdgcn_permlane32_swap(__float_as_uint(rm), __float_as_uint(rm), false, false); rm = max3f(__uint_as_float(rr[0]), __uint_as_float(rr[1]), rm); }
            const float mn = fmaxf(m_run, rm), alpha = __builtin_amdgcn_exp2f(m_run - mn); m_run = mn;
            float rs = 0.f;
#pragma unroll
            for (int r = 0; r < 16; ++r) { s0[r] = __builtin_amdgcn_exp2f(s0[r] - mn); s1[r] = __builtin_amdgcn_exp2f(s1[r] - mn); rs += s0[r] + s1[r]; }
            l_run = l_run * alpha + rs;
#pragma unroll
            for (int r = 0; r < 16; ++r) { o[0][r] *= alpha; o[1][r] *= alpha; }
            u32x4 pw[4];
            pw[0] = (u32x4){cvtpk(s0[0], s0[1]), cvtpk(s0[2], s0[3]), cvtpk(s0[4], s0[5]), cvtpk(s0[6], s0[7])};
            pw[1] = (u32x4){cvtpk(s0[8], s0[9]), cvtpk(s0[10], s0[11]), cvtpk(s0[12], s0[13]), cvtpk(s0[14], s0[15])};
            pw[2] = (u32x4){cvtpk(s1[0], s1[1]), cvtpk(s1[2], s1[3]), cvtpk(s1[4], s1[5]), cvtpk(s1[6], s1[7])};
            pw[3] = (u32x4){cvtpk(s1[8], s1[9]), cvtpk(s1[10], s1[11]), cvtpk(s1[12], s1[13]), cvtpk(s1[14], s1[15])};
            const ALAS char* vp = lds + L_V + buf * 8192 + ((lane >> 4) & 1) * 32 + (lane & 3) * 8 + (4 * hi + ((lane & 15) >> 2)) * 64;
#pragma unroll
            for (int d0 = 0; d0 < 2; ++d0)
#pragma unroll
                for (int ks = 0; ks < 4; ++ks) { const s16x4 lo = vtr(vp + d0 * 4096 + ks * 1024), hh = vtr(vp + d0 * 4096 + ks * 1024 + 512);
                    const bf16x8 vf = (bf16x8){lo[0], lo[1], lo[2], lo[3], hh[0], hh[1], hh[2], hh[3]};
                    o[d0] = __builtin_amdgcn_mfma_f32_32x32x16_bf16(vf, __builtin_bit_cast(bf16x8, pw[ks]), o[d0], 0, 0, 0); }
        }
        *(ALAS u32x4*)(lds + L_K + ks_st * 8192 + ldst) = kreg; *(ALAS u32x4*)(lds + L_V + (buf ^ 1) * 8192 + ldst) = vreg;
        { const int tk = (t + 3 < NT) ? t + 3 : NT - 1, tv = (t + 2 < NT) ? t + 2 : NT - 1;
          kreg = *(const u32x4*)(Kh + (size_t)tk * 8192 + koff); vreg = *(const u32x4*)(Vh + (size_t)tv * 8192 + voff); }
        __syncthreads();
        s0 = n0; s1 = n1;
        ks_next = (ks_next == 2) ? 0 : ks_next + 1; ks_st = (ks_st == 2) ? 0 : ks_st + 1;
    }
    l_run = pairsum(l_run);
    const float rl = 1.0f / l_run;
    ALAS bf16_t* stg = (ALAS bf16_t*)(lds + L_STG) + wid * 2048;
#pragma unroll
    for (int d0 = 0; d0 < 2; ++d0)
#pragma unroll
        for (int rq = 0; rq < 4; ++rq) { typedef unsigned u32x2 __attribute__((ext_vector_type(2)));
            const u32x2 w = {cvtpk(o[d0][4 * rq] * rl, o[d0][4 * rq + 1] * rl), cvtpk(o[d0][4 * rq + 2] * rl, o[d0][4 * rq + 3] * rl)};
            *(ALAS u32x2*)(stg + r32 * 64 + d0 * 32 + 8 * rq + 4 * hi) = w; }
    asm volatile("s_waitcnt lgkmcnt(0)" ::: "memory");
    bf16_t* Yw = Y + (size_t)(b * SEQ + q0 + wid * 32) * 1024 + TYPE * 512 + h * 64;
#pragma unroll
    for (int i = 0; i < 4; ++i) { const int row = i * 8 + (lane >> 3), ch = lane & 7; const u32x4 v = *(const ALAS u32x4*)(stg + row * 64 + ch * 8); *(u32x4*)(Yw + (size_t)row * 1024 + ch * 8) = v; }
    __syncthreads();
}
#undef ALAS
}

constexpr int NWAVES = 8;
constexpr size_t MiB = 1u << 20;
constexpr size_t WS_CTL = 0, CTL_ZERO_BYTES = 256 * 1024;
constexpr size_t WS_KMEAN = 64 * 1024;
constexpr size_t WS_MOD = 256 * 1024;
constexpr size_t WS_WFG = 448 * 1024;
constexpr size_t WS_GAINS = 480 * 1024;
constexpr size_t WS_LF = 512 * 1024;
constexpr size_t WS_FC = 1 * MiB;
constexpr size_t WS_PARTS = 2 * MiB;
constexpr size_t WS_WIN = 4 * MiB;
constexpr size_t WS_WFT = 14 * MiB, WS_WMT = 15 * MiB;
constexpr size_t WS_WOT = 16 * MiB;
constexpr size_t WS_WEFF = 18 * MiB;
constexpr size_t WS_HY = 24 * MiB;
constexpr size_t WS_QKV = 56 * MiB;
constexpr size_t WS_MIX = 152 * MiB;
constexpr size_t WS_U8 = 184 * MiB, WS_V8 = 200 * MiB;
constexpr size_t WS_SU = 216 * MiB, WS_SV = 216 * MiB + 65536;
constexpr size_t WS_PP = 56 * MiB;
constexpr size_t WS_WT = 220 * MiB;
constexpr size_t WS_EG = 248 * MiB;
constexpr size_t WS_SC = 56 * MiB;
constexpr size_t WS_END = 256 * MiB;
constexpr int CW_BAR = 4096;
constexpr int RING_BYTES = 131072, LDSCTL_OFF = RING_BYTES, MISC_OFF = LDSCTL_OFF + 320, LDS_BYTES = 147456;

#define GAS __attribute__((address_space(1)))
#define LAS __attribute__((address_space(3)))
typedef unsigned short bf16;
typedef unsigned v4u __attribute__((ext_vector_type(4)));
typedef unsigned v2u __attribute__((ext_vector_type(2)));
typedef float f32x4 __attribute__((ext_vector_type(4)));
typedef GAS unsigned gu32;
#define RLX_AGENT __ATOMIC_RELAXED, __HIP_MEMORY_SCOPE_AGENT
#define LDS_WAIT() asm volatile("s_waitcnt lgkmcnt(0)" ::: "memory")
#define VM_WAIT() asm volatile("s_waitcnt vmcnt(0)" ::: "memory")
__device__ __forceinline__ unsigned f2bf(float f) { unsigned u = __builtin_bit_cast(unsigned, f); return (u + 0x7fffu + ((u >> 16) & 1u)) >> 16; }
__device__ __forceinline__ unsigned pk2(float lo, float hi) { return f2bf(lo) | (f2bf(hi) << 16); }
__device__ __forceinline__ float wave_sum(float v) {
#pragma unroll
    for (int o = 1; o < 64; o <<= 1) v += __shfl_xor(v, o);
    return v;
}
#define XB_TMO      128
#define XB_XCNT(j)  (256  + 64 * (j))
#define XB_XSUB(j)  (1280 + 64 * (j))
#define XB_XGEN(j)  (2304 + 64 * (j))
#define XB_TOP      3328
#define XB_TOPGEN   3392
#define XCD_BAR_WORDS 3456
#define XB_SPIN_CAP (1u << 18)

__device__ __forceinline__ unsigned xb_ld(unsigned* p)              { return __hip_atomic_load(p, __ATOMIC_RELAXED, __HIP_MEMORY_SCOPE_AGENT); }
__device__ __forceinline__ unsigned xb_add(unsigned* p, unsigned v) { return __hip_atomic_fetch_add(p, v, __ATOMIC_RELAXED, __HIP_MEMORY_SCOPE_AGENT); }
__device__ __forceinline__ unsigned xb_xcc_id() { return (unsigned)__builtin_amdgcn_s_getreg((3 << 11) | 20) & 0xFu; }
#define XB_SPIN(cond, bar) do { unsigned _sp = 0; while (cond) { __builtin_amdgcn_s_sleep(1); \
    if ((++_sp & 255u) == 0u) { if (xb_ld(&(bar)[XB_TMO])) break; if (_sp > XB_SPIN_CAP) { atomicAdd(&(bar)[XB_TMO], 1u); break; } } } } while (0)

struct XcdBarrier {
    unsigned* bar; unsigned x;
    volatile LAS unsigned* st;
};

__device__ __forceinline__ XcdBarrier xcd_barrier_post(unsigned* bar, volatile LAS unsigned* st) {
    XcdBarrier b; b.bar = bar; b.x = xb_xcc_id(); b.st = st;
    if (threadIdx.x == 0) (void)xb_add(&bar[XB_XCNT(b.x)], 1u);
    return b;
}
__device__ __forceinline__ void xcd_barrier_complete(unsigned* bar, unsigned x, unsigned& nloc, unsigned& nx) {
    const unsigned G = gridDim.x * gridDim.y * gridDim.z;
    unsigned sum, cnt, mine, sp = 0u;
    for (;;) {
        sum = 0u; cnt = 0u; mine = 0u;
#pragma unroll
        for (unsigned j = 0; j < 16; ++j) { const unsigned c = xb_ld(&bar[XB_XCNT(j)]); sum += c; cnt += (c > 0u) ? 1u : 0u; mine = (j == x) ? c : mine; }
        if (sum == G) break;
        __builtin_amdgcn_s_sleep(1);
        if ((++sp & 255u) == 0u) { if (xb_ld(&bar[XB_TMO])) break; if (sp > XB_SPIN_CAP) { atomicAdd(&bar[XB_TMO], 1u); break; } }
    }
    nloc = mine > 0u ? mine : 1u; nx = cnt > 0u ? cnt : 1u;
}

__device__ __forceinline__ void xcd_barrier(const XcdBarrier& b) {
    asm volatile("s_waitcnt vmcnt(0)" ::: "memory");
    __syncthreads();
    if (threadIdx.x == 0) {
        unsigned* bar = b.bar;
        __builtin_amdgcn_s_waitcnt(0);
        unsigned nloc = b.st[0], nx = b.st[1];
        if (nloc == 0u) { xcd_barrier_complete(bar, b.x, nloc, nx); b.st[0] = nloc; b.st[1] = nx; }
        const unsigned old = xb_add(&bar[XB_XSUB(b.x)], 1u);
        const unsigned gen = old / nloc;
        if (old + 1u == (gen + 1u) * nloc) {
            __builtin_amdgcn_fence(__ATOMIC_RELEASE, "agent");
            asm volatile("s_waitcnt vmcnt(0)" ::: "memory");
            const unsigned og = xb_add(&bar[XB_TOP], 1u);
            const unsigned tg = og / nx;
            if (og + 1u == (tg + 1u) * nx) xb_add(&bar[XB_TOPGEN], 1u);
            else XB_SPIN(xb_ld(&bar[XB_TOPGEN]) == tg, bar);
            __builtin_amdgcn_fence(__ATOMIC_ACQUIRE, "agent");
            xb_add(&bar[XB_XGEN(b.x)], 1u);
            asm volatile("s_waitcnt vmcnt(0)" ::: "memory");
        } else {
            XB_SPIN(xb_ld(&bar[XB_XGEN(b.x)]) == gen, bar);
            __builtin_amdgcn_fence(__ATOMIC_ACQUIRE, "agent");
            asm volatile("s_waitcnt vmcnt(0)" ::: "memory");
        }
    }
    __syncthreads();
}

struct Frame {
    LAS unsigned char* lds; int tid, lane, wave, G, bid;
    const float *x, *c, *w_ada, *b_ada, *norm1_g, *w_in, *b_fgate, *fox_q_g, *fox_k_g, *moba_q_g, *moba_k_g, *w_up_fox, *w_up_moba, *w_out, *norm2_g, *w_peer_q, *sub_keys, *peer_u, *peer_v;
    float* out; unsigned char* ws;
};

__device__ __forceinline__ void tr_item(const float* W, int ldw, int col0, int k0, bf16* WT, int ldt, int row0, LAS float* scr, int lane) {
#pragma unroll 8
    for (int i = 0; i < 32; ++i) { const int kk = 2 * i + (lane >> 5); scr[kk * 33 + (lane & 31)] = W[(size_t)(k0 + kk) * ldw + col0 + (lane & 31)]; }
    LDS_WAIT(); asm volatile("" ::: "memory");
    const int c = lane & 7;
#pragma unroll
    for (int j = 0; j < 4; ++j) { const int n = (lane >> 3) + 8 * j; const LAS float* s = scr + (8 * c) * 33 + n;
        v4u o; o.x = pk2(s[0 * 33], s[1 * 33]); o.y = pk2(s[2 * 33], s[3 * 33]); o.z = pk2(s[4 * 33], s[5 * 33]); o.w = pk2(s[6 * 33], s[7 * 33]);
        *(GAS v4u*)(WT + (size_t)(row0 + n) * ldt + k0 + 8 * c) = o; }
    LDS_WAIT(); asm volatile("" ::: "memory");
}

__device__ __forceinline__ void p0_prep(Frame& F) {
    const int tid = F.tid, lane = F.lane, wave = F.wave, G = F.G;
    float* mod = (float*)(F.ws + WS_MOD);
    {
        LAS float* Kt = (LAS float*)F.lds; LAS float* Wt = Kt + 128 * 128;
        bf16* WeffT = (bf16*)(F.ws + WS_WEFF);
        for (int it = F.bid; it < 256; it += G) {
            const int hp = it >> 4, d0 = (it & 15) * 64;
            const float* keys = F.sub_keys + (size_t)hp * 128 * 128;
#pragma unroll
            for (int i = 0; i < 8; ++i) { const int idx = (i * 512 + tid) * 4, n = idx >> 7, cc = idx & 127; const f32x4 v = *(const f32x4*)(keys + idx);
                Kt[(cc + 0) * 128 + n] = v[0]; Kt[(cc + 1) * 128 + n] = v[1]; Kt[(cc + 2) * 128 + n] = v[2]; Kt[(cc + 3) * 128 + n] = v[3]; }
#pragma unroll
            for (int i = 0; i < 4; ++i) { const int idx = (i * 512 + tid) * 4, dd = idx >> 7, cc = idx & 127; const f32x4 v = *(const f32x4*)(F.w_peer_q + (size_t)(d0 + dd) * 2048 + hp * 128 + cc);
                Wt[(cc + 0) * 64 + dd] = v[0]; Wt[(cc + 1) * 64 + dd] = v[1]; Wt[(cc + 2) * 64 + dd] = v[2]; Wt[(cc + 3) * 64 + dd] = v[3]; }
            __syncthreads();
            const int tn = tid & 31, td = tid >> 5;
            float acc[4][4];
#pragma unroll
            for (int i = 0; i < 4; ++i)
#pragma unroll
                for (int j = 0; j < 4; ++j) acc[i][j] = 0.f;
            for (int cc = 0; cc < 128; ++cc) { const f32x4 kv = *(const LAS f32x4*)(Kt + cc * 128 + 4 * tn), wv = *(const LAS f32x4*)(Wt + cc * 64 + 4 * td);
#pragma unroll
                for (int i = 0; i < 4; ++i)
#pragma unroll
                    for (int j = 0; j < 4; ++j) acc[i][j] += kv[i] * wv[j]; }
#pragma unroll
            for (int i = 0; i < 4; ++i) { v2u o; o.x = pk2(acc[i][0], acc[i][1]); o.y = pk2(acc[i][2], acc[i][3]); *(GAS v2u*)(WeffT + (size_t)(hp * 128 + 4 * tn + i) * 1024 + d0 + 4 * td) = o; }
            __syncthreads();
        }
    }
    {
        LAS float* sc = (LAS float*)F.lds; LAS float* red = sc + 8192;
        for (int it = F.bid; it < 192; it += G) {
            for (int i = tid; i < 8192; i += 512) { const int bb = i >> 10, k = i & 1023; const float v = F.c[i]; sc[k * 8 + bb] = v / (1.0f + expf(-v)); }
            __syncthreads();
            const int n = it * 32 + (lane & 31), kpar = lane >> 5; float a[8];
#pragma unroll
            for (int bb = 0; bb < 8; ++bb) a[bb] = 0.f;
            for (int k0 = wave * 128; k0 < wave * 128 + 128; k0 += 32) {
                float w[16];
#pragma unroll
                for (int j = 0; j < 16; ++j) w[j] = F.w_ada[(size_t)(k0 + 2 * j + kpar) * 6144 + n];
#pragma unroll
                for (int j = 0; j < 16; ++j) { const int k = k0 + 2 * j + kpar; const f32x4 s0 = *(const LAS f32x4*)(sc + k * 8), s1 = *(const LAS f32x4*)(sc + k * 8 + 4);
                    a[0] += w[j] * s0[0]; a[1] += w[j] * s0[1]; a[2] += w[j] * s0[2]; a[3] += w[j] * s0[3]; a[4] += w[j] * s1[0]; a[5] += w[j] * s1[1]; a[6] += w[j] * s1[2]; a[7] += w[j] * s1[3]; }
            }
#pragma unroll
            for (int bb = 0; bb < 8; ++bb) red[((wave * 2 + kpar) * 8 + bb) * 32 + (lane & 31)] = a[bb];
            __syncthreads();
            if (tid < 256) { const int bb = tid >> 5, cc = tid & 31; float s = 0.f;
#pragma unroll
              for (int w = 0; w < 16; ++w) s += red[(w * 8 + bb) * 32 + cc];
              mod[bb * 6144 + it * 32 + cc] = s + F.b_ada[it * 32 + cc]; }
            __syncthreads();
        }
    }
    {
        LAS float* scr = (LAS float*)(F.lds + wave * 16384);
        const int gw = F.bid * NWAVES + wave, NGW = G * NWAVES;
        constexpr int I_IN = 16 * 160, I_UP = 8 * 32, I_OUT = 16 * 32;
        for (int it = gw; it < I_IN + 2 * I_UP + I_OUT; it += NGW) {
            int r = it;
            if (r < I_IN) { const int kb = r / 160, rb = r % 160, tile = rb >> 3, bj = (rb >> 2) & 1, wc = rb & 3; const int Lg = tile * 256 + 64 * wc + 32 * bj; const int src = Lg < 1536 ? Lg : Lg + 8;
                tr_item(F.w_in, IN_COLS, src, kb * 64, (bf16*)(F.ws + WS_WIN), 1024, rb * 32, scr, lane); continue; }
            r -= I_IN;
            if (r < I_UP) { tr_item(F.w_up_fox, 1024, (r & 31) * 32, (r >> 5) * 64, (bf16*)(F.ws + WS_WFT), 512, (r & 31) * 32, scr, lane); continue; }
            r -= I_UP;
            if (r < I_UP) { tr_item(F.w_up_moba, 1024, (r & 31) * 32, (r >> 5) * 64, (bf16*)(F.ws + WS_WMT), 512, (r & 31) * 32, scr, lane); continue; }
            r -= I_UP;
            tr_item(F.w_out, 1024, (r & 31) * 32, (r >> 5) * 64, (bf16*)(F.ws + WS_WOT), 1024, (r & 31) * 32, scr, lane);
        }
    }
    {
        const size_t gt = (size_t)F.bid * 512 + tid, NT_ = (size_t)G * 512;
        float* wfg = (float*)(F.ws + WS_WFG);
        for (size_t i = gt; i < 8192; i += NT_) { const int j = (int)(i >> 10), k = (int)(i & 1023); wfg[i] = F.w_in[(size_t)k * IN_COLS + 1536 + j]; }
        if (gt < 64) { float* gn = (float*)(F.ws + WS_GAINS); gn[gt] = F.fox_q_g[gt]; gn[64 + gt] = F.fox_k_g[gt]; gn[128 + gt] = F.moba_q_g[gt]; gn[192 + gt] = F.moba_k_g[gt]; }
    }
    {
        const int gw = F.bid * NWAVES + wave, NGW = G * NWAVES;
        for (int r4 = gw; r4 < 2 * NEXP / 4; r4 += NGW) {
            const int r = r4 * 4; const bool isu = r < NEXP; const int rr = isu ? r : r - NEXP;
            const GAS f32x4* src = (const GAS f32x4*)((isu ? F.peer_u : F.peer_v) + (size_t)rr * 1024) + lane;
            f32x4 v[4][4]; float mx[4];
#pragma unroll
            for (int q = 0; q < 4; ++q)
#pragma unroll
                for (int j = 0; j < 4; ++j) v[q][j] = src[q * 256 + 64 * j];
#pragma unroll
            for (int q = 0; q < 4; ++q) { mx[q] = 0.f;
#pragma unroll
                for (int j = 0; j < 4; ++j) mx[q] = fmaxf(mx[q], fmaxf(fmaxf(fabsf(v[q][j][0]), fabsf(v[q][j][1])), fmaxf(fabsf(v[q][j][2]), fabsf(v[q][j][3])))); }
#pragma unroll
            for (int o = 1; o < 64; o <<= 1) {
#pragma unroll
                for (int q = 0; q < 4; ++q) mx[q] = fmaxf(mx[q], __shfl_xor(mx[q], o)); }
#pragma unroll
            for (int q = 0; q < 4; ++q) {
                const float sc = mx[q] > 0.f ? mx[q] * (1.0f / 384.0f) : 1.0f, inv = 1.0f / sc;
                GAS unsigned char* dstb = (GAS unsigned char*)(F.ws + (isu ? WS_U8 : WS_V8)) + (size_t)(rr + q) * 128 + 4 * (lane & 31);
#pragma unroll
                for (int j = 0; j < 4; ++j) { int w = 0; w = __builtin_amdgcn_cvt_pk_fp8_f32(v[q][j][0] * inv, v[q][j][1] * inv, w, false); w = __builtin_amdgcn_cvt_pk_fp8_f32(v[q][j][2] * inv, v[q][j][3] * inv, w, true);
                    *(GAS unsigned*)(dstb + (size_t)(2 * j + (lane >> 5)) * ((size_t)NEXP * 128)) = (unsigned)w; }
                if (lane == 0) ((float*)(F.ws + (isu ? WS_SU : WS_SV)))[rr + q] = sc;
            }
        }
    }
}

template <int SECOND>
__device__ __forceinline__ void rows_phase(Frame& F) {
    const int tid = F.tid, lane = F.lane, wave = F.wave;
    LAS float* Ac = (LAS float*)F.lds; LAS float* Bc = Ac + 1024; LAS float* wfs = Bc + 1024;
    const float* mod = (const float*)(F.ws + WS_MOD);
    const float* src = SECOND ? F.out : F.x;
    const float* gain = SECOND ? F.norm2_g : F.norm1_g;
    bf16* dst = (bf16*)(F.ws + WS_HY);
    if (!SECOND) { const float* wfg = (const float*)(F.ws + WS_WFG); for (int i = tid; i < 8192; i += 512) wfs[i] = wfg[i]; }
    for (int it = F.bid; it < 256; it += F.G) {
        const int b = it >> 5;
        const float* shift = mod + (size_t)b * 6144 + (SECOND ? 3072 : 0); const float* scale = shift + 1024;
        __syncthreads();
        for (int i = tid; i < 1024; i += 512) { Ac[i] = gain[i] * (1.0f + scale[i]); Bc[i] = shift[i]; }
        __syncthreads();
        for (int i = 0; i < 8; ++i) {
            const int row = it * 64 + wave * 8 + i;
            const GAS f32x4* xr = (const GAS f32x4*)(src + (size_t)row * 1024) + lane;
            f32x4 v[4]; float ss = 0.f;
#pragma unroll
            for (int j = 0; j < 4; ++j) { v[j] = xr[64 * j]; ss += (v[j][0] * v[j][0] + v[j][1] * v[j][1]) + (v[j][2] * v[j][2] + v[j][3] * v[j][3]); }
            float rstd;
            if (SECOND) { const float* pp = (const float*)(F.ws + WS_PARTS) + (size_t)row * 16; float s = 0.f;
#pragma unroll
                for (int q = 0; q < 16; ++q) s += pp[q];
                rstd = rsqrtf(s * (1.0f / 1024.0f) + RMS_EPS); }
            else rstd = rsqrtf(wave_sum(ss) * (1.0f / 1024.0f) + RMS_EPS);
            float p[8];
#pragma unroll
            for (int q = 0; q < 8; ++q) p[q] = 0.f;
            GAS v2u* o8 = (GAS v2u*)(dst + (size_t)row * 1024) + lane;
#pragma unroll
            for (int j = 0; j < 4; ++j) {
                const int col = 4 * (64 * j + lane);
                const f32x4 a = *(const LAS f32x4*)(Ac + col), bb = *(const LAS f32x4*)(Bc + col);
                const f32x4 hv = v[j] * rstd * a + bb;
                v2u o; o.x = pk2(hv[0], hv[1]); o.y = pk2(hv[2], hv[3]); o8[64 * j] = o;
                if (!SECOND) {
#pragma unroll
                    for (int q = 0; q < 8; ++q) { const f32x4 w = *(const LAS f32x4*)(wfs + q * 1024 + col); p[q] += (hv[0] * w[0] + hv[1] * w[1]) + (hv[2] * w[2] + hv[3] * w[3]); }
                }
            }
            if (!SECOND) {
                float mine = 0.f;
#pragma unroll
                for (int q = 0; q < 8; ++q) { const float s = wave_sum(p[q]); mine = (lane == q) ? s : mine; }
                if (lane < 8) { const float z = mine + F.b_fgate[lane]; const float ls = fminf(z, 0.f) - log1pf(expf(-fabsf(z))); ((float*)(F.ws + WS_LF))[(size_t)row * 8 + lane] = ls; }
            }
        }
    }
    __syncthreads();
}

__device__ __forceinline__ void fcum_items(Frame& F) {
    LAS float* wtot = (LAS float*)F.lds;
    const float* LFp = (const float*)(F.ws + WS_LF); float* Fc = (float*)(F.ws + WS_FC);
    for (int it = F.bid; it < 64; it += F.G) {
        const int b = it >> 3, h = it & 7, s0 = 4 * F.tid;
        float v[4];
#pragma unroll
        for (int i = 0; i < 4; ++i) v[i] = LFp[((size_t)b * SEQ + s0 + i) * 8 + h];
        v[1] += v[0]; v[2] += v[1]; v[3] += v[2];
        float inc = v[3];
#pragma unroll
        for (int o = 1; o < 64; o <<= 1) { const float t = __shfl_up(inc, o); if (F.lane >= o) inc += t; }
        __syncthreads();
        if (F.lane == 63) wtot[F.wave] = inc;
        __syncthreads();
        float base = inc - v[3];
        for (int w = 0; w < F.wave; ++w) base += wtot[w];
        float* o = Fc + (size_t)(b * NHEAD + h) * SEQ + s0;
#pragma unroll
        for (int i = 0; i < 4; ++i) o[i] = base + v[i];
    }
    __syncthreads();
}

__device__ __forceinline__ unsigned okey(float f) { const unsigned u = __float_as_uint(f); return (u & 0x80000000u) ? ~u : (u | 0x80000000u); }
__device__ __forceinline__ float okey_inv(unsigned k) { return __uint_as_float((k & 0x80000000u) ? (k ^ 0x80000000u) : ~k); }
__device__ __forceinline__ void chain16(unsigned (&L)[16], unsigned x) {
#pragma unroll
    for (int k = 0; k < 16; ++k) { const unsigned hi = L[k] > x ? L[k] : x; x = L[k] > x ? x : L[k]; L[k] = hi; }
}
__device__ __forceinline__ void cmpex_desc(unsigned& a, unsigned& b) { const unsigned hi = a > b ? a : b, lo = a > b ? b : a; a = hi; b = lo; }
__device__ __forceinline__ void bitonic_merge16(unsigned (&a)[16]) {
#pragma unroll
    for (int j = 8; j > 0; j >>= 1)
#pragma unroll
        for (int i = 0; i < 16; ++i) { const int l = i ^ j; if (l > i) cmpex_desc(a[i], a[l]); }
}
__device__ __forceinline__ void sort16_desc(unsigned (&a)[16]) {
#pragma unroll
    for (int k = 2; k <= 16; k <<= 1)
#pragma unroll
        for (int j = k >> 1; j > 0; j >>= 1)
#pragma unroll
            for (int i = 0; i < 16; ++i) { const int l = i ^ j; if (l > i) { if ((i & k) == 0 || k == 16) cmpex_desc(a[i], a[l]); else cmpex_desc(a[l], a[i]); } }
}
__device__ __forceinline__ void merge_top16(unsigned (&T)[16], const unsigned (&B)[16]) {
#pragma unroll
    for (int i = 0; i < 16; ++i) T[i] = T[i] > B[15 - i] ? T[i] : B[15 - i];
    bitonic_merge16(T);
}
__device__ __forceinline__ void top16_of_128(const float* p, unsigned (&L)[16]) {
#pragma unroll
    for (int c = 0; c < 8; ++c) {
        f32x4 v[4];
#pragma unroll
        for (int j = 0; j < 4; ++j) v[j] = *(const f32x4*)(p + c * 16 + j * 4);
        unsigned B[16];
#pragma unroll
        for (int j = 0; j < 4; ++j)
#pragma unroll
            for (int e = 0; e < 4; ++e) B[4 * j + e] = (okey(v[j][e]) & ~127u) | (unsigned)(127 - (c * 16 + j * 4 + e));
        sort16_desc(B);
        if (c == 0) {
#pragma unroll
            for (int k = 0; k < 16; ++k) L[k] = B[k];
        } else merge_top16(L, B);
    }
}
__device__ __forceinline__ void topk_phase(Frame& F) {
    const float* SC = (const float*)(F.ws + WS_SC); unsigned* EG = (unsigned*)(F.ws + WS_EG);
    LAS unsigned char* tab = F.lds + F.tid * 32;
    for (int th = F.bid * 512 + F.tid; th < NTOK * 8; th += F.G * 512) {
        const float* p = SC + (size_t)th * 256;
        unsigned L1[16], L2[16];
        top16_of_128(p, L1); top16_of_128(p + 128, L2);
        float v1[16], v2[16];
#pragma unroll
        for (int k = 0; k < 16; ++k) { v1[k] = okey_inv(L1[k] & ~127u); tab[k] = (unsigned char)(127u - (L1[k] & 127u)); v2[k] = okey_inv(L2[k] & ~127u); tab[16 + k] = (unsigned char)(127u - (L2[k] & 127u)); }
        unsigned C[16];
#pragma unroll
        for (int j = 0; j < 16; ++j) C[j] = (okey(v1[0] + v2[j]) & ~255u) | (unsigned)(255 - j);
#pragma unroll
        for (int i = 1; i < 16; ++i)
#pragma unroll
            for (int j = 0; j < 16 / (i + 1); ++j) chain16(C, (okey(v1[i] + v2[j]) & ~255u) | (unsigned)(255 - (i * 16 + j)));
        float sv[16]; float sum = 0.f; const float mx = okey_inv(C[0] & ~255u);
#pragma unroll
        for (int k = 0; k < 16; ++k) { sv[k] = expf(okey_inv(C[k] & ~255u) - mx); sum += sv[k]; }
        const float rs = 1.0f / sum;
        unsigned o[16];
#pragma unroll
        for (int k = 0; k < 16; ++k) { const int pos = 255 - (int)(C[k] & 255u); const unsigned eid = (unsigned)tab[pos >> 4] * 128u + (unsigned)tab[16 + (pos & 15)];
            const _Float16 hg = (_Float16)(sv[k] * rs); o[k] = ((unsigned)__builtin_bit_cast(unsigned short, hg) << 16) | eid; }
        GAS v4u* dst = (GAS v4u*)(EG + (size_t)th * 16);
#pragma unroll
        for (int q = 0; q < 4; ++q) dst[q] = (v4u){o[4 * q], o[4 * q + 1], o[4 * q + 2], o[4 * q + 3]};
    }
}

typedef float f32x2v __attribute__((ext_vector_type(2)));
__device__ __forceinline__ float gelu_tanh(float a) { const float y = 0.7978845608028654f * (a + 0.044715f * a * a * a); const float th = 1.0f - 2.0f / (__expf(2.0f * y) + 1.0f); return 0.5f * a * (1.0f + th); }
__device__ __forceinline__ void fp8x16_to_f32(const v4u r, float (&f)[16]) {
#pragma unroll
    for (int q = 0; q < 4; ++q) { const f32x2v lo = __builtin_amdgcn_cvt_pk_f32_fp8((int)r[q], false), hi = __builtin_amdgcn_cvt_pk_f32_fp8((int)r[q], true); f[4 * q] = lo[0]; f[4 * q + 1] = lo[1]; f[4 * q + 2] = hi[0]; f[4 * q + 3] = hi[1]; }
}
template <bool VSIDE>
__device__ __forceinline__ void peer_gather(Frame& F, bool dry) {
    const int lane = F.lane, wave = F.wave, g = lane >> 3, ch = lane & 7;
    const bool sliced = (F.G % 8) == 0;
    const int x_lo = sliced ? (F.bid & 7) : 0, x_hi = sliced ? x_lo + 1 : 8;
    const int wv = sliced ? (F.bid >> 3) * NWAVES + wave : F.bid * NWAVES + wave, NW = sliced ? (F.G >> 3) * NWAVES : F.G * NWAVES;
    const unsigned* EG = (const unsigned*)(F.ws + WS_EG); const bf16* H2 = (const bf16*)(F.ws + WS_HY); const float* Wt = (const float*)(F.ws + WS_WT);
    const unsigned char* TB = F.ws + (VSIDE ? WS_V8 : WS_U8); float* Pp = (float*)(F.ws + WS_PP); const float* mod = (const float*)(F.ws + WS_MOD);
    const bool c0 = VSIDE ? (lane & 8) != 0 : (lane & 1) != 0, c1 = VSIDE ? (lane & 16) != 0 : (lane & 2) != 0, c2 = VSIDE ? (lane & 32) != 0 : (lane & 4) != 0;
    constexpr int X0 = VSIDE ? 8 : 1, X1 = VSIDE ? 16 : 2, X2 = VSIDE ? 32 : 4;
    for (int x = x_lo; x < x_hi; ++x) {
        const unsigned char* tb = TB + (size_t)x * ((size_t)NEXP * 128) + 16 * ch;
#define PG_TOK(tt) ((tt) < NTOK ? (tt) : NTOK - 1)
#define PG_LOAD_EG(tt) do { const unsigned* ep_ = EG + (size_t)PG_TOK(tt) * 128 + 16 * g; _Pragma("unroll") for (int q_ = 0; q_ < 4; ++q_) eg[q_] = *(const GAS v4u*)(ep_ + 4 * q_); } while (0)
#define PG_LOAD_AUX(tt, AUX) do { if (VSIDE) { const float* wp_ = Wt + (size_t)PG_TOK(tt) * 128 + 16 * g; _Pragma("unroll") for (int q_ = 0; q_ < 4; ++q_) AUX[q_] = *(const GAS v4u*)(wp_ + 4 * q_); } \
        else { const bf16* hp_ = H2 + (size_t)PG_TOK(tt) * 1024 + 128 * x + 16 * ch; AUX[0] = *(const GAS v4u*)hp_; AUX[1] = *(const GAS v4u*)(hp_ + 8); } } while (0)
#define PG_ROWS8(R, EGV, H) do { _Pragma("unroll") for (int i_ = 0; i_ < 8; ++i_) { const unsigned e_ = EGV[2 * (H) + (i_ >> 2)][i_ & 3] & 0xffffu; R[i_] = *(const GAS v4u*)(tb + (size_t)e_ * 128); } } while (0)
        v4u eg[4], egC[4], auxC[4], auxN[4], rLo[8], rHi[8];
        float v16[16], hf[16];
        auto half = [&](const v4u (&R)[8], const int H) {
#pragma unroll
            for (int i = 0; i < 8; ++i) { float f[16]; fp8x16_to_f32(R[i], f);
                if (VSIDE) { const float w = __uint_as_float(auxC[2 * H + (i >> 2)][i & 3]);
#pragma unroll
                    for (int c = 0; c < 16; ++c) v16[c] += w * f[c];
                    asm volatile("" : "+v"(v16[0]), "+v"(v16[1]), "+v"(v16[2]), "+v"(v16[3]), "+v"(v16[4]), "+v"(v16[5]), "+v"(v16[6]), "+v"(v16[7]),
                                      "+v"(v16[8]), "+v"(v16[9]), "+v"(v16[10]), "+v"(v16[11]), "+v"(v16[12]), "+v"(v16[13]), "+v"(v16[14]), "+v"(v16[15])); }
                else { float a0 = 0.f, a1 = 0.f;
#pragma unroll
                    for (int c = 0; c < 16; c += 2) { a0 += f[c] * hf[c]; a1 += f[c + 1] * hf[c + 1]; }
                    v16[8 * H + i] = a0 + a1; asm volatile("" : "+v"(v16[8 * H + i])); }
                __builtin_amdgcn_sched_barrier(0); }
        };
        auto finish = [&](int tt) {
            float r8[8], r4[4], r2[2];
#pragma unroll
            for (int c = 0; c < 8; ++c) { const float keep = c0 ? v16[8 + c] : v16[c], send = c0 ? v16[c] : v16[8 + c]; r8[c] = keep + __shfl_xor(send, X0); }
#pragma unroll
            for (int c = 0; c < 4; ++c) { const float keep = c1 ? r8[4 + c] : r8[c], send = c1 ? r8[c] : r8[4 + c]; r4[c] = keep + __shfl_xor(send, X1); }
#pragma unroll
            for (int c = 0; c < 2; ++c) { const float keep = c2 ? r4[2 + c] : r4[c], send = c2 ? r4[c] : r4[2 + c]; r2[c] = keep + __shfl_xor(send, X2); }
            const int sub = (c0 ? 8 : 0) + (c1 ? 4 : 0) + (c2 ? 2 : 0);
            if (tt < NTOK) {
                if (VSIDE) {
                    const int col = 128 * x + 16 * ch + sub; const int b = tt >> 11; const float* g2 = mod + (size_t)b * 6144 + 5120;
                    float* orow = F.out + (size_t)tt * 1024;
                    const f32x2v xv = *(const GAS f32x2v*)(orow + col), gvv = *(const GAS f32x2v*)(g2 + col);
                    f32x2v o; o[0] = xv[0] + gvv[0] * r2[0]; o[1] = xv[1] + gvv[1] * r2[1];
                    *(GAS f32x2v*)((dry ? (float*)(F.ws + WS_SC) + (size_t)tt * 1024 : orow) + col) = o;
                } else {
                    *(GAS f32x2v*)(Pp + ((size_t)x * NTOK + tt) * 128 + 16 * g + sub) = (f32x2v){r2[0], r2[1]};
                }
            }
        };
        int t = wv;
        PG_LOAD_EG(t); PG_LOAD_AUX(t, auxC);
#pragma unroll
        for (int q = 0; q < 4; ++q) egC[q] = eg[q];
        PG_ROWS8(rLo, egC, 0);
        PG_LOAD_EG(t + NW); PG_LOAD_AUX(t + NW, auxN);
        for (; t < NTOK; t += NW) {
            PG_ROWS8(rHi, egC, 1);
            if (VSIDE) {
#pragma unroll
                for (int c = 0; c < 16; ++c) v16[c] = 0.f;
            } else {
#pragma unroll
                for (int q = 0; q < 4; ++q) { hf[2 * q] = pg8::bf_lo(auxC[0][q]); hf[2 * q + 1] = pg8::bf_hi(auxC[0][q]); hf[8 + 2 * q] = pg8::bf_lo(auxC[1][q]); hf[8 + 2 * q + 1] = pg8::bf_hi(auxC[1][q]); }
            }
            half(rLo, 0);
            PG_ROWS8(rLo, eg, 0);
            half(rHi, 1);
            finish(t);
#pragma unroll
            for (int q = 0; q < 4; ++q) { egC[q] = eg[q]; auxC[q] = auxN[q]; }
            PG_LOAD_EG(t + 2 * NW); PG_LOAD_AUX(t + 2 * NW, auxN);
        }
#undef PG_TOK
#undef PG_LOAD_EG
#undef PG_LOAD_AUX
#undef PG_ROWS8
    }
}
__device__ __forceinline__ void peer_w_phase(Frame& F) {
    const unsigned* EG = (const unsigned*)(F.ws + WS_EG); const float* Pp = (const float*)(F.ws + WS_PP);
    const float* SU = (const float*)(F.ws + WS_SU); const float* SV = (const float*)(F.ws + WS_SV); float* Wt = (float*)(F.ws + WS_WT);
    for (size_t i = (size_t)F.bid * 512 + F.tid; i < (size_t)NTOK * 128; i += (size_t)F.G * 512) {
        float a = 0.f;
#pragma unroll
        for (int x = 0; x < 8; ++x) a += Pp[(size_t)x * NTOK * 128 + i];
        const unsigned egv = EG[i]; const unsigned e = egv & 0xffffu;
        Wt[i] = (float)__builtin_bit_cast(_Float16, (unsigned short)(egv >> 16)) * gelu_tanh(a * SU[e]) * SV[e];
    }
}

constexpr int N_PHASES = 12;
struct Args { const float* in[19]; float* out; unsigned char* ws; int ph_lo, ph_hi; };
__global__ void __launch_bounds__(NWAVES * 64, 2) fwd_kernel(Args args) {
    extern __shared__ __attribute__((aligned(16))) unsigned char lds_raw[];
    Frame F;
    F.lds = (LAS unsigned char*)lds_raw;
    F.tid = threadIdx.x; F.lane = F.tid & 63; F.wave = __builtin_amdgcn_readfirstlane(F.tid >> 6); F.G = gridDim.x; F.bid = blockIdx.x;
    F.x = args.in[0]; F.c = args.in[1]; F.w_ada = args.in[2]; F.b_ada = args.in[3]; F.norm1_g = args.in[4]; F.w_in = args.in[5]; F.b_fgate = args.in[6];
    F.fox_q_g = args.in[7]; F.fox_k_g = args.in[8]; F.moba_q_g = args.in[9]; F.moba_k_g = args.in[10]; F.w_up_fox = args.in[11]; F.w_up_moba = args.in[12];
    F.w_out = args.in[13]; F.norm2_g = args.in[14]; F.w_peer_q = args.in[15]; F.sub_keys = args.in[16]; F.peer_u = args.in[17]; F.peer_v = args.in[18];
    F.out = args.out; F.ws = args.ws;
    unsigned char* ws = args.ws;
    volatile LAS unsigned* MISC = (volatile LAS unsigned*)(F.lds + MISC_OFF);
    for (int u = F.tid; u < (LDS_BYTES - LDSCTL_OFF) / 4; u += NWAVES * 64) ((LAS unsigned*)(F.lds + LDSCTL_OFF))[u] = 0u;
    __syncthreads();
#if !MK_PER_PHASE
    XcdBarrier bar = xcd_barrier_post((unsigned*)(ws + WS_CTL) + CW_BAR, MISC + 8);
#define GRID_BAR() xcd_barrier(bar)
#else
    (void)MISC;
#define GRID_BAR() do {} while (0)
#endif
    const int lo = args.ph_lo, hi = args.ph_hi;
#define IN(k) (lo <= (k) && (k) < hi)
#define REPS(k) (((k) == DUP_PHASE) ? DUP_N : 1)
#define REP(k) for (int rep_ = 0; rep_ < REPS(k); ++rep_)
#define REPBAR(k) do { if (rep_ + 1 < REPS(k)) GRID_BAR(); } while (0)
#define SEAM(k) do { if (IN(k) && IN((k) + 1)) GRID_BAR(); } while (0)
    typedef pg8::bf16_t pb;

    if (IN(0)) REP(0) { p0_prep(F); REPBAR(0); } SEAM(0);
    if (IN(1)) REP(1) { rows_phase<0>(F); REPBAR(1); } SEAM(1);
    if (IN(2)) REP(2) {
        fcum_items(F);
        pg8::Gemm g{(const pb*)(ws + WS_HY), (const pb*)(ws + WS_WIN), NTOK, NIN, DM, DM, DM}; pg8::StaticOrder S; S.init(NTOK, NIN, F.G, F.bid);
        pg8::EpiIn E{(pb*)(ws + WS_QKV), (pb*)F.out, (const float*)(ws + WS_GAINS), (float*)(ws + ((rep_ + 1 < REPS(2)) ? WS_EG : WS_KMEAN))};
        pg8::gemm_phase<pg8::EpiIn, pg8::StaticOrder, true, true>(F.lds, g, S, E);
        REPBAR(2);
    } SEAM(2);
    if (IN(3)) REP(3) {
        const pb* qkv = (const pb*)(ws + WS_QKV); constexpr size_t TS = (size_t)NTOK * 512;
        for (int it = F.bid; it < 256; it += F.G) {
            const int bh = it >> 2, s = it & 3, b = bh >> 3, h = bh & 7;
            att::attn_unit<0>(b, h, 7 - s, qkv, qkv + TS, qkv + 2 * TS, (const float*)(ws + WS_FC), nullptr, (pb*)(ws + WS_HY), (__attribute__((address_space(3))) char*)F.lds);
            att::attn_unit<1>(b, h, 7 - s, qkv + 3 * TS, qkv + 4 * TS, qkv + 5 * TS, nullptr, (const float*)(ws + WS_KMEAN), (pb*)(ws + WS_HY), (__attribute__((address_space(3))) char*)F.lds);
            att::attn_unit<0>(b, h, s, qkv, qkv + TS, qkv + 2 * TS, (const float*)(ws + WS_FC), nullptr, (pb*)(ws + WS_HY), (__attribute__((address_space(3))) char*)F.lds);
            att::attn_unit<1>(b, h, s, qkv + 3 * TS, qkv + 4 * TS, qkv + 5 * TS, nullptr, (const float*)(ws + WS_KMEAN), (pb*)(ws + WS_HY), (__attribute__((address_space(3))) char*)F.lds);
        }
        REPBAR(3);
    } SEAM(3);
    if (IN(4)) {
        pg8::StaticOrder S; S.init(NTOK, DM, F.G, F.bid);
        { pg8::Gemm g{(const pb*)(ws + WS_HY), (const pb*)(ws + WS_WFT), NTOK, DM, 512, DM, 512};
          pg8::EpiUp<0> E{(const pb*)F.out, (pb*)(ws + WS_MIX)}; pg8::gemm_phase<pg8::EpiUp<0>, pg8::StaticOrder, true, true>(F.lds, g, S, E); }
        VM_WAIT(); __syncthreads();
        { pg8::Gemm g{(const pb*)(ws + WS_HY) + 512, (const pb*)(ws + WS_WMT), NTOK, DM, 512, DM, 512};
          pg8::EpiUp<1> E{(const pb*)F.out, (pb*)(ws + WS_MIX)}; pg8::gemm_phase<pg8::EpiUp<1>, pg8::StaticOrder, true, true>(F.lds, g, S, E); }
    } SEAM(4);
    if (IN(5)) {
        pg8::Gemm g{(const pb*)(ws + WS_MIX), (const pb*)(ws + WS_WOT), NTOK, DM, DM, DM, DM}; pg8::StaticOrder S; S.init(NTOK, DM, F.G, F.bid);
        pg8::EpiOut E{F.x, (const float*)(ws + WS_MOD), F.out, (float*)(ws + WS_PARTS)};
        pg8::gemm_phase<pg8::EpiOut, pg8::StaticOrder, true, true>(F.lds, g, S, E);
    } SEAM(5);
    if (IN(6)) { rows_phase<1>(F); } SEAM(6);
    if (IN(7)) REP(7) {
        pg8::Gemm g{(const pb*)(ws + WS_HY), (const pb*)(ws + WS_WEFF), NTOK, NSC, DM, DM, DM}; pg8::StaticOrder S; S.init(NTOK, NSC, F.G, F.bid);
        pg8::EpiSc E{(float*)(ws + WS_SC)};
        pg8::gemm_phase<pg8::EpiSc, pg8::StaticOrder, true, true>(F.lds, g, S, E);
        REPBAR(7);
    } SEAM(7);
    if (IN(8)) REP(8) { topk_phase(F); REPBAR(8); } SEAM(8);
    if (IN(9)) REP(9) { peer_gather<false>(F, false); REPBAR(9); } SEAM(9);
    if (IN(10)) REP(10) { peer_w_phase(F); REPBAR(10); } SEAM(10);
    if (IN(11)) REP(11) { peer_gather<true>(F, rep_ + 1 < REPS(11)); REPBAR(11); }
#undef IN
#undef SEAM
}

extern "C" void kernel_launch(void* const* d_in, const int* in_sizes, int n_in, void* d_out, int out_size, void* d_ws, size_t ws_size, hipStream_t stream) {
    static int grid = 0;
    if (grid == 0) {
        if (n_in != 19 || out_size != NTOK * DM || ws_size < WS_END) { fprintf(stderr, "kernel_launch: unexpected shapes (n_in %d, out %d, ws %zu); nothing launched\n", n_in, out_size, ws_size); grid = -1; return; }
        int dev = 0, cus = 0, per_cu = 0;
        if (hipGetDevice(&dev) != hipSuccess || hipDeviceGetAttribute(&cus, hipDeviceAttributeMultiprocessorCount, dev) != hipSuccess) { grid = -1; return; }
        if (hipFuncSetAttribute((const void*)fwd_kernel, hipFuncAttributeMaxDynamicSharedMemorySize, LDS_BYTES) != hipSuccess) { fprintf(stderr, "kernel_launch: hipFuncSetAttribute failed\n"); grid = -1; return; }
        if (hipOccupancyMaxActiveBlocksPerMultiprocessor(&per_cu, (const void*)fwd_kernel, NWAVES * 64, LDS_BYTES) != hipSuccess || per_cu < 1) { fprintf(stderr, "kernel_launch: occupancy query says %d blocks per CU\n", per_cu); per_cu = 1; }
        (void)hipGetLastError();
        grid = cus;
    }
    if (grid < 0) return;
    (void)hipMemsetAsync((char*)d_ws + WS_CTL, 0, CTL_ZERO_BYTES, stream);
    Args a{};
    for (int i = 0; i < 19; ++i) a.in[i] = (const float*)d_in[i];
    a.out = (float*)d_out; a.ws = (unsigned char*)d_ws;
#if MK_PER_PHASE
    for (int ph = 0; ph < N_PHASES; ++ph) { a.ph_lo = ph; a.ph_hi = ph + 1; hipLaunchKernelGGL(fwd_kernel, dim3(grid), dim3(NWAVES * 64), LDS_BYTES, stream, a); }
#else
    a.ph_lo = 0; a.ph_hi = N_PHASES;
    hipLaunchKernelGGL(fwd_kernel, dim3(grid), dim3(NWAVES * 64), LDS_BYTES, stream, a);
#endif
}
```

```cpp
#include <hip/hip_runtime.h>
#include <hip/hip_bf16.h>
#include <cstdio>
#include <cstdint>
#include <cmath>

#ifndef DUP_PHASE
#define DUP_PHASE -1
#endif
#define DUP_N 2
#ifndef MK_PER_PHASE
#define MK_PER_PHASE 0
#endif

constexpr int NB = 8, SEQ = 2048, DM = 1024, NTOK = NB * SEQ, NHEAD = 8, HDIM = 64;
constexpr int IN_COLS = 5128, NIN = 5120, NSC = 2048, NEXP = 16384;
constexpr float RMS_EPS = 1e-6f;
constexpr float LOG2E = 1.4426950408889634f;
constexpr float QSCALE = 0.125f * LOG2E;

namespace pg8 {
#define PG8_LAS __attribute__((address_space(3)))
typedef unsigned short bf16_t;
typedef short bf16x8 __attribute__((ext_vector_type(8)));
typedef float f32x4 __attribute__((ext_vector_type(4)));
typedef unsigned u32x4 __attribute__((ext_vector_type(4)));
constexpr int BM = 256, BK = 64, HALF = 128, HTB = HALF * BK * 2  , STAGE_BYTES = 8 * HTB, NXCD = 8, WGM = 8;

__host__ __device__ __forceinline__ int lds_byte(int r, int c) { const int st = (r >> 4) * 2 + (c >> 5), rr = r & 15, cc = c & 31, ob = rr * 64 + cc * 2; return st * 1024 + (ob ^ (((ob >> 9) & 1) << 5)); }
__host__ __device__ __forceinline__ void stage_rc(int b, int& R, int& C) { const int st = b / 1024, sb = b % 1024, swz = sb ^ (((sb >> 9) & 1) << 5); R = (st >> 1) * 16 + swz / 64; C = (st & 1) * 32 + (swz % 64) / 2; }
__host__ __device__ __forceinline__ int perm32(int rho) { const int n = rho >> 4, i = rho & 15; return 8 * (i >> 2) + 4 * n + (i & 3); }

struct Unit { int pm, pn; };
struct Gemm { const bf16_t* A; const bf16_t* Bt; int M, N, K, lda, ldb; };

struct StaticOrder {
    int nM, nN, nwg, G, c;
    __host__ __device__ void init(int M, int N, int G_, int c_) { nM = M / BM; nN = N / BM; nwg = nM * nN; G = G_; c = c_; }
    __host__ __device__ bool next(int i, Unit& u) const {
        const long L = (long)i * G + c; if (L >= nwg) return false;
        int wgid = (int)L; { const int q = nwg / NXCD, r = nwg % NXCD, xcd = wgid % NXCD, off = wgid / NXCD; wgid = (xcd < r ? xcd * (q + 1) : r * (q + 1) + (xcd - r) * q) + off; }
        const int nig = WGM * nN, gid = wgid / nig, fm = gid * WGM, gsz = (nM - fm) < WGM ? (nM - fm) : WGM;
        u.pm = fm + ((wgid % nig) % gsz); u.pn = (wgid % nig) / gsz; return true;
    }
    __device__ __forceinline__ void a_ready(const Unit&) const {}
    __device__ __forceinline__ void done(const Unit&) const {}
};

__device__ __forceinline__ unsigned cvt_pk_bf16(float lo, float hi) { unsigned r; asm volatile("v_cvt_pk_bf16_f32 %0, %1, %2" : "=v"(r) : "v"(lo), "v"(hi)); return r; }
__device__ __forceinline__ float bf_lo(unsigned w) { return __uint_as_float(w << 16); }
__device__ __forceinline__ float bf_hi(unsigned w) { return __uint_as_float(w & 0xffff0000u); }
__device__ __forceinline__ float sigmoidf_(float x) { return 1.0f / (1.0f + __expf(-x)); }

struct EpiIn {
    static constexpr bool PERM = true, AFTER_DRAIN = false;
    bf16_t* qkv;
    bf16_t* G;
    const float* gains;
    float* kmean;
    __device__ __forceinline__ void operator()(const f32x4 (&acc)[2][2][4][2], const Unit& u, int wr, int wc, int fr, int fq) const {
        const int pn = u.pn;
        if (pn < 12) {
            const int sec = pn >> 1, head = (pn & 1) * 4 + wc;
            const bool isq = (sec == 0 || sec == 3), isk = (sec == 1 || sec == 4);
            const float* gp = gains + ((sec >= 3 ? sec - 1 : sec) & 3) * 64;
            f32x4 gv[2][2];
#pragma unroll
            for (int bj = 0; bj < 2; ++bj)
#pragma unroll
                for (int n = 0; n < 2; ++n) { gv[bj][n] = (f32x4){1.f, 1.f, 1.f, 1.f}; if (isq || isk) gv[bj][n] = *(const f32x4*)(gp + 32 * bj + 8 * fq + 4 * n) * (isq ? QSCALE : 1.0f); }
            bf16_t* base = qkv + (size_t)sec * ((size_t)NTOK * 512);
            f32x4 cs[2][2];
#pragma unroll
            for (int bj = 0; bj < 2; ++bj)
#pragma unroll
                for (int n = 0; n < 2; ++n) cs[bj][n] = (f32x4){0.f, 0.f, 0.f, 0.f};
#pragma unroll
            for (int ai = 0; ai < 2; ++ai)
#pragma unroll
                for (int m = 0; m < 4; ++m) {
                    const int row = u.pm * BM + ai * HALF + wr * 64 + m * 16 + fr; const int b = row >> 11, s = row & 2047;
                    f32x4 v[2][2];
#pragma unroll
                    for (int bj = 0; bj < 2; ++bj)
#pragma unroll
                        for (int n = 0; n < 2; ++n) v[bj][n] = acc[ai][bj][m][n];
                    if (isq || isk) {
                        float ss = 0.f;
#pragma unroll
                        for (int bj = 0; bj < 2; ++bj)
#pragma unroll
                            for (int n = 0; n < 2; ++n) { const f32x4 x = v[bj][n]; ss += (x[0] * x[0] + x[1] * x[1]) + (x[2] * x[2] + x[3] * x[3]); }
                        ss += __shfl_xor(ss, 16); ss += __shfl_xor(ss, 32);
                        const float rstd = rsqrtf(ss * (1.0f / 64.0f) + RMS_EPS);
#pragma unroll
                        for (int bj = 0; bj < 2; ++bj)
#pragma unroll
                            for (int n = 0; n < 2; ++n) v[bj][n] = v[bj][n] * rstd * gv[bj][n];
                    }
                    if (sec == 4) {
#pragma unroll
                        for (int bj = 0; bj < 2; ++bj)
#pragma unroll
                            for (int n = 0; n < 2; ++n) cs[bj][n] += v[bj][n];
                    }
                    bf16_t* dst = base + ((size_t)(b * NHEAD + head) * SEQ + s) * HDIM + 8 * fq;
#pragma unroll
                    for (int bj = 0; bj < 2; ++bj) { u32x4 w; w.x = cvt_pk_bf16(v[bj][0][0], v[bj][0][1]); w.y = cvt_pk_bf16(v[bj][0][2], v[bj][0][3]); w.z = cvt_pk_bf16(v[bj][1][0], v[bj][1][1]); w.w = cvt_pk_bf16(v[bj][1][2], v[bj][1][3]);
                        *(u32x4*)(dst + 32 * bj) = w; }
                }
            if (sec == 4) {
                const int b = (u.pm * BM) >> 11, blk = u.pm & 7;
                float* km = kmean + ((size_t)(b * NHEAD + head) * 8 + blk) * HDIM + 8 * fq;
#pragma unroll
                for (int bj = 0; bj < 2; ++bj)
#pragma unroll
                    for (int n = 0; n < 2; ++n)
#pragma unroll
                        for (int e = 0; e < 4; ++e) { float x = cs[bj][n][e]; x += __shfl_xor(x, 1); x += __shfl_xor(x, 2); x += __shfl_xor(x, 4); x += __shfl_xor(x, 8);
                            if (fr == 0) atomicAdd(km + 32 * bj + 4 * n + e, x * (1.0f / 256.0f)); }
            }
        } else {
            const int gc0 = (pn - 12) * 256 + 64 * wc + 8 * fq;
#pragma unroll
            for (int ai = 0; ai < 2; ++ai)
#pragma unroll
                for (int m = 0; m < 4; ++m) {
                    const int row = u.pm * BM + ai * HALF + wr * 64 + m * 16 + fr;
                    bf16_t* dst = G + (size_t)row * 2048 + gc0;
#pragma unroll
                    for (int bj = 0; bj < 2; ++bj) { const f32x4 a = acc[ai][bj][m][0], c = acc[ai][bj][m][1]; u32x4 w;
                        w.x = cvt_pk_bf16(sigmoidf_(a[0]), sigmoidf_(a[1])); w.y = cvt_pk_bf16(sigmoidf_(a[2]), sigmoidf_(a[3])); w.z = cvt_pk_bf16(sigmoidf_(c[0]), sigmoidf_(c[1])); w.w = cvt_pk_bf16(sigmoidf_(c[2]), sigmoidf_(c[3]));
                        *(u32x4*)(dst + 32 * bj) = w; }
                }
        }
    }
};

template <int SECOND> struct EpiUp {
    static constexpr bool PERM = true, AFTER_DRAIN = false;
    const bf16_t* G; bf16_t* MIX;
    __device__ __forceinline__ void operator()(const f32x4 (&acc)[2][2][4][2], const Unit& u, int wr, int wc, int fr, int fq) const {
        const int col0 = u.pn * BM + wc * 32 + 8 * fq;
#pragma unroll
        for (int ai = 0; ai < 2; ++ai)
#pragma unroll
            for (int m = 0; m < 4; ++m) {
                const int row = u.pm * BM + ai * HALF + wr * 64 + m * 16 + fr;
#pragma unroll
                for (int bj = 0; bj < 2; ++bj) {
                    const int col = col0 + bj * HALF;
                    const u32x4 g = *(const u32x4*)(G + (size_t)row * 2048 + SECOND * 1024 + col);
                    const f32x4 a = acc[ai][bj][m][0], c = acc[ai][bj][m][1];
                    float v[8] = {a[0] * bf_lo(g.x), a[1] * bf_hi(g.x), a[2] * bf_lo(g.y), a[3] * bf_hi(g.y), c[0] * bf_lo(g.z), c[1] * bf_hi(g.z), c[2] * bf_lo(g.w), c[3] * bf_hi(g.w)};
                    bf16_t* p = MIX + (size_t)row * 1024 + col;
                    if (SECOND) { const u32x4 o = __builtin_nontemporal_load((const u32x4*)p);
                        v[0] += bf_lo(o.x); v[1] += bf_hi(o.x); v[2] += bf_lo(o.y); v[3] += bf_hi(o.y); v[4] += bf_lo(o.z); v[5] += bf_hi(o.z); v[6] += bf_lo(o.w); v[7] += bf_hi(o.w); }
                    u32x4 w; w.x = cvt_pk_bf16(v[0], v[1]); w.y = cvt_pk_bf16(v[2], v[3]); w.z = cvt_pk_bf16(v[4], v[5]); w.w = cvt_pk_bf16(v[6], v[7]);
                    *(u32x4*)p = w;
                }
            }
    }
};

struct EpiOut {
    static constexpr bool PERM = true, AFTER_DRAIN = false;
    const float* x; const float* mod; float* out; float* parts;
    __device__ __forceinline__ void operator()(const f32x4 (&acc)[2][2][4][2], const Unit& u, int wr, int wc, int fr, int fq) const {
        const int col0 = u.pn * BM + wc * 32 + 8 * fq;
        const int b = (u.pm * BM) >> 11;
        const float* g1 = mod + (size_t)b * 6144 + 2048;
        f32x4 gt[2][2];
#pragma unroll
        for (int bj = 0; bj < 2; ++bj)
#pragma unroll
            for (int n = 0; n < 2; ++n) gt[bj][n] = *(const f32x4*)(g1 + col0 + bj * HALF + 4 * n);
#pragma unroll
        for (int ai = 0; ai < 2; ++ai)
#pragma unroll
            for (int m = 0; m < 4; ++m) {
                const int row = u.pm * BM + ai * HALF + wr * 64 + m * 16 + fr; const size_t off = (size_t)row * 1024 + col0;
                float ss = 0.f;
#pragma unroll
                for (int bj = 0; bj < 2; ++bj)
#pragma unroll
                    for (int n = 0; n < 2; ++n) { const f32x4 xv = *(const f32x4*)(x + off + bj * HALF + 4 * n); const f32x4 o = xv + gt[bj][n] * acc[ai][bj][m][n];
                        ss += (o[0] * o[0] + o[1] * o[1]) + (o[2] * o[2] + o[3] * o[3]); *(f32x4*)(out + off + bj * HALF + 4 * n) = o; }
                ss += __shfl_xor(ss, 16); ss += __shfl_xor(ss, 32);
                if (fq == 0) parts[(size_t)row * 16 + u.pn * 4 + wc] = ss;
            }
    }
};

struct EpiSc {
    static constexpr bool PERM = true, AFTER_DRAIN = false;
    float* SC;
    __device__ __forceinline__ void operator()(const f32x4 (&acc)[2][2][4][2], const Unit& u, int wr, int wc, int fr, int fq) const {
        const int col0 = u.pn * BM + wc * 32 + 8 * fq;
#pragma unroll
        for (int ai = 0; ai < 2; ++ai)
#pragma unroll
            for (int m = 0; m < 4; ++m) {
                const int row = u.pm * BM + ai * HALF + wr * 64 + m * 16 + fr; const size_t off = (size_t)row * 2048 + col0;
#pragma unroll
                for (int bj = 0; bj < 2; ++bj)
#pragma unroll
                    for (int n = 0; n < 2; ++n) *(f32x4*)(SC + off + bj * HALF + 4 * n) = acc[ai][bj][m][n];
            }
    }
};

template <class Epi, class Sched, bool ALIGN_EPI = false, bool SP2 = false>
__device__ __forceinline__ void gemm_phase(PG8_LAS unsigned char* lds, const Gemm g, const Sched& S, const Epi& E) {
    const int tid = threadIdx.x, wid = __builtin_amdgcn_readfirstlane(tid >> 6), lane = tid & 63, wr = wid >> 2, wc = wid & 3, fr = lane & 15, fq = lane >> 4;
    const int K = g.K, nt = K / BK;
    unsigned voffA[2], voffB[2];
#pragma unroll
    for (int i = 0; i < 2; ++i) { int R, C; stage_rc(tid * 16 + i * 8192, R, C); const int Rb = Epi::PERM ? ((R & ~31) + perm32(R & 31)) : R;
        voffA[i] = (unsigned)(R * g.lda + C) * 2u; voffB[i] = (unsigned)(Rb * g.ldb + C) * 2u; }
    const size_t kstep = (size_t)(BK * 2);
    const size_t hstepA = (size_t)HALF * g.lda * 2, hstepB = (size_t)HALF * g.ldb * 2;
    const size_t tstepA = 2 * hstepA, tstepB = 2 * hstepB;
    const unsigned ldsw = (unsigned)wid * 1024u;
    const int aoff = lds_byte(wr * 64 + fr, fq * 8), boff = lds_byte(wc * 32 + fr, fq * 8);
#define PG8_SA(b, h) (((b) * 2 + (h)) * HTB)
#define PG8_SB(b, h) ((4 + (b) * 2 + (h)) * HTB)
#define PG8_STAGE(bufoff, gbase, voff) do { _Pragma("unroll") for (int _i = 0; _i < 2; ++_i) \
        __builtin_amdgcn_global_load_lds((const unsigned*)((const char*)(gbase) + (voff)[_i]), (PG8_LAS unsigned*)(lds + (bufoff) + ldsw + _i * 8192), 16, 0, 0); } while (0)
#define PG8_LDA(dst, b, h) do { _Pragma("unroll") for (int m = 0; m < 4; ++m) _Pragma("unroll") for (int k = 0; k < 2; ++k) dst[m][k] = *(const PG8_LAS bf16x8*)(lds + PG8_SA(b, h) + aoff + m * 2048 + k * 1024); } while (0)
#define PG8_LDB(dst, b, h) do { _Pragma("unroll") for (int n = 0; n < 2; ++n) _Pragma("unroll") for (int k = 0; k < 2; ++k) dst[n][k] = *(const PG8_LAS bf16x8*)(lds + PG8_SB(b, h) + boff + n * 2048 + k * 1024); } while (0)
#define PG8_MMA(ai, bj, At, Bt) do { __builtin_amdgcn_s_setprio(1); _Pragma("unroll") for (int m = 0; m < 4; ++m) _Pragma("unroll") for (int n = 0; n < 2; ++n) _Pragma("unroll") for (int k = 0; k < 2; ++k) \
        acc[ai][bj][m][n] = __builtin_amdgcn_mfma_f32_16x16x32_bf16(Bt[n][k], At[m][k], acc[ai][bj][m][n], 0, 0, 0); __builtin_amdgcn_s_setprio(0); } while (0)
#define PG8_WAIT_V(n) asm volatile("s_waitcnt vmcnt(" #n ")" ::: "memory")
#define PG8_WAIT_L(n) asm volatile("s_waitcnt lgkmcnt(" #n ")" ::: "memory")
#define PG8_BAR __builtin_amdgcn_s_barrier()
#define PG8_SCHED __builtin_amdgcn_sched_barrier(0)
    Unit cur, nxt; int ui = 0;
    if (!S.next(0, cur)) return;
    f32x4 acc[2][2][4][2];
#pragma unroll
    for (int a = 0; a < 2; ++a)
#pragma unroll
        for (int b = 0; b < 2; ++b)
#pragma unroll
            for (int m = 0; m < 4; ++m)
#pragma unroll
                for (int n = 0; n < 2; ++n) acc[a][b][m][n] = (f32x4){0.f, 0.f, 0.f, 0.f};
    bf16x8 At[4][2], B0[2][2], B1[2][2];
    const char* cA = (const char*)g.A + (size_t)cur.pm * tstepA; const char* cB = (const char*)g.Bt + (size_t)cur.pn * tstepB;
    S.a_ready(cur);
    if constexpr (SP2) {
        PG8_STAGE(PG8_SB(0, 0), cB, voffB); PG8_STAGE(PG8_SB(0, 1), cB + hstepB, voffB); PG8_STAGE(PG8_SA(0, 0), cA, voffA); PG8_STAGE(PG8_SA(0, 1), cA + hstepA, voffA);
        if (wr == 1) PG8_BAR;
        PG8_WAIT_V(2); PG8_BAR;
        PG8_STAGE(PG8_SB(1, 0), cB + kstep, voffB); PG8_STAGE(PG8_SA(1, 0), cA + kstep, voffA); PG8_STAGE(PG8_SB(1, 1), cB + hstepB + kstep, voffB);
        PG8_WAIT_V(6); PG8_BAR;
    } else {
        PG8_STAGE(PG8_SB(0, 0), cB, voffB); PG8_STAGE(PG8_SA(0, 0), cA, voffA); PG8_STAGE(PG8_SB(0, 1), cB + hstepB, voffB); PG8_STAGE(PG8_SA(0, 1), cA + hstepA, voffA);
        if (wr == 1) PG8_BAR;
        PG8_WAIT_V(4); PG8_BAR;
        PG8_STAGE(PG8_SB(1, 0), cB + kstep, voffB); PG8_STAGE(PG8_SA(1, 0), cA + kstep, voffA); PG8_STAGE(PG8_SB(1, 1), cB + hstepB + kstep, voffB);
        PG8_WAIT_V(6); PG8_BAR;
    }
    for (;;) {
        const bool has_next = S.next(ui + 1, nxt);
        const char* nA = has_next ? (const char*)g.A + (size_t)nxt.pm * tstepA : cA; const char* nB = has_next ? (const char*)g.Bt + (size_t)nxt.pn * tstepB : cB;
        for (int t = 0; t < nt; t += 2) {
            const bool last = (t == nt - 2);
            const char* a1 = cA + (size_t)(t + 1) * kstep;
            const char* a2 = last ? nA : cA + (size_t)(t + 2) * kstep; const char* b2 = last ? nB : cB + (size_t)(t + 2) * kstep;
            const char* a3 = a2 + kstep; const char* b3 = b2 + kstep;
            if (last && has_next) S.a_ready(nxt);
            if constexpr (SP2) {
            PG8_LDB(B0, 0, 0); PG8_LDB(B1, 0, 1); PG8_SCHED; PG8_LDA(At, 0, 0); PG8_STAGE(PG8_SA(1, 1), a1 + hstepA, voffA);
            PG8_WAIT_V(8); PG8_WAIT_L(0); PG8_BAR; PG8_MMA(0, 0, At, B0); PG8_MMA(0, 1, At, B1); PG8_BAR; PG8_SCHED;
            PG8_LDA(At, 0, 1); PG8_STAGE(PG8_SB(0, 0), b2, voffB); PG8_STAGE(PG8_SB(0, 1), b2 + hstepB, voffB); PG8_STAGE(PG8_SA(0, 0), a2, voffA);
            PG8_WAIT_V(8); PG8_WAIT_L(0); PG8_BAR; PG8_MMA(1, 0, At, B0); PG8_MMA(1, 1, At, B1); PG8_BAR; PG8_SCHED;
            PG8_LDB(B0, 1, 0); PG8_LDB(B1, 1, 1); PG8_SCHED; PG8_LDA(At, 1, 0); PG8_STAGE(PG8_SA(0, 1), a2 + hstepA, voffA);
            PG8_WAIT_V(8); PG8_WAIT_L(0); PG8_BAR; PG8_MMA(0, 0, At, B0); PG8_MMA(0, 1, At, B1); PG8_BAR; PG8_SCHED;
            PG8_LDA(At, 1, 1); PG8_STAGE(PG8_SB(1, 0), b3, voffB); PG8_STAGE(PG8_SB(1, 1), b3 + hstepB, voffB); PG8_STAGE(PG8_SA(1, 0), a3, voffA);
            PG8_WAIT_V(8); PG8_WAIT_L(0); PG8_BAR; PG8_MMA(1, 0, At, B0); PG8_MMA(1, 1, At, B1); PG8_BAR; PG8_SCHED;
            } else {
            PG8_LDB(B0, 0, 0); PG8_SCHED; PG8_LDA(At, 0, 0); PG8_STAGE(PG8_SA(1, 1), a1 + hstepA, voffA);
            PG8_WAIT_L(8); PG8_BAR; PG8_WAIT_L(0); PG8_MMA(0, 0, At, B0); PG8_BAR; PG8_SCHED;
            PG8_LDB(B1, 0, 1); PG8_STAGE(PG8_SB(0, 0), b2, voffB);
            PG8_BAR; PG8_WAIT_L(0); PG8_MMA(0, 1, At, B1); PG8_BAR;
            PG8_LDA(At, 0, 1); PG8_STAGE(PG8_SA(0, 0), a2, voffA);
            PG8_BAR; PG8_WAIT_L(0); PG8_MMA(1, 0, At, B0); PG8_BAR; PG8_SCHED;
            PG8_STAGE(PG8_SB(0, 1), b2 + hstepB, voffB);
            PG8_WAIT_V(6); PG8_BAR; PG8_MMA(1, 1, At, B1); PG8_BAR;
            PG8_LDB(B0, 1, 0); PG8_SCHED; PG8_LDA(At, 1, 0); PG8_STAGE(PG8_SA(0, 1), a2 + hstepA, voffA);
            PG8_WAIT_L(8); PG8_BAR; PG8_WAIT_L(0); PG8_MMA(0, 0, At, B0); PG8_BAR; PG8_SCHED;
            PG8_LDB(B1, 1, 1); PG8_STAGE(PG8_SB(1, 0), b3, voffB);
            PG8_BAR; PG8_WAIT_L(0); PG8_MMA(0, 1, At, B1); PG8_BAR;
            PG8_LDA(At, 1, 1); PG8_STAGE(PG8_SA(1, 0), a3, voffA);
            PG8_BAR; PG8_WAIT_L(0); PG8_MMA(1, 0, At, B0); PG8_BAR; PG8_SCHED;
            PG8_STAGE(PG8_SB(1, 1), b3 + hstepB, voffB);
            PG8_WAIT_V(6); PG8_BAR; PG8_MMA(1, 1, At, B1); PG8_BAR;
            }
        }
        if constexpr (ALIGN_EPI) { if (wr == 0) PG8_BAR; }
        if constexpr (!Epi::AFTER_DRAIN) { E(acc, cur, wr, wc, fr, fq); S.done(cur); }
        if (!has_next) break;
#pragma unroll
        for (int a = 0; a < 2; ++a)
#pragma unroll
            for (int b = 0; b < 2; ++b)
#pragma unroll
                for (int m = 0; m < 4; ++m)
#pragma unroll
                    for (int n = 0; n < 2; ++n) acc[a][b][m][n] = (f32x4){0.f, 0.f, 0.f, 0.f};
        cur = nxt; cA = nA; cB = nB; ++ui;
        if constexpr (ALIGN_EPI) { if (wr == 1) PG8_BAR; }
    }
    PG8_WAIT_V(0);
    if constexpr (!ALIGN_EPI) { if (wr == 0) PG8_BAR; }
    PG8_BAR;
    if constexpr (Epi::AFTER_DRAIN) { E.fused(acc, cur, wr, wc, fr, fq, lds, wid, lane); S.done(cur); }
#undef PG8_SA
#undef PG8_SB
#undef PG8_STAGE
#undef PG8_LDA
#undef PG8_LDB
#undef PG8_MMA
#undef PG8_WAIT_V
#undef PG8_WAIT_L
#undef PG8_BAR
#undef PG8_SCHED
}
}

namespace att {
#define ALAS __attribute__((address_space(3)))
typedef unsigned short bf16_t;
typedef short bf16x8 __attribute__((ext_vector_type(8)));
typedef short s16x4 __attribute__((ext_vector_type(4)));
typedef short v4i16_t __attribute__((ext_vector_type(4)));
typedef float f32x16 __attribute__((ext_vector_type(16)));
typedef float f32x4 __attribute__((ext_vector_type(4)));
typedef unsigned u32x4 __attribute__((ext_vector_type(4)));
constexpr int L_K = 0, L_V = 24576, L_KB = 40960, L_KM = 49152, L_STG = 51200, L_END = L_STG + 8 * 4096;
__device__ __forceinline__ s16x4 vtr(const ALAS char* p) { return __builtin_bit_cast(s16x4, __builtin_amdgcn_ds_read_tr16_b64_v4i16((ALAS v4i16_t*)p)); }
__device__ __forceinline__ unsigned cvtpk(float lo, float hi) { typedef float f2 __attribute__((ext_vector_type(2))); typedef __bf16 b2 __attribute__((ext_vector_type(2))); f2 v = {lo, hi}; b2 b = __builtin_convertvector(v, b2); return __builtin_bit_cast(unsigned, b); }
__device__ __forceinline__ float pairsum(float v) { auto rr = __builtin_amdgcn_permlane32_swap(__float_as_uint(v), __float_as_uint(v), false, false); return __uint_as_float(rr[0]) + __uint_as_float(rr[1]); }
__device__ __forceinline__ float max3f(float a, float b, float c) { float r; asm("v_max3_f32 %0, %1, %2, %3" : "=v"(r) : "v"(a), "v"(b), "v"(c)); return r; }

template <int TYPE>
__device__ __forceinline__ void attn_unit(int b, int h, int qb, const bf16_t* Q, const bf16_t* K, const bf16_t* V, const float* Fcum, const float* kmean, bf16_t* Y, ALAS char* lds) {
    const int tid = threadIdx.x, lane = tid & 63, r32 = lane & 31, hi = lane >> 5; const int wid = __builtin_amdgcn_readfirstlane(tid >> 6);
    const size_t headbase = (size_t)(b * NHEAD + h) * SEQ * HDIM;
    const char* Kh = (const char*)(K + headbase); const char* Vh = (const char*)(V + headbase); const bf16_t* Qh = Q + headbase;
    const int q0 = qb * 256, NT = 4 * (qb + 1);
    ALAS float* kbias = (ALAS float*)(lds + L_KB);
    ALAS float* km = (ALAS float*)(lds + L_KM);
    {
        const float slope = exp2f(-(float)(h + 1));
        for (int s = tid; s < q0 + 256; s += 512) kbias[s] = (TYPE == 0) ? (-Fcum[(size_t)(b * NHEAD + h) * SEQ + s] * LOG2E) : (slope * (float)s * LOG2E);
        if (TYPE == 1) km[tid] = kmean[(size_t)(b * NHEAD + h) * 512 + tid];
    }
    bf16x8 qr[4];
    { const bf16_t* qrow = Qh + (size_t)(q0 + wid * 32 + r32) * HDIM;
#pragma unroll
      for (int d0 = 0; d0 < 4; ++d0) qr[d0] = *(const bf16x8*)(qrow + d0 * 16 + hi * 8); }
    const int koff = lane * 128 + wid * 16;
    const int voff = (16 * (wid & 3) + (lane >> 2)) * 128 + (wid >> 2) * 64 + (lane & 3) * 16;
    const int ldst = wid * 1024 + lane * 16;
    { const u32x4 k0 = *(const u32x4*)(Kh + koff), k1 = *(const u32x4*)(Kh + 8192 + koff), v0 = *(const u32x4*)(Vh + voff);
      *(ALAS u32x4*)(lds + L_K + ldst) = k0; *(ALAS u32x4*)(lds + L_K + 8192 + ldst) = k1; *(ALAS u32x4*)(lds + L_V + ldst) = v0; }
    u32x4 kreg = *(const u32x4*)(Kh + 2 * 8192 + koff), vreg = *(const u32x4*)(Vh + 8192 + voff);
    __syncthreads();
    unsigned sel = 0xffu;
    if (TYPE == 1) {
        float gate[7];
#pragma unroll
        for (int jb = 0; jb < 7; ++jb) {
            float g = 0.f;
#pragma unroll
            for (int d0 = 0; d0 < 4; ++d0) {
                const f32x4 k0 = *(const ALAS f32x4*)(km + jb * 64 + d0 * 16 + hi * 8), k1 = *(const ALAS f32x4*)(km + jb * 64 + d0 * 16 + hi * 8 + 4);
#pragma unroll
                for (int e = 0; e < 4; ++e) { g += __uint_as_float((unsigned)(unsigned short)qr[d0][e] << 16) * k0[e]; g += __uint_as_float((unsigned)(unsigned short)qr[d0][4 + e] << 16) * k1[e]; }
            }
            gate[jb] = pairsum(g);
        }
        if (qb <= 3) sel = (1u << qb) - 1u;
        else { sel = 0u;
#pragma unroll
            for (int it = 0; it < 3; ++it) { float best = -INFINITY; int bi = 0;
#pragma unroll
                for (int jb = 0; jb < 7; ++jb) { const bool ok = (jb < qb) && !((sel >> jb) & 1u) && (gate[jb] > best); best = ok ? gate[jb] : best; bi = ok ? jb : bi; }
                sel |= 1u << bi; } }
    }
    float m_run = -1e30f, l_run = 0.f; f32x16 o[2]; o[0] = f32x16{}; o[1] = f32x16{};
    const int qrel = wid * 32 + r32;
    auto qk_tile = [&](int t, int kslot, f32x16& p0, f32x16& p1) {
        { const ALAS float* kbt = kbias + 64 * t + 4 * hi;
#pragma unroll
          for (int rq = 0; rq < 4; ++rq) { const f32x4 b0 = *(const ALAS f32x4*)(kbt + 8 * rq), b1 = *(const ALAS f32x4*)(kbt + 32 + 8 * rq);
#pragma unroll
              for (int e = 0; e < 4; ++e) { p0[4 * rq + e] = b0[e]; p1[4 * rq + e] = b1[e]; } } }
        { const ALAS char* kb = lds + L_K + kslot * 8192 + hi * 1024 + r32 * 16;
#pragma unroll
          for (int d0 = 0; d0 < 4; ++d0) { const bf16x8 b0 = *(const ALAS bf16x8*)(kb + d0 * 2048), b1 = *(const ALAS bf16x8*)(kb + d0 * 2048 + 512);
              p0 = __builtin_amdgcn_mfma_f32_32x32x16_bf16(b0, qr[d0], p0, 0, 0, 0); p1 = __builtin_amdgcn_mfma_f32_32x32x16_bf16(b1, qr[d0], p1, 0, 0, 0); } }
    };
    auto mask_tile = [&](int t, f32x16& p0, f32x16& p1) {
        const int jband = t - (NT - 4);
        if (jband >= 0) { const int kb0 = 64 * jband + 4 * hi;
#pragma unroll
            for (int r = 0; r < 16; ++r) { const int kv = kb0 + (r & 3) + 8 * (r >> 2); if (kv > qrel) p0[r] = -INFINITY; if (kv + 32 > qrel) p1[r] = -INFINITY; } }
        else if (TYPE == 1) { if (!((sel >> (t >> 2)) & 1u)) {
#pragma unroll
            for (int r = 0; r < 16; ++r) { p0[r] = -INFINITY; p1[r] = -INFINITY; } } }
    };
    f32x16 s0, s1;
    qk_tile(0, 0, s0, s1);
    int ks_next = 1, ks_st = 2;
    for (int t = 0; t < NT; ++t) {
        const int buf = t & 1;
        mask_tile(t, s0, s1);
        f32x16 n0, n1;
        qk_tile(t + 1, ks_next, n0, n1);
        {
            float ra = max3f(s0[0], s0[1], s1[0]), rb = max3f(s0[2], s0[3], s1[1]); ra = max3f(ra, s1[2], s1[3]);
#pragma unroll
            for (int r = 4; r < 16; r += 4) { ra = max3f(ra, s0[r], s0[r + 1]); rb = max3f(rb, s0[r + 2], s0[r + 3]); ra = max3f(ra, s1[r], s1[r + 1]); rb = max3f(rb, s1[r + 2], s1[r + 3]); }
            float rm = max3f(ra, rb, rb);
            { auto rr = __builtin_amdgcn_permlane32_swap(__float_as_uint(rm), __float_as_uint(rm), false, false); rm = max3f(__uint_as_float(rr[0]), __uint_as_float(rr[1]), rm); }
            const float mn = fmaxf(m_run, rm), alpha = __builtin_amdgcn_exp2f(m_run - mn); m_run = mn;
            float rs = 0.f;
#pragma unroll
            for (int r = 0; r < 16; ++r) { s0[r] = __builtin_amdgcn_exp2f(s0[r] - mn); s1[r] = __builtin_amdgcn_exp2f(s1[r] - mn); rs += s0[r] + s1[r]; }
            l_run = l_run * alpha + rs;
#pragma unroll
            for (int r = 0; r < 16; ++r) { o[0][r] *= alpha; o[1][r] *= alpha; }
            u32x4 pw[4];
            pw[0] = (u32x4){cvtpk(s0[0], s0[1]), cvtpk(s0[2], s0[3]), cvtpk(s0[4], s0[5]), cvtpk(s0[6], s0[7])};
            pw[1] = (u32x4){cvtpk(s0[8], s0[9]), cvtpk(s0[10], s0[11]), cvtpk(s0[12], s0[13]), cvtpk(s0[14], s0[15])};
            pw[2] = (u32x4){cvtpk(s1[0], s1[1]), cvtpk(s1[2], s1[3]), cvtpk(s1[4], s1[5]), cvtpk(s1[6], s1[7])};
            pw[3] = (u32x4){cvtpk(s1[8], s1[9]), cvtpk(s1[10], s1[11]), cvtpk(s1[12], s1[13]), cvtpk(s1[14], s1[15])};
            const ALAS char* vp = lds + L_V + buf * 8192 + ((lane >> 4) & 1) * 32 + (lane & 3) * 8 + (4 * hi + ((lane & 15) >> 2)) * 64;
#pragma unroll
            for (int d0 = 0; d0 < 2; ++d0)
#pragma unroll
                for (int ks = 0; ks < 4; ++ks) { const s16x4 lo = vtr(vp + d0 * 4096 + ks * 1024), hh = vtr(vp + d0 * 4096 + ks * 1024 + 512);
                    const bf16x8 vf = (bf16x8){lo[0], lo[1], lo[2], lo[3], hh[0], hh[1], hh[2], hh[3]};
                    o[d0] = __builtin_amdgcn_mfma_f32_32x32x16_bf16(vf, __builtin_bit_cast(bf16x8, pw[ks]), o[d0], 0, 0, 0); }
        }
        *(ALAS u32x4*)(lds + L_K + ks_st * 8192 + ldst) = kreg; *(ALAS u32x4*)(lds + L_V + (buf ^ 1) * 8192 + ldst) = vreg;
        { const int tk = (t + 3 < NT) ? t + 3 : NT - 1, tv = (t + 2 < NT) ? t + 2 : NT - 1;
          kreg = *(const u32x4*)(Kh + (size_t)tk * 8192 + koff); vreg = *(const u32x4*)(Vh + (size_t)tv * 8192 + voff); }
        __syncthreads();
        s0 = n0; s1 = n1;
        ks_next = (ks_next == 2) ? 0 : ks_next + 1; ks_st = (ks_st == 2) ? 0 : ks_st + 1;
    }
    l_run = pairsum(l_run);
    const float rl = 1.0f / l_run;
    ALAS bf16_t* stg = (ALAS bf16_t*)(lds + L_STG) + wid * 2048;
#pragma unroll
    for (int d0 = 0; d0 < 2; ++d0)
#pragma unroll
        for (int rq = 0; rq < 4; ++rq) { typedef unsigned u32x2 __attribute__((ext_vector_type(2)));
            const u32x2 w = {cvtpk(o[d0][4 * rq] * rl, o[d0][4 * rq + 1] * rl), cvtpk(o[d0][4 * rq + 2] * rl, o[d0][4 * rq + 3] * rl)};
            *(ALAS u32x2*)(stg + r32 * 64 + d0 * 32 + 8 * rq + 4 * hi) = w; }
    asm volatile("s_waitcnt lgkmcnt(0)" ::: "memory");
    bf16_t* Yw = Y + (size_t)(b * SEQ + q0 + wid * 32) * 1024 + TYPE * 512 + h * 64;
#pragma unroll
    for (int i = 0; i < 4; ++i) { const int row = i * 8 + (lane >> 3), ch = lane & 7; const u32x4 v = *(const ALAS u32x4*)(stg + row * 64 + ch * 8); *(u32x4*)(Yw + (size_t)row * 1024 + ch * 8) = v; }
    __syncthreads();
}
#undef ALAS
}

constexpr int NWAVES = 8;
constexpr size_t MiB = 1u << 20;
constexpr size_t WS_CTL = 0, CTL_ZERO_BYTES = 256 * 1024;
constexpr size_t WS_KMEAN = 64 * 1024;
constexpr size_t WS_MOD = 256 * 1024;
constexpr size_t WS_WFG = 448 * 1024;
constexpr size_t WS_GAINS = 480 * 1024;
constexpr size_t WS_LF = 512 * 1024;
constexpr size_t WS_FC = 1 * MiB;
constexpr size_t WS_PARTS = 2 * MiB;
constexpr size_t WS_WIN = 4 * MiB;
constexpr size_t WS_WFT = 14 * MiB, WS_WMT = 15 * MiB;
constexpr size_t WS_WOT = 16 * MiB;
constexpr size_t WS_WEFF = 18 * MiB;
constexpr size_t WS_HY = 24 * MiB;
constexpr size_t WS_QKV = 56 * MiB;
constexpr size_t WS_MIX = 152 * MiB;
constexpr size_t WS_U8 = 184 * MiB, WS_V8 = 200 * MiB;
constexpr size_t WS_SU = 216 * MiB, WS_SV = 216 * MiB + 65536;
constexpr size_t WS_PP = 56 * MiB;
constexpr size_t WS_WT = 220 * MiB;
constexpr size_t WS_EG = 248 * MiB;
constexpr size_t WS_SC = 56 * MiB;
constexpr size_t WS_END = 256 * MiB;
constexpr int CW_BAR = 4096;
constexpr int RING_BYTES = 131072, LDSCTL_OFF = RING_BYTES, MISC_OFF = LDSCTL_OFF + 320, LDS_BYTES = 147456;

#define GAS __attribute__((address_space(1)))
#define LAS __attribute__((address_space(3)))
typedef unsigned short bf16;
typedef unsigned v4u __attribute__((ext_vector_type(4)));
typedef unsigned v2u __attribute__((ext_vector_type(2)));
typedef float f32x4 __attribute__((ext_vector_type(4)));
typedef GAS unsigned gu32;
#define RLX_AGENT __ATOMIC_RELAXED, __HIP_MEMORY_SCOPE_AGENT
#define LDS_WAIT() asm volatile("s_waitcnt lgkmcnt(0)" ::: "memory")
#define VM_WAIT() asm volatile("s_waitcnt vmcnt(0)" ::: "memory")
__device__ __forceinline__ unsigned f2bf(float f) { unsigned u = __builtin_bit_cast(unsigned, f); return (u + 0x7fffu + ((u >> 16) & 1u)) >> 16; }
__device__ __forceinline__ unsigned pk2(float lo, float hi) { return f2bf(lo) | (f2bf(hi) << 16); }
__device__ __forceinline__ float wave_sum(float v) {
#pragma unroll
    for (int o = 1; o < 64; o <<= 1) v += __shfl_xor(v, o);
    return v;
}
#define XB_TMO      128
#define XB_XCNT(j)  (256  + 64 * (j))
#define XB_XSUB(j)  (1280 + 64 * (j))
#define XB_XGEN(j)  (2304 + 64 * (j))
#define XB_TOP      3328
#define XB_TOPGEN   3392
#define XCD_BAR_WORDS 3456
#define XB_SPIN_CAP (1u << 18)

__device__ __forceinline__ unsigned xb_ld(unsigned* p)              { return __hip_atomic_load(p, __ATOMIC_RELAXED, __HIP_MEMORY_SCOPE_AGENT); }
__device__ __forceinline__ unsigned xb_add(unsigned* p, unsigned v) { return __hip_atomic_fetch_add(p, v, __ATOMIC_RELAXED, __HIP_MEMORY_SCOPE_AGENT); }
__device__ __forceinline__ unsigned xb_xcc_id() { return (unsigned)__builtin_amdgcn_s_getreg((3 << 11) | 20) & 0xFu; }
#define XB_SPIN(cond, bar) do { unsigned _sp = 0; while (cond) { __builtin_amdgcn_s_sleep(1); \
    if ((++_sp & 255u) == 0u) { if (xb_ld(&(bar)[XB_TMO])) break; if (_sp > XB_SPIN_CAP) { atomicAdd(&(bar)[XB_TMO], 1u); break; } } } } while (0)

struct XcdBarrier {
    unsigned* bar; unsigned x;
    volatile LAS unsigned* st;
};

__device__ __forceinline__ XcdBarrier xcd_barrier_post(unsigned* bar, volatile LAS unsigned* st) {
    XcdBarrier b; b.bar = bar; b.x = xb_xcc_id(); b.st = st;
    if (threadIdx.x == 0) (void)xb_add(&bar[XB_XCNT(b.x)], 1u);
    return b;
}
__device__ __forceinline__ void xcd_barrier_complete(unsigned* bar, unsigned x, unsigned& nloc, unsigned& nx) {
    const unsigned G = gridDim.x * gridDim.y * gridDim.z;
    unsigned sum, cnt, mine, sp = 0u;
    for (;;) {
        sum = 0u; cnt = 0u; mine = 0u;
#pragma unroll
        for (unsigned j = 0; j < 16; ++j) { const unsigned c = xb_ld(&bar[XB_XCNT(j)]); sum += c; cnt += (c > 0u) ? 1u : 0u; mine = (j == x) ? c : mine; }
        if (sum == G) break;
        __builtin_amdgcn_s_sleep(1);
        if ((++sp & 255u) == 0u) { if (xb_ld(&bar[XB_TMO])) break; if (sp > XB_SPIN_CAP) { atomicAdd(&bar[XB_TMO], 1u); break; } }
    }
    nloc = mine > 0u ? mine : 1u; nx = cnt > 0u ? cnt : 1u;
}

__device__ __forceinline__ void xcd_barrier(const XcdBarrier& b) {
    asm volatile("s_waitcnt vmcnt(0)" ::: "memory");
    __syncthreads();
    if (threadIdx.x == 0) {
        unsigned* bar = b.bar;
        __builtin_amdgcn_s_waitcnt(0);
        unsigned nloc = b.st[0], nx = b.st[1];
        if (nloc == 0u) { xcd_barrier_complete(bar, b.x, nloc, nx); b.st[0] = nloc; b.st[1] = nx; }
        const unsigned old = xb_add(&bar[XB_XSUB(b.x)], 1u);
        const unsigned gen = old / nloc;
        if (old + 1u == (gen + 1u) * nloc) {
            __builtin_amdgcn_fence(__ATOMIC_RELEASE, "agent");
            asm volatile("s_waitcnt vmcnt(0)" ::: "memory");
            const unsigned og = xb_add(&bar[XB_TOP], 1u);
            const unsigned tg = og / nx;
            if (og + 1u == (tg + 1u) * nx) xb_add(&bar[XB_TOPGEN], 1u);
            else XB_SPIN(xb_ld(&bar[XB_TOPGEN]) == tg, bar);
            __builtin_amdgcn_fence(__ATOMIC_ACQUIRE, "agent");
            xb_add(&bar[XB_XGEN(b.x)], 1u);
            asm volatile("s_waitcnt vmcnt(0)" ::: "memory");
        } else {
            XB_SPIN(xb_ld(&bar[XB_XGEN(b.x)]) == gen, bar);
            __builtin_amdgcn_fence(__ATOMIC_ACQUIRE, "agent");
            asm volatile("s_waitcnt vmcnt(0)" ::: "memory");
        }
    }
    __syncthreads();
}

struct Frame {
    LAS unsigned char* lds; int tid, lane, wave, G, bid;
    const float *x, *c, *w_ada, *b_ada, *norm1_g, *w_in, *b_fgate, *fox_q_g, *fox_k_g, *moba_q_g, *moba_k_g, *w_up_fox, *w_up_moba, *w_out, *norm2_g, *w_peer_q, *sub_keys, *peer_u, *peer_v;
    float* out; unsigned char* ws;
};

__device__ __forceinline__ void tr_item(const float* W, int ldw, int col0, int k0, bf16* WT, int ldt, int row0, LAS float* scr, int lane) {
#pragma unroll 8
    for (int i = 0; i < 32; ++i) { const int kk = 2 * i + (lane >> 5); scr[kk * 33 + (lane & 31)] = W[(size_t)(k0 + kk) * ldw + col0 + (lane & 31)]; }
    LDS_WAIT(); asm volatile("" ::: "memory");
    const int c = lane & 7;
#pragma unroll
    for (int j = 0; j < 4; ++j) { const int n = (lane >> 3) + 8 * j; const LAS float* s = scr + (8 * c) * 33 + n;
        v4u o; o.x = pk2(s[0 * 33], s[1 * 33]); o.y = pk2(s[2 * 33], s[3 * 33]); o.z = pk2(s[4 * 33], s[5 * 33]); o.w = pk2(s[6 * 33], s[7 * 33]);
        *(GAS v4u*)(WT + (size_t)(row0 + n) * ldt + k0 + 8 * c) = o; }
    LDS_WAIT(); asm volatile("" ::: "memory");
}

__device__ __forceinline__ void p0_prep(Frame& F) {
    const int tid = F.tid, lane = F.lane, wave = F.wave, G = F.G;
    float* mod = (float*)(F.ws + WS_MOD);
    {
        LAS float* Kt = (LAS float*)F.lds; LAS float* Wt = Kt + 128 * 128;
        bf16* WeffT = (bf16*)(F.ws + WS_WEFF);
        for (int it = F.bid; it < 256; it += G) {
            const int hp = it >> 4, d0 = (it & 15) * 64;
            const float* keys = F.sub_keys + (size_t)hp * 128 * 128;
#pragma unroll
            for (int i = 0; i < 8; ++i) { const int idx = (i * 512 + tid) * 4, n = idx >> 7, cc = idx & 127; const f32x4 v = *(const f32x4*)(keys + idx);
                Kt[(cc + 0) * 128 + n] = v[0]; Kt[(cc + 1) * 128 + n] = v[1]; Kt[(cc + 2) * 128 + n] = v[2]; Kt[(cc + 3) * 128 + n] = v[3]; }
#pragma unroll
            for (int i = 0; i < 4; ++i) { const int idx = (i * 512 + tid) * 4, dd = idx >> 7, cc = idx & 127; const f32x4 v = *(const f32x4*)(F.w_peer_q + (size_t)(d0 + dd) * 2048 + hp * 128 + cc);
                Wt[(cc + 0) * 64 + dd] = v[0]; Wt[(cc + 1) * 64 + dd] = v[1]; Wt[(cc + 2) * 64 + dd] = v[2]; Wt[(cc + 3) * 64 + dd] = v[3]; }
            __syncthreads();
            const int tn = tid & 31, td = tid >> 5;
            float acc[4][4];
#pragma unroll
            for (int i = 0; i < 4; ++i)
#pragma unroll
                for (int j = 0; j < 4; ++j) acc[i][j] = 0.f;
            for (int cc = 0; cc < 128; ++cc) { const f32x4 kv = *(const LAS f32x4*)(Kt + cc * 128 + 4 * tn), wv = *(const LAS f32x4*)(Wt + cc * 64 + 4 * td);
#pragma unroll
                for (int i = 0; i < 4; ++i)
#pragma unroll
                    for (int j = 0; j < 4; ++j) acc[i][j] += kv[i] * wv[j]; }
#pragma unroll
            for (int i = 0; i < 4; ++i) { v2u o; o.x = pk2(acc[i][0], acc[i][1]); o.y = pk2(acc[i][2], acc[i][3]); *(GAS v2u*)(WeffT + (size_t)(hp * 128 + 4 * tn + i) * 1024 + d0 + 4 * td) = o; }
            __syncthreads();
        }
    }
    {
        LAS float* sc = (LAS float*)F.lds; LAS float* red = sc + 8192;
        for (int it = F.bid; it < 192; it += G) {
            for (int i = tid; i < 8192; i += 512) { const int bb = i >> 10, k = i & 1023; const float v = F.c[i]; sc[k * 8 + bb] = v / (1.0f + expf(-v)); }
            __syncthreads();
            const int n = it * 32 + (lane & 31), kpar = lane >> 5; float a[8];
#pragma unroll
            for (int bb = 0; bb < 8; ++bb) a[bb] = 0.f;
            for (int k0 = wave * 128; k0 < wave * 128 + 128; k0 += 32) {
                float w[16];
#pragma unroll
                for (int j = 0; j < 16; ++j) w[j] = F.w_ada[(size_t)(k0 + 2 * j + kpar) * 6144 + n];
#pragma unroll
                for (int j = 0; j < 16; ++j) { const int k = k0 + 2 * j + kpar; const f32x4 s0 = *(const LAS f32x4*)(sc + k * 8), s1 = *(const LAS f32x4*)(sc + k * 8 + 4);
                    a[0] += w[j] * s0[0]; a[1] += w[j] * s0[1]; a[2] += w[j] * s0[2]; a[3] += w[j] * s0[3]; a[4] += w[j] * s1[0]; a[5] += w[j] * s1[1]; a[6] += w[j] * s1[2]; a[7] += w[j] * s1[3]; }
            }
#pragma unroll
            for (int bb = 0; bb < 8; ++bb) red[((wave * 2 + kpar) * 8 + bb) * 32 + (lane & 31)] = a[bb];
            __syncthreads();
            if (tid < 256) { const int bb = tid >> 5, cc = tid & 31; float s = 0.f;
#pragma unroll
              for (int w = 0; w < 16; ++w) s += red[(w * 8 + bb) * 32 + cc];
              mod[bb * 6144 + it * 32 + cc] = s + F.b_ada[it * 32 + cc]; }
            __syncthreads();
        }
    }
    {
        LAS float* scr = (LAS float*)(F.lds + wave * 16384);
        const int gw = F.bid * NWAVES + wave, NGW = G * NWAVES;
        constexpr int I_IN = 16 * 160, I_UP = 8 * 32, I_OUT = 16 * 32;
        for (int it = gw; it < I_IN + 2 * I_UP + I_OUT; it += NGW) {
            int r = it;
            if (r < I_IN) { const int kb = r / 160, rb = r % 160, tile = rb >> 3, bj = (rb >> 2) & 1, wc = rb & 3; const int Lg = tile * 256 + 64 * wc + 32 * bj; const int src = Lg < 1536 ? Lg : Lg + 8;
                tr_item(F.w_in, IN_COLS, src, kb * 64, (bf16*)(F.ws + WS_WIN), 1024, rb * 32, scr, lane); continue; }
            r -= I_IN;
            if (r < I_UP) { tr_item(F.w_up_fox, 1024, (r & 31) * 32, (r >> 5) * 64, (bf16*)(F.ws + WS_WFT), 512, (r & 31) * 32, scr, lane); continue; }
            r -= I_UP;
            if (r < I_UP) { tr_item(F.w_up_moba, 1024, (r & 31) * 32, (r >> 5) * 64, (bf16*)(F.ws + WS_WMT), 512, (r & 31) * 32, scr, lane); continue; }
            r -= I_UP;
            tr_item(F.w_out, 1024, (r & 31) * 32, (r >> 5) * 64, (bf16*)(F.ws + WS_WOT), 1024, (r & 31) * 32, scr, lane);
        }
    }
    {
        const size_t gt = (size_t)F.bid * 512 + tid, NT_ = (size_t)G * 512;
        float* wfg = (float*)(F.ws + WS_WFG);
        for (size_t i = gt; i < 8192; i += NT_) { const int j = (int)(i >> 10), k = (int)(i & 1023); wfg[i] = F.w_in[(size_t)k * IN_COLS + 1536 + j]; }
        if (gt < 64) { float* gn = (float*)(F.ws + WS_GAINS); gn[gt] = F.fox_q_g[gt]; gn[64 + gt] = F.fox_k_g[gt]; gn[128 + gt] = F.moba_q_g[gt]; gn[192 + gt] = F.moba_k_g[gt]; }
    }
    {
        const int gw = F.bid * NWAVES + wave, NGW = G * NWAVES;
        for (int r4 = gw; r4 < 2 * NEXP / 4; r4 += NGW) {
            const int r = r4 * 4; const bool isu = r < NEXP; const int rr = isu ? r : r - NEXP;
            const GAS f32x4* src = (const GAS f32x4*)((isu ? F.peer_u : F.peer_v) + (size_t)rr * 1024) + lane;
            f32x4 v[4][4]; float mx[4];
#pragma unroll
            for (int q = 0; q < 4; ++q)
#pragma unroll
                for (int j = 0; j < 4; ++j) v[q][j] = src[q * 256 + 64 * j];
#pragma unroll
            for (int q = 0; q < 4; ++q) { mx[q] = 0.f;
#pragma unroll
                for (int j = 0; j < 4; ++j) mx[q] = fmaxf(mx[q], fmaxf(fmaxf(fabsf(v[q][j][0]), fabsf(v[q][j][1])), fmaxf(fabsf(v[q][j][2]), fabsf(v[q][j][3])))); }
#pragma unroll
            for (int o = 1; o < 64; o <<= 1) {
#pragma unroll
                for (int q = 0; q < 4; ++q) mx[q] = fmaxf(mx[q], __shfl_xor(mx[q], o)); }
#pragma unroll
            for (int q = 0; q < 4; ++q) {
                const float sc = mx[q] > 0.f ? mx[q] * (1.0f / 384.0f) : 1.0f, inv = 1.0f / sc;
                GAS unsigned char* dstb = (GAS unsigned char*)(F.ws + (isu ? WS_U8 : WS_V8)) + (size_t)(rr + q) * 128 + 4 * (lane & 31);
#pragma unroll
                for (int j = 0; j < 4; ++j) { int w = 0; w = __builtin_amdgcn_cvt_pk_fp8_f32(v[q][j][0] * inv, v[q][j][1] * inv, w, false); w = __builtin_amdgcn_cvt_pk_fp8_f32(v[q][j][2] * inv, v[q][j][3] * inv, w, true);
                    *(GAS unsigned*)(dstb + (size_t)(2 * j + (lane >> 5)) * ((size_t)NEXP * 128)) = (unsigned)w; }
                if (lane == 0) ((float*)(F.ws + (isu ? WS_SU : WS_SV)))[rr + q] = sc;
            }
        }
    }
}

template <int SECOND>
__device__ __forceinline__ void rows_phase(Frame& F) {
    const int tid = F.tid, lane = F.lane, wave = F.wave;
    LAS float* Ac = (LAS float*)F.lds; LAS float* Bc = Ac + 1024; LAS float* wfs = Bc + 1024;
    const float* mod = (const float*)(F.ws + WS_MOD);
    const float* src = SECOND ? F.out : F.x;
    const float* gain = SECOND ? F.norm2_g : F.norm1_g;
    bf16* dst = (bf16*)(F.ws + WS_HY);
    if (!SECOND) { const float* wfg = (const float*)(F.ws + WS_WFG); for (int i = tid; i < 8192; i += 512) wfs[i] = wfg[i]; }
    for (int it = F.bid; it < 256; it += F.G) {
        const int b = it >> 5;
        const float* shift = mod + (size_t)b * 6144 + (SECOND ? 3072 : 0); const float* scale = shift + 1024;
        __syncthreads();
        for (int i = tid; i < 1024; i += 512) { Ac[i] = gain[i] * (1.0f + scale[i]); Bc[i] = shift[i]; }
        __syncthreads();
        for (int i = 0; i < 8; ++i) {
            const int row = it * 64 + wave * 8 + i;
            const GAS f32x4* xr = (const GAS f32x4*)(src + (size_t)row * 1024) + lane;
            f32x4 v[4]; float ss = 0.f;
#pragma unroll
            for (int j = 0; j < 4; ++j) { v[j] = xr[64 * j]; ss += (v[j][0] * v[j][0] + v[j][1] * v[j][1]) + (v[j][2] * v[j][2] + v[j][3] * v[j][3]); }
            float rstd;
            if (SECOND) { const float* pp = (const float*)(F.ws + WS_PARTS) + (size_t)row * 16; float s = 0.f;
#pragma unroll
                for (int q = 0; q < 16; ++q) s += pp[q];
                rstd = rsqrtf(s * (1.0f / 1024.0f) + RMS_EPS); }
            else rstd = rsqrtf(wave_sum(ss) * (1.0f / 1024.0f) + RMS_EPS);
            float p[8];
#pragma unroll
            for (int q = 0; q < 8; ++q) p[q] = 0.f;
            GAS v2u* o8 = (GAS v2u*)(dst + (size_t)row * 1024) + lane;
#pragma unroll
            for (int j = 0; j < 4; ++j) {
                const int col = 4 * (64 * j + lane);
                const f32x4 a = *(const LAS f32x4*)(Ac + col), bb = *(const LAS f32x4*)(Bc + col);
                const f32x4 hv = v[j] * rstd * a + bb;
                v2u o; o.x = pk2(hv[0], hv[1]); o.y = pk2(hv[2], hv[3]); o8[64 * j] = o;
                if (!SECOND) {
#pragma unroll
                    for (int q = 0; q < 8; ++q) { const f32x4 w = *(const LAS f32x4*)(wfs + q * 1024 + col); p[q] += (hv[0] * w[0] + hv[1] * w[1]) + (hv[2] * w[2] + hv[3] * w[3]); }
                }
            }
            if (!SECOND) {
                float mine = 0.f;
#pragma unroll
                for (int q = 0; q < 8; ++q) { const float s = wave_sum(p[q]); mine = (lane == q) ? s : mine; }
                if (lane < 8) { const float z = mine + F.b_fgate[lane]; const float ls = fminf(z, 0.f) - log1pf(expf(-fabsf(z))); ((float*)(F.ws + WS_LF))[(size_t)row * 8 + lane] = ls; }
            }
        }
    }
    __syncthreads();
}

__device__ __forceinline__ void fcum_items(Frame& F) {
    LAS float* wtot = (LAS float*)F.lds;
    const float* LFp = (const float*)(F.ws + WS_LF); float* Fc = (float*)(F.ws + WS_FC);
    for (int it = F.bid; it < 64; it += F.G) {
        const int b = it >> 3, h = it & 7, s0 = 4 * F.tid;
        float v[4];
#pragma unroll
        for (int i = 0; i < 4; ++i) v[i] = LFp[((size_t)b * SEQ + s0 + i) * 8 + h];
        v[1] += v[0]; v[2] += v[1]; v[3] += v[2];
        float inc = v[3];
#pragma unroll
        for (int o = 1; o < 64; o <<= 1) { const float t = __shfl_up(inc, o); if (F.lane >= o) inc += t; }
        __syncthreads();
        if (F.lane == 63) wtot[F.wave] = inc;
        __syncthreads();
        float base = inc - v[3];
        for (int w = 0; w < F.wave; ++w) base += wtot[w];
        float* o = Fc + (size_t)(b * NHEAD + h) * SEQ + s0;
#pragma unroll
        for (int i = 0; i < 4; ++i) o[i] = base + v[i];
    }
    __syncthreads();
}

__device__ __forceinline__ unsigned okey(float f) { const unsigned u = __float_as_uint(f); return (u & 0x80000000u) ? ~u : (u | 0x80000000u); }
__device__ __forceinline__ float okey_inv(unsigned k) { return __uint_as_float((k & 0x80000000u) ? (k ^ 0x80000000u) : ~k); }
__device__ __forceinline__ void chain16(unsigned (&L)[16], unsigned x) {
#pragma unroll
    for (int k = 0; k < 16; ++k) { const unsigned hi = L[k] > x ? L[k] : x; x = L[k] > x ? x : L[k]; L[k] = hi; }
}
__device__ __forceinline__ void cmpex_desc(unsigned& a, unsigned& b) { const unsigned hi = a > b ? a : b, lo = a > b ? b : a; a = hi; b = lo; }
__device__ __forceinline__ void bitonic_merge16(unsigned (&a)[16]) {
#pragma unroll
    for (int j = 8; j > 0; j >>= 1)
#pragma unroll
        for (int i = 0; i < 16; ++i) { const int l = i ^ j; if (l > i) cmpex_desc(a[i], a[l]); }
}
__device__ __forceinline__ void sort16_desc(unsigned (&a)[16]) {
#pragma unroll
    for (int k = 2; k <= 16; k <<= 1)
#pragma unroll
        for (int j = k >> 1; j > 0; j >>= 1)
#pragma unroll
            for (int i = 0; i < 16; ++i) { const int l = i ^ j; if (l > i) { if ((i & k) == 0 || k == 16) cmpex_desc(a[i], a[l]); else cmpex_desc(a[l], a[i]); } }
}
__device__ __forceinline__ void merge_top16(unsigned (&T)[16], const unsigned (&B)[16]) {
#pragma unroll
    for (int i = 0; i < 16; ++i) T[i] = T[i] > B[15 - i] ? T[i] : B[15 - i];
    bitonic_merge16(T);
}
__device__ __forceinline__ void top16_of_128(const float* p, unsigned (&L)[16]) {
#pragma unroll
    for (int c = 0; c < 8; ++c) {
        f32x4 v[4];
#pragma unroll
        for (int j = 0; j < 4; ++j) v[j] = *(const f32x4*)(p + c * 16 + j * 4);
        unsigned B[16];
#pragma unroll
        for (int j = 0; j < 4; ++j)
#pragma unroll
            for (int e = 0; e < 4; ++e) B[4 * j + e] = (okey(v[j][e]) & ~127u) | (unsigned)(127 - (c * 16 + j * 4 + e));
        sort16_desc(B);
        if (c == 0) {
#pragma unroll
            for (int k = 0; k < 16; ++k) L[k] = B[k];
        } else merge_top16(L, B);
    }
}
struct EpiTopk {
    static constexpr bool PERM = true, AFTER_DRAIN = true;
    unsigned* EG;
    __device__ __forceinline__ void fused(pg8::f32x4 (&acc)[2][2][4][2], const pg8::Unit& u, int wr, int wc, int fr_, int fq_, PG8_LAS unsigned char* lds, int wid, int lane_) const {
        int lane = lane_; asm volatile("" : "+v"(lane));
        const int fr = lane & 15, fq = lane >> 4; (void)fr_; (void)fq_;
        const int row_l = wid * 32 + (lane & 31), seg = lane >> 5;
        unsigned Lh[2][16];
#pragma unroll
        for (int bj = 0; bj < 2; ++bj) {
#pragma unroll
            for (int ai = 0; ai < 2; ++ai)
#pragma unroll
                for (int m = 0; m < 4; ++m)
#pragma unroll
                    for (int n = 0; n < 2; ++n) { const int rowt = ai * 128 + wr * 64 + m * 16 + fr, j = 8 * wc + 2 * fq + n, pos = j ^ (rowt & 31);
                        *(PG8_LAS pg8::f32x4*)(lds + (rowt * 32 + pos) * 16) = acc[ai][bj][m][n]; }
            asm volatile("s_waitcnt lgkmcnt(0)" ::: "memory"); __syncthreads();
            unsigned T[16];
#pragma unroll
            for (int ch = 0; ch < 4; ++ch) {
                unsigned B[16];
#pragma unroll
                for (int q = 0; q < 4; ++q) { const int j = 16 * seg + 4 * ch + q, pos = j ^ (row_l & 31); const pg8::f32x4 v = *(const PG8_LAS pg8::f32x4*)(lds + (row_l * 32 + pos) * 16);
#pragma unroll
                    for (int e = 0; e < 4; ++e) B[4 * q + e] = (okey(v[e]) & ~127u) | (unsigned)(127 - (4 * j + e)); }
                sort16_desc(B);
                if (ch == 0) {
#pragma unroll
                    for (int k = 0; k < 16; ++k) T[k] = B[k];
                } else merge_top16(T, B);
                asm volatile("" : "+v"(T[0]), "+v"(T[1]), "+v"(T[2]), "+v"(T[3]), "+v"(T[4]), "+v"(T[5]), "+v"(T[6]), "+v"(T[7]), "+v"(T[8]), "+v"(T[9]), "+v"(T[10]), "+v"(T[11]), "+v"(T[12]), "+v"(T[13]), "+v"(T[14]), "+v"(T[15]));
                __builtin_amdgcn_sched_barrier(0);
            }
            unsigned Pk[16];
#pragma unroll
            for (int k = 0; k < 16; ++k) { auto rr = __builtin_amdgcn_permlane32_swap(T[k], T[k], false, false); Pk[k] = seg ? rr[0] : rr[1]; }
            merge_top16(T, Pk);
#pragma unroll
            for (int k = 0; k < 16; ++k) Lh[bj][k] = T[k];
            asm volatile("s_waitcnt lgkmcnt(0)" ::: "memory"); __syncthreads();
        }
        PG8_LAS unsigned char* tab = lds + (wid * 64 + lane) * 32;
        float v1[16], v2[16];
#pragma unroll
        for (int k = 0; k < 16; ++k) { v1[k] = okey_inv(Lh[0][k] & ~127u); tab[k] = (unsigned char)(127u - (Lh[0][k] & 127u)); v2[k] = okey_inv(Lh[1][k] & ~127u); tab[16 + k] = (unsigned char)(127u - (Lh[1][k] & 127u)); }
        unsigned C[16];
#pragma unroll
        for (int j = 0; j < 16; ++j) C[j] = (okey(v1[0] + v2[j]) & ~255u) | (unsigned)(255 - j);
#pragma unroll
        for (int i = 1; i < 16; ++i)
#pragma unroll
            for (int j = 0; j < 16 / (i + 1); ++j) chain16(C, (okey(v1[i] + v2[j]) & ~255u) | (unsigned)(255 - (i * 16 + j)));
        float sv[16]; float sum = 0.f; const float mx = okey_inv(C[0] & ~255u);
#pragma unroll
        for (int k = 0; k < 16; ++k) { sv[k] = expf(okey_inv(C[k] & ~255u) - mx); sum += sv[k]; }
        const float rs = 1.0f / sum;
        unsigned o[16];
#pragma unroll
        for (int k = 0; k < 16; ++k) { const int pos = 255 - (int)(C[k] & 255u); const unsigned eid = (unsigned)tab[pos >> 4] * 128u + (unsigned)tab[16 + (pos & 15)];
            const _Float16 hg = (_Float16)(sv[k] * rs); o[k] = ((unsigned)__builtin_bit_cast(unsigned short, hg) << 16) | eid; }
        if (seg == 0) {
            GAS v4u* dst = (GAS v4u*)(EG + ((size_t)(u.pm * 256 + row_l) * 8 + u.pn) * 16);
#pragma unroll
            for (int q = 0; q < 4; ++q) dst[q] = (v4u){o[4 * q], o[4 * q + 1], o[4 * q + 2], o[4 * q + 3]};
        }
        asm volatile("s_waitcnt lgkmcnt(0)" ::: "memory"); __syncthreads();
    }
};
struct OneUnit {
    pg8::StaticOrder S; int which;
    __device__ __forceinline__ bool next(int i, pg8::Unit& u) const { return i == 0 && S.next(which, u); }
    __device__ __forceinline__ void a_ready(const pg8::Unit&) const {}
    __device__ __forceinline__ void done(const pg8::Unit&) const {}
};
__device__ __forceinline__ void topk_phase(Frame& F) {
    const float* SC = (const float*)(F.ws + WS_SC); unsigned* EG = (unsigned*)(F.ws + WS_EG);
    LAS unsigned char* tab = F.lds + F.tid * 32;
    for (int th = F.bid * 512 + F.tid; th < NTOK * 8; th += F.G * 512) {
        const float* p = SC + (size_t)th * 256;
        unsigned L1[16], L2[16];
        top16_of_128(p, L1); top16_of_128(p + 128, L2);
        float v1[16], v2[16];
#pragma unroll
        for (int k = 0; k < 16; ++k) { v1[k] = okey_inv(L1[k] & ~127u); tab[k] = (unsigned char)(127u - (L1[k] & 127u)); v2[k] = okey_inv(L2[k] & ~127u); tab[16 + k] = (unsigned char)(127u - (L2[k] & 127u)); }
        unsigned C[16];
#pragma unroll
        for (int j = 0; j < 16; ++j) C[j] = (okey(v1[0] + v2[j]) & ~255u) | (unsigned)(255 - j);
#pragma unroll
        for (int i = 1; i < 16; ++i)
#pragma unroll
            for (int j = 0; j < 16 / (i + 1); ++j) chain16(C, (okey(v1[i] + v2[j]) & ~255u) | (unsigned)(255 - (i * 16 + j)));
        float sv[16]; float sum = 0.f; const float mx = okey_inv(C[0] & ~255u);
#pragma unroll
        for (int k = 0; k < 16; ++k) { sv[k] = expf(okey_inv(C[k] & ~255u) - mx); sum += sv[k]; }
        const float rs = 1.0f / sum;
        unsigned o[16];
#pragma unroll
        for (int k = 0; k < 16; ++k) { const int pos = 255 - (int)(C[k] & 255u); const unsigned eid = (unsigned)tab[pos >> 4] * 128u + (unsigned)tab[16 + (pos & 15)];
            const _Float16 hg = (_Float16)(sv[k] * rs); o[k] = ((unsigned)__builtin_bit_cast(unsigned short, hg) << 16) | eid; }
        GAS v4u* dst = (GAS v4u*)(EG + (size_t)th * 16);
#pragma unroll
        for (int q = 0; q < 4; ++q) dst[q] = (v4u){o[4 * q], o[4 * q + 1], o[4 * q + 2], o[4 * q + 3]};
    }
}

typedef float f32x2v __attribute__((ext_vector_type(2)));
__device__ __forceinline__ float gelu_tanh(float a) { const float y = 0.7978845608028654f * (a + 0.044715f * a * a * a); const float th = 1.0f - 2.0f / (__expf(2.0f * y) + 1.0f); return 0.5f * a * (1.0f + th); }
__device__ __forceinline__ void fp8x16_to_f32(const v4u r, float (&f)[16]) {
#pragma unroll
    for (int q = 0; q < 4; ++q) { const f32x2v lo = __builtin_amdgcn_cvt_pk_f32_fp8((int)r[q], false), hi = __builtin_amdgcn_cvt_pk_f32_fp8((int)r[q], true); f[4 * q] = lo[0]; f[4 * q + 1] = lo[1]; f[4 * q + 2] = hi[0]; f[4 * q + 3] = hi[1]; }
}
template <bool VSIDE>
__device__ __forceinline__ void peer_gather(Frame& F, bool dry) {
    const int lane = F.lane, wave = F.wave, g = lane >> 3, ch = lane & 7;
    const bool sliced = (F.G % 8) == 0;
    const int x_lo = sliced ? (F.bid & 7) : 0, x_hi = sliced ? x_lo + 1 : 8;
    const int wv = sliced ? (F.bid >> 3) * NWAVES + wave : F.bid * NWAVES + wave, NW = sliced ? (F.G >> 3) * NWAVES : F.G * NWAVES;
    const unsigned* EG = (const unsigned*)(F.ws + WS_EG); const bf16* H2 = (const bf16*)(F.ws + WS_HY); const float* Wt = (const float*)(F.ws + WS_WT);
    const unsigned char* TB = F.ws + (VSIDE ? WS_V8 : WS_U8); float* Pp = (float*)(F.ws + WS_PP); const float* mod = (const float*)(F.ws + WS_MOD);
    const bool c0 = VSIDE ? (lane & 8) != 0 : (lane & 1) != 0, c1 = VSIDE ? (lane & 16) != 0 : (lane & 2) != 0, c2 = VSIDE ? (lane & 32) != 0 : (lane & 4) != 0;
    constexpr int X0 = VSIDE ? 8 : 1, X1 = VSIDE ? 16 : 2, X2 = VSIDE ? 32 : 4;
    for (int x = x_lo; x < x_hi; ++x) {
        const unsigned char* tb = TB + (size_t)x * ((size_t)NEXP * 128) + 16 * ch;
#define PG_TOK(tt) ((tt) < NTOK ? (tt) : NTOK - 1)
#define PG_LOAD_EG(tt) do { const unsigned* ep_ = EG + (size_t)PG_TOK(tt) * 128 + 16 * g; _Pragma("unroll") for (int q_ = 0; q_ < 4; ++q_) eg[q_] = *(const GAS v4u*)(ep_ + 4 * q_); } while (0)
#define PG_LOAD_AUX(tt, AUX) do { if (VSIDE) { const float* wp_ = Wt + (size_t)PG_TOK(tt) * 128 + 16 * g; _Pragma("unroll") for (int q_ = 0; q_ < 4; ++q_) AUX[q_] = *(const GAS v4u*)(wp_ + 4 * q_); } \
        else { const bf16* hp_ = H2 + (size_t)PG_TOK(tt) * 1024 + 128 * x + 16 * ch; AUX[0] = *(const GAS v4u*)hp_; AUX[1] = *(const GAS v4u*)(hp_ + 8); } } while (0)
#define PG_ROWS8(R, EGV, H) do { _Pragma("unroll") for (int i_ = 0; i_ < 8; ++i_) { const unsigned e_ = EGV[2 * (H) + (i_ >> 2)][i_ & 3] & 0xffffu; R[i_] = *(const GAS v4u*)(tb + (size_t)e_ * 128); } } while (0)
        v4u eg[4], egC[4], auxC[4], auxN[4], rLo[8], rHi[8];
        float v16[16], hf[16];
        auto half = [&](const v4u (&R)[8], const int H) {
#pragma unroll
            for (int i = 0; i < 8; ++i) { float f[16]; fp8x16_to_f32(R[i], f);
                if (VSIDE) { const float w = __uint_as_float(auxC[2 * H + (i >> 2)][i & 3]);
#pragma unroll
                    for (int c = 0; c < 16; ++c) v16[c] += w * f[c];
                    asm volatile("" : "+v"(v16[0]), "+v"(v16[1]), "+v"(v16[2]), "+v"(v16[3]), "+v"(v16[4]), "+v"(v16[5]), "+v"(v16[6]), "+v"(v16[7]),
                                      "+v"(v16[8]), "+v"(v16[9]), "+v"(v16[10]), "+v"(v16[11]), "+v"(v16[12]), "+v"(v16[13]), "+v"(v16[14]), "+v"(v16[15])); }
                else { float a0 = 0.f, a1 = 0.f;
#pragma unroll
                    for (int c = 0; c < 16; c += 2) { a0 += f[c] * hf[c]; a1 += f[c + 1] * hf[c + 1]; }
                    v16[8 * H + i] = a0 + a1; asm volatile("" : "+v"(v16[8 * H + i])); }
                __builtin_amdgcn_sched_barrier(0); }
        };
        auto finish = [&](int tt) {
            float r8[8], r4[4], r2[2];
#pragma unroll
            for (int c = 0; c < 8; ++c) { const float keep = c0 ? v16[8 + c] : v16[c], send = c0 ? v16[c] : v16[8 + c]; r8[c] = keep + __shfl_xor(send, X0); }
#pragma unroll
            for (int c = 0; c < 4; ++c) { const float keep = c1 ? r8[4 + c] : r8[c], send = c1 ? r8[c] : r8[4 + c]; r4[c] = keep + __shfl_xor(send, X1); }
#pragma unroll
            for (int c = 0; c < 2; ++c) { const float keep = c2 ? r4[2 + c] : r4[c], send = c2 ? r4[c] : r4[2 + c]; r2[c] = keep + __shfl_xor(send, X2); }
            const int sub = (c0 ? 8 : 0) + (c1 ? 4 : 0) + (c2 ? 2 : 0);
            if (tt < NTOK) {
                if (VSIDE) {
                    const int col = 128 * x + 16 * ch + sub; const int b = tt >> 11; const float* g2 = mod + (size_t)b * 6144 + 5120;
                    float* orow = F.out + (size_t)tt * 1024;
                    const f32x2v xv = *(const GAS f32x2v*)(orow + col), gvv = *(const GAS f32x2v*)(g2 + col);
                    f32x2v o; o[0] = xv[0] + gvv[0] * r2[0]; o[1] = xv[1] + gvv[1] * r2[1];
                    *(GAS f32x2v*)((dry ? (float*)(F.ws + WS_SC) + (size_t)tt * 1024 : orow) + col) = o;
                } else {
                    *(GAS f32x2v*)(Pp + ((size_t)x * NTOK + tt) * 128 + 16 * g + sub) = (f32x2v){r2[0], r2[1]};
                }
            }
        };
        int t = wv;
        PG_LOAD_EG(t); PG_LOAD_AUX(t, auxC);
#pragma unroll
        for (int q = 0; q < 4; ++q) egC[q] = eg[q];
        PG_ROWS8(rLo, egC, 0);
        PG_LOAD_EG(t + NW); PG_LOAD_AUX(t + NW, auxN);
        for (; t < NTOK; t += NW) {
            PG_ROWS8(rHi, egC, 1);
            if (VSIDE) {
#pragma unroll
                for (int c = 0; c < 16; ++c) v16[c] = 0.f;
            } else {
#pragma unroll
                for (int q = 0; q < 4; ++q) { hf[2 * q] = pg8::bf_lo(auxC[0][q]); hf[2 * q + 1] = pg8::bf_hi(auxC[0][q]); hf[8 + 2 * q] = pg8::bf_lo(auxC[1][q]); hf[8 + 2 * q + 1] = pg8::bf_hi(auxC[1][q]); }
            }
            half(rLo, 0);
            PG_ROWS8(rLo, eg, 0);
            half(rHi, 1);
            finish(t);
#pragma unroll
            for (int q = 0; q < 4; ++q) { egC[q] = eg[q]; auxC[q] = auxN[q]; }
            PG_LOAD_EG(t + 2 * NW); PG_LOAD_AUX(t + 2 * NW, auxN);
        }
#undef PG_TOK
#undef PG_LOAD_EG
#undef PG_LOAD_AUX
#undef PG_ROWS8
    }
}
__device__ __forceinline__ void peer_w_phase(Frame& F) {
    const unsigned* EG = (const unsigned*)(F.ws + WS_EG); const float* Pp = (const float*)(F.ws + WS_PP);
    const float* SU = (const float*)(F.ws + WS_SU); const float* SV = (const float*)(F.ws + WS_SV); float* Wt = (float*)(F.ws + WS_WT);
    for (size_t i = (size_t)F.bid * 512 + F.tid; i < (size_t)NTOK * 128; i += (size_t)F.G * 512) {
        float a = 0.f;
#pragma unroll
        for (int x = 0; x < 8; ++x) a += Pp[(size_t)x * NTOK * 128 + i];
        const unsigned egv = EG[i]; const unsigned e = egv & 0xffffu;
        Wt[i] = (float)__builtin_bit_cast(_Float16, (unsigned short)(egv >> 16)) * gelu_tanh(a * SU[e]) * SV[e];
    }
}

constexpr int N_PHASES = 12;
struct Args { const float* in[19]; float* out; unsigned char* ws; int ph_lo, ph_hi; };
__global__ void __launch_bounds__(NWAVES * 64, 2) fwd_kernel(Args args) {
    extern __shared__ __attribute__((aligned(16))) unsigned char lds_raw[];
    Frame F;
    F.lds = (LAS unsigned char*)lds_raw;
    F.tid = threadIdx.x; F.lane = F.tid & 63; F.wave = __builtin_amdgcn_readfirstlane(F.tid >> 6); F.G = gridDim.x; F.bid = blockIdx.x;
    F.x = args.in[0]; F.c = args.in[1]; F.w_ada = args.in[2]; F.b_ada = args.in[3]; F.norm1_g = args.in[4]; F.w_in = args.in[5]; F.b_fgate = args.in[6];
    F.fox_q_g = args.in[7]; F.fox_k_g = args.in[8]; F.moba_q_g = args.in[9]; F.moba_k_g = args.in[10]; F.w_up_fox = args.in[11]; F.w_up_moba = args.in[12];
    F.w_out = args.in[13]; F.norm2_g = args.in[14]; F.w_peer_q = args.in[15]; F.sub_keys = args.in[16]; F.peer_u = args.in[17]; F.peer_v = args.in[18];
    F.out = args.out; F.ws = args.ws;
    unsigned char* ws = args.ws;
    volatile LAS unsigned* MISC = (volatile LAS unsigned*)(F.lds + MISC_OFF);
    for (int u = F.tid; u < (LDS_BYTES - LDSCTL_OFF) / 4; u += NWAVES * 64) ((LAS unsigned*)(F.lds + LDSCTL_OFF))[u] = 0u;
    __syncthreads();
#if !MK_PER_PHASE
    XcdBarrier bar = xcd_barrier_post((unsigned*)(ws + WS_CTL) + CW_BAR, MISC + 8);
#define GRID_BAR() xcd_barrier(bar)
#else
    (void)MISC;
#define GRID_BAR() do {} while (0)
#endif
    const int lo = args.ph_lo, hi = args.ph_hi;
#define IN(k) (lo <= (k) && (k) < hi)
#define REPS(k) (((k) == DUP_PHASE) ? DUP_N : 1)
#define REP(k) for (int rep_ = 0; rep_ < REPS(k); ++rep_)
#define REPBAR(k) do { if (rep_ + 1 < REPS(k)) GRID_BAR(); } while (0)
#define SEAM(k) do { if (IN(k) && IN((k) + 1)) GRID_BAR(); } while (0)
    typedef pg8::bf16_t pb;

    if (IN(0)) REP(0) { p0_prep(F); REPBAR(0); } SEAM(0);
    if (IN(1)) REP(1) { rows_phase<0>(F); REPBAR(1); } SEAM(1);
    if (IN(2)) REP(2) {
        fcum_items(F);
        pg8::Gemm g{(const pb*)(ws + WS_HY), (const pb*)(ws + WS_WIN), NTOK, NIN, DM, DM, DM}; pg8::StaticOrder S; S.init(NTOK, NIN, F.G, F.bid);
        pg8::EpiIn E{(pb*)(ws + WS_QKV), (pb*)F.out, (const float*)(ws + WS_GAINS), (float*)(ws + ((rep_ + 1 < REPS(2)) ? WS_EG : WS_KMEAN))};
        pg8::gemm_phase<pg8::EpiIn, pg8::StaticOrder, true, true>(F.lds, g, S, E);
        REPBAR(2);
    } SEAM(2);
    if (IN(3)) REP(3) {
        const pb* qkv = (const pb*)(ws + WS_QKV); constexpr size_t TS = (size_t)NTOK * 512;
        for (int it = F.bid; it < 256; it += F.G) {
            const int bh = it >> 2, s = it & 3, b = bh >> 3, h = bh & 7;
            att::attn_unit<0>(b, h, 7 - s, qkv, qkv + TS, qkv + 2 * TS, (const float*)(ws + WS_FC), nullptr, (pb*)(ws + WS_HY), (__attribute__((address_space(3))) char*)F.lds);
            att::attn_unit<1>(b, h, 7 - s, qkv + 3 * TS, qkv + 4 * TS, qkv + 5 * TS, nullptr, (const float*)(ws + WS_KMEAN), (pb*)(ws + WS_HY), (__attribute__((address_space(3))) char*)F.lds);
            att::attn_unit<0>(b, h, s, qkv, qkv + TS, qkv + 2 * TS, (const float*)(ws + WS_FC), nullptr, (pb*)(ws + WS_HY), (__attribute__((address_space(3))) char*)F.lds);
            att::attn_unit<1>(b, h, s, qkv + 3 * TS, qkv + 4 * TS, qkv + 5 * TS, nullptr, (const float*)(ws + WS_KMEAN), (pb*)(ws + WS_HY), (__attribute__((address_space(3))) char*)F.lds);
        }
        REPBAR(3);
    } SEAM(3);
    if (IN(4)) {
        pg8::StaticOrder S; S.init(NTOK, DM, F.G, F.bid);
        { pg8::Gemm g{(const pb*)(ws + WS_HY), (const pb*)(ws + WS_WFT), NTOK, DM, 512, DM, 512};
          pg8::EpiUp<0> E{(const pb*)F.out, (pb*)(ws + WS_MIX)}; pg8::gemm_phase<pg8::EpiUp<0>, pg8::StaticOrder, true, true>(F.lds, g, S, E); }
        VM_WAIT(); __syncthreads();
        { pg8::Gemm g{(const pb*)(ws + WS_HY) + 512, (const pb*)(ws + WS_WMT), NTOK, DM, 512, DM, 512};
          pg8::EpiUp<1> E{(const pb*)F.out, (pb*)(ws + WS_MIX)}; pg8::gemm_phase<pg8::EpiUp<1>, pg8::StaticOrder, true, true>(F.lds, g, S, E); }
    } SEAM(4);
    if (IN(5)) {
        pg8::Gemm g{(const pb*)(ws + WS_MIX), (const pb*)(ws + WS_WOT), NTOK, DM, DM, DM, DM}; pg8::StaticOrder S; S.init(NTOK, DM, F.G, F.bid);
        pg8::EpiOut E{F.x, (const float*)(ws + WS_MOD), F.out, (float*)(ws + WS_PARTS)};
        pg8::gemm_phase<pg8::EpiOut, pg8::StaticOrder, true, true>(F.lds, g, S, E);
    } SEAM(5);
    if (IN(6)) { rows_phase<1>(F); } SEAM(6);
    if (IN(7)) REP(7) {
        pg8::Gemm g{(const pb*)(ws + WS_HY), (const pb*)(ws + WS_WEFF), NTOK, NSC, DM, DM, DM};
        OneUnit S; S.S.init(NTOK, NSC, F.G, F.bid);
        EpiTopk E{(unsigned*)(ws + WS_EG)};
        pg8::Unit tmp;
        for (S.which = 0; S.S.next(S.which, tmp); ++S.which) pg8::gemm_phase<EpiTopk, OneUnit, false, true>(F.lds, g, S, E);
        REPBAR(7);
    } SEAM(7);
    if (IN(9)) REP(9) { peer_gather<false>(F, false); REPBAR(9); } SEAM(9);
    if (IN(10)) REP(10) { peer_w_phase(F); REPBAR(10); } SEAM(10);
    if (IN(11)) REP(11) { peer_gather<true>(F, rep_ + 1 < REPS(11)); REPBAR(11); }
#undef IN
#undef SEAM
}

extern "C" void kernel_launch(void* const* d_in, const int* in_sizes, int n_in, void* d_out, int out_size, void* d_ws, size_t ws_size, hipStream_t stream) {
    static int grid = 0;
    if (grid == 0) {
        if (n_in != 19 || out_size != NTOK * DM || ws_size < WS_END) { fprintf(stderr, "kernel_launch: unexpected shapes (n_in %d, out %d, ws %zu); nothing launched\n", n_in, out_size, ws_size); grid = -1; return; }
        int dev = 0, cus = 0, per_cu = 0;
        if (hipGetDevice(&dev) != hipSuccess || hipDeviceGetAttribute(&cus, hipDeviceAttributeMultiprocessorCount, dev) != hipSuccess) { grid = -1; return; }
        if (hipFuncSetAttribute((const void*)fwd_kernel, hipFuncAttributeMaxDynamicSharedMemorySize, LDS_BYTES) != hipSuccess) { fprintf(stderr, "kernel_launch: hipFuncSetAttribute failed\n"); grid = -1; return; }
        if (hipOccupancyMaxActiveBlocksPerMultiprocessor(&per_cu, (const void*)fwd_kernel, NWAVES * 64, LDS_BYTES) != hipSuccess || per_cu < 1) { fprintf(stderr, "kernel_launch: occupancy query says %d blocks per CU\n", per_cu); per_cu = 1; }
        (void)hipGetLastError();
        grid = cus;
    }
    if (grid < 0) return;
    (void)hipMemsetAsync((char*)d_ws + WS_CTL, 0, CTL_ZERO_BYTES, stream);
    Args a{};
    for (int i = 0; i < 19; ++i) a.in[i] = (const float*)d_in[i];
    a.out = (float*)d_out; a.ws = (unsigned char*)d_ws;
#if MK_PER_PHASE
    for (int ph = 0; ph < N_PHASES; ++ph) { a.ph_lo = ph; a.ph_hi = ph + 1; hipLaunchKernelGGL(fwd_kernel, dim3(grid), dim3(NWAVES * 64), LDS_BYTES, stream, a); }
#else
    a.ph_lo = 0; a.ph_hi = N_PHASES;
    hipLaunchKernelGGL(fwd_kernel, dim3(grid), dim3(NWAVES * 64), LDS_BYTES, stream, a);
#endif
}
```
